# Optimizing an MI355X kernel written in HIP

```python
import math
import jax, jax.numpy as jnp
from jax import lax
import numpy as np

D_MODEL = 1024
BATCH = 8
SEQ = 2048
DEPTH = 2
DEC_BATCH = 128
DEC_SEQ = 8
PAST_LEN = 16384
PAGE_SIZE = 128

N_AB = (DEPTH + 1) // 2
N_CONV = DEPTH // 2
A_HEADS = 8
A_HEAD_DIM = 64
A_WIDTH = A_HEADS * A_HEAD_DIM
DECAY_LORA = 64
AAA_LORA = 64
GATE_LORA = 128
A_PROJ = 3 * A_WIDTH + DECAY_LORA + AAA_LORA + GATE_LORA
A_SPLITS = (A_WIDTH, 2 * A_WIDTH, 3 * A_WIDTH, 3 * A_WIDTH + DECAY_LORA, 3 * A_WIDTH + DECAY_LORA + AAA_LORA)
A_GN_EPS = 64e-5
B_HEADS = 8
B_HEAD_DIM = 64
B_WIDTH = B_HEADS * B_HEAD_DIM
B_PROJ = 4 * B_WIDTH
RET_CHUNK = 128
ROPE_BASE = 10000.0
B_GN_EPS = 1e-5
CONV_W = 3
D_FF = 4 * D_MODEL
LN_EPS = 1e-5
ALPHA = (2.0 * DEPTH) ** 0.25
BETA = (8.0 * DEPTH) ** -0.25

kernel_name = 'hybrid_rwkv7_retnet_shortconv_step'


def layer_norm(x, g, b):
    xf = x.astype(jnp.float32)
    mu = jnp.mean(xf, -1, keepdims=True)
    var = jnp.mean(jnp.square(xf - mu), -1, keepdims=True)
    return ((xf - mu) * lax.rsqrt(var + LN_EPS)).astype(x.dtype) * g + b


def head_norm(y, g, b, eps):
    Bn, T, H, N = y.shape
    mu = jnp.mean(y, -1, keepdims=True)
    var = jnp.mean(jnp.square(y - mu), -1, keepdims=True)
    yn = ((y - mu) * lax.rsqrt(var + eps)).reshape(Bn, T, H * N)
    return yn * g.astype(jnp.float32) + b.astype(jnp.float32)


def rope(x, pos):
    half = x.shape[-1] // 2
    inv = ROPE_BASE ** (-jnp.arange(half, dtype=jnp.float32) / half)
    ang = pos.astype(jnp.float32)[:, None] * inv[None, :]
    cos = jnp.cos(ang)[None, :, None, :]
    sin = jnp.sin(ang)[None, :, None, :]
    x1, x2 = x[..., :half], x[..., half:]
    return jnp.concatenate([x1 * cos - x2 * sin, x2 * cos + x1 * sin], axis=-1)


def rwkv7_mixer(p, p_last, S0, mu, w0, w2, a0, a2, g2, k_k, k_a, r_k, lnx_g, lnx_b):
    Bn, T, _ = p.shape
    p_prev = jnp.concatenate([p_last[:, None, :].astype(p.dtype), p[:, :-1]], axis=1)
    m = p + (p_prev - p) * mu
    r, k, v, wd, ad, gd = jnp.split(m, A_SPLITS, axis=-1)
    w = -jax.nn.softplus(-(w0 + jnp.tanh(wd) @ w2)) - 0.5
    decay = jnp.exp(-jnp.exp(w.astype(jnp.float32)))
    a = jax.nn.sigmoid(a0 + ad @ a2)
    g = jax.nn.sigmoid(gd) @ g2
    kk = k * k_k
    k = k * (1.0 + (a - 1.0) * k_a)
    heads = lambda t: t.astype(jnp.float32).reshape(Bn, T, A_HEADS, A_HEAD_DIM)
    r, k, v, kk, a, decay = map(heads, (r, k, v, kk, a, decay))
    kk = kk * lax.rsqrt(jnp.maximum(jnp.sum(kk * kk, -1, keepdims=True), 1e-24))

    def step(S, inp):
        r_t, k_t, v_t, kk_t, a_t, w_t = inp
        sa = jnp.einsum('bhvk,bhk->bhv', S, -kk_t)
        S = (S * w_t[:, :, None, :] + sa[..., None] * (kk_t * a_t)[:, :, None, :]
             + v_t[..., None] * k_t[:, :, None, :])
        return S, jnp.einsum('bhvk,bhk->bhv', S, r_t)

    xs = tuple(jnp.swapaxes(t, 0, 1) for t in (r, k, v, kk, a, decay))
    S, o = lax.scan(step, S0.astype(jnp.float32), xs)
    o = jnp.swapaxes(o, 0, 1)
    bonus = (jnp.sum(r * k * r_k.astype(jnp.float32), -1, keepdims=True) * v).reshape(Bn, T, A_WIDTH)
    y = (head_norm(o, lnx_g, lnx_b, A_GN_EPS) + bonus) * g.astype(jnp.float32)
    return y, p[:, -1], S.astype(S0.dtype)


def retention(q, k, v, S0, log_gamma):
    Bn, T, H, N = q.shape
    C = RET_CHUNK if T % RET_CHUNK == 0 else T
    nc = T // C
    chunks = lambda t: t.reshape(Bn, nc, C, H, N).transpose(1, 0, 3, 2, 4)
    idx = jnp.arange(C, dtype=jnp.float32)
    diff = idx[:, None] - idx[None, :]
    lg = log_gamma[:, None, None]
    dmask = jnp.where(diff[None] >= 0, jnp.exp(lg * jnp.maximum(diff, 0.0)[None]), 0.0)
    q_decay = jnp.exp(log_gamma[:, None] * (idx + 1.0)[None, :])[None, :, :, None]
    k_decay = jnp.exp(log_gamma[:, None] * (C - 1.0 - idx)[None, :])[None, :, :, None]
    c_decay = jnp.exp(log_gamma * C)[None, :, None, None]

    def step(S, inp):
        qi, ki, vi = inp
        scores = jnp.einsum('bhin,bhjn->bhij', qi, ki) * dmask
        inner = jnp.einsum('bhij,bhjn->bhin', scores, vi)
        cross = jnp.einsum('bhik,bhkv->bhiv', qi, S) * q_decay
        S = S * c_decay + jnp.einsum('bhjk,bhjv->bhkv', ki * k_decay, vi)
        return S, inner + cross

    S, o = lax.scan(step, S0, (chunks(q), chunks(k), chunks(v)))
    return o.transpose(1, 0, 3, 2, 4).reshape(Bn, T, H, N), S


def ab_mixer(x, shift0, wkv0, ret0, pos, w_in, mu, w0, w2, a0, a2, g2, k_k, k_a, r_k,
             lnx_g, lnx_b, gn_g, gn_b, w_out):
    Bn, T, _ = x.shape
    proj = x @ w_in
    pa, pb = proj[..., :A_PROJ], proj[..., A_PROJ:]
    ya, shift1, wkv1 = rwkv7_mixer(pa, shift0, wkv0, mu, w0, w2, a0, a2, g2, k_k, k_a, r_k, lnx_g, lnx_b)
    q, kr, vr, gate = jnp.split(pb, 4, axis=-1)
    hb = lambda t: t.astype(jnp.float32).reshape(Bn, T, B_HEADS, B_HEAD_DIM)
    q = rope(hb(q), pos)
    kr = rope(hb(kr), pos) * (B_HEAD_DIM ** -0.5)
    log_gamma = jnp.log1p(-jnp.exp2(-5.0 - jnp.arange(B_HEADS, dtype=jnp.float32)))
    ob, ret1 = retention(q, kr, hb(vr), ret0.astype(jnp.float32), log_gamma)
    yb = jax.nn.silu(gate.astype(jnp.float32)) * head_norm(ob, gn_g, gn_b, B_GN_EPS)
    y = jnp.concatenate([ya, yb], axis=-1).astype(x.dtype) @ w_out
    return y, shift1, wkv1, ret1.astype(ret0.dtype)


def conv_mixer(x, buf0, w_in, conv_w, w_out):
    T = x.shape[1]
    bg, cg, h = jnp.split(x @ w_in, 3, axis=-1)
    u = cg * h
    ext = jnp.concatenate([buf0.astype(u.dtype), u], axis=1)
    conv = sum(ext[:, j:j + T] * conv_w[j] for j in range(CONV_W))
    return (bg * conv) @ w_out, ext[:, ext.shape[1] - (CONV_W - 1):]


def sqrelu_mlp(x, w_up, w_down):
    return jnp.square(jax.nn.relu(x @ w_up)) @ w_down


def trunk(x, st_shift, st_wkv, st_ret, st_conv, pos, w_in_ab, mu_a, w0, w2, a0, a2, g2, k_k, k_a, r_k,
          lnx_g, lnx_b, gn_g, gn_b, w_out_ab, w_in_conv, conv_w, w_out_conv,
          ln1_g, ln1_b, ln2_g, ln2_b, w_up, w_down):
    shifts, wkvs, rets, convs = [], [], [], []
    for l in range(DEPTH):
        i = l // 2
        if l % 2 == 0:
            y, s1, wk1, r1 = ab_mixer(x, st_shift[i], st_wkv[i], st_ret[i], pos, w_in_ab[i], mu_a[i], w0[i],
                                      w2[i], a0[i], a2[i], g2[i], k_k[i], k_a[i], r_k[i], lnx_g[i], lnx_b[i],
                                      gn_g[i], gn_b[i], w_out_ab[i])
            shifts.append(s1)
            wkvs.append(wk1)
            rets.append(r1)
        else:
            y, c1 = conv_mixer(x, st_conv[i], w_in_conv[i], conv_w[i], w_out_conv[i])
            convs.append(c1)
        x = layer_norm(ALPHA * x + y, ln1_g[l], ln1_b[l])
        x = layer_norm(ALPHA * x + sqrelu_mlp(x, w_up[l], w_down[l]), ln2_g[l], ln2_b[l])
    return x, jnp.stack(shifts), jnp.stack(wkvs), jnp.stack(rets), jnp.stack(convs)


def setup_inputs(seed: int = 0) -> dict:
    key = jax.random.key(seed)
    ks = jax.random.split(key, 30)
    f32 = jnp.float32
    nrm = lambda k, shape, s: s * jax.random.normal(k, shape, f32)
    uni = lambda k, shape, lo, hi: jax.random.uniform(k, shape, f32, lo, hi)
    return {
        'x_prompt': nrm(ks[0], (BATCH, SEQ, D_MODEL), 1.0),
        'x_sample': nrm(ks[1], (DEC_BATCH, DEC_SEQ, D_MODEL), 1.0),
        'state_shift': nrm(ks[2], (N_AB, DEC_BATCH, A_PROJ), 1.0),
        'state_wkv': nrm(ks[3], (N_AB, DEC_BATCH, A_HEADS, A_HEAD_DIM, A_HEAD_DIM), 0.5),
        'state_ret': nrm(ks[4], (N_AB, DEC_BATCH, B_HEADS, B_HEAD_DIM, B_HEAD_DIM), 1.0),
        'state_conv': nrm(ks[5], (N_CONV, DEC_BATCH, CONV_W - 1, D_MODEL), 1.0),
        'w_in_ab': nrm(ks[6], (N_AB, D_MODEL, A_PROJ + B_PROJ), D_MODEL ** -0.5),
        'mu_a': uni(ks[7], (N_AB, A_PROJ), 0.0, 1.0),
        'w0': uni(ks[8], (N_AB, A_WIDTH), -4.0, 0.0),
        'w2': nrm(ks[9], (N_AB, DECAY_LORA, A_WIDTH), 0.5 * DECAY_LORA ** -0.5),
        'a0': nrm(ks[10], (N_AB, A_WIDTH), 0.1),
        'a2': nrm(ks[11], (N_AB, AAA_LORA, A_WIDTH), 0.5 * AAA_LORA ** -0.5),
        'g2': nrm(ks[12], (N_AB, GATE_LORA, A_WIDTH), GATE_LORA ** -0.5),
        'k_k': 0.85 + nrm(ks[13], (N_AB, A_WIDTH), 0.02),
        'k_a': 1.0 + nrm(ks[14], (N_AB, A_WIDTH), 0.02),
        'r_k': nrm(ks[15], (N_AB, A_HEADS, A_HEAD_DIM), 0.1),
        'lnx_g': 1.0 + nrm(ks[16], (N_AB, A_WIDTH), 0.01),
        'lnx_b': nrm(ks[17], (N_AB, A_WIDTH), 0.01),
        'gn_g': 1.0 + nrm(ks[18], (N_AB, B_WIDTH), 0.01),
        'gn_b': nrm(ks[19], (N_AB, B_WIDTH), 0.01),
        'w_out_ab': nrm(ks[20], (N_AB, A_WIDTH + B_WIDTH, D_MODEL), BETA * (A_WIDTH + B_WIDTH) ** -0.5),
        'w_in_conv': nrm(ks[21], (N_CONV, D_MODEL, 3 * D_MODEL), D_MODEL ** -0.5),
        'conv_w': nrm(ks[22], (N_CONV, CONV_W, D_MODEL), CONV_W ** -0.5),
        'w_out_conv': nrm(ks[23], (N_CONV, D_MODEL, D_MODEL), BETA * D_MODEL ** -0.5),
        'ln1_g': 1.0 + nrm(ks[24], (DEPTH, D_MODEL), 0.01),
        'ln1_b': nrm(ks[25], (DEPTH, D_MODEL), 0.01),
        'ln2_g': 1.0 + nrm(ks[26], (DEPTH, D_MODEL), 0.01),
        'ln2_b': nrm(ks[27], (DEPTH, D_MODEL), 0.01),
        'w_up': nrm(ks[28], (DEPTH, D_MODEL, D_FF), D_MODEL ** -0.5),
        'w_down': nrm(ks[29], (DEPTH, D_FF, D_MODEL), BETA * D_FF ** -0.5),
    }


def reference(x_prompt, x_sample, state_shift, state_wkv, state_ret, state_conv, w_in_ab, mu_a, w0, w2, a0, a2,
              g2, k_k, k_a, r_k, lnx_g, lnx_b, gn_g, gn_b, w_out_ab, w_in_conv, conv_w, w_out_conv,
              ln1_g, ln1_b, ln2_g, ln2_b, w_up, w_down):
    params = (w_in_ab, mu_a, w0, w2, a0, a2, g2, k_k, k_a, r_k, lnx_g, lnx_b, gn_g, gn_b, w_out_ab,
              w_in_conv, conv_w, w_out_conv, ln1_g, ln1_b, ln2_g, ln2_b, w_up, w_down)
    Bp, Tp, _ = x_prompt.shape
    dt = state_wkv.dtype
    z_shift = jnp.zeros((N_AB, Bp, A_PROJ), dt)
    z_wkv = jnp.zeros((N_AB, Bp, A_HEADS, A_HEAD_DIM, A_HEAD_DIM), dt)
    z_ret = jnp.zeros((N_AB, Bp, B_HEADS, B_HEAD_DIM, B_HEAD_DIM), dt)
    z_conv = jnp.zeros((N_CONV, Bp, CONV_W - 1, D_MODEL), dt)
    pos_p = jnp.arange(Tp, dtype=jnp.int32)
    y_prompt, p_shift, p_wkv, p_ret, p_conv = trunk(x_prompt, z_shift, z_wkv, z_ret, z_conv, pos_p, *params)
    pos_s = PAST_LEN + jnp.arange(x_sample.shape[1], dtype=jnp.int32)
    y_sample, s_shift, s_wkv, s_ret, s_conv = trunk(x_sample, state_shift, state_wkv, state_ret, state_conv,
                                                    pos_s, *params)
    return (y_prompt, y_sample, p_shift, p_wkv, p_ret, p_conv, s_shift, s_wkv, s_ret, s_conv)
```

```cpp
#include <hip/hip_runtime.h>
#include <hip/hip_cooperative_groups.h>
#include <cstdio>
#include <cmath>
namespace cg = cooperative_groups;

#define LAS __attribute__((address_space(3)))
typedef unsigned short bf16_t;
typedef short bf16x8 __attribute__((ext_vector_type(8)));
typedef float f32x4 __attribute__((ext_vector_type(4)));
typedef unsigned u32x4 __attribute__((ext_vector_type(4)));
typedef unsigned u32x2 __attribute__((ext_vector_type(2)));

constexpr int DM = 1024, MP = 16384, MS = 1024, MT = MP + MS;
constexpr int TP = 2048, TS = 8, NBP = 8, NBS = 128;
constexpr int APROJ = 1792, NPROJ = 3840, DFF = 4096, NCONV = 3072;
constexpr float ALPHA = 1.4142135623730951f;
constexpr int LDS_BYTES = 155648;
constexpr int NTHREADS = 512;

constexpr size_t WS_WIN = 0;
constexpr size_t WS_WOUT = WS_WIN + (size_t)NPROJ * DM * 2;
constexpr size_t WS_WCIN = WS_WOUT + (size_t)DM * DM * 2;
constexpr size_t WS_WCOUT = WS_WCIN + (size_t)NCONV * DM * 2;
constexpr size_t WS_WUP0 = WS_WCOUT + (size_t)DM * DM * 2;
constexpr size_t WS_WUP1 = WS_WUP0 + (size_t)DFF * DM * 2;
constexpr size_t WS_WDN0 = WS_WUP1 + (size_t)DFF * DM * 2;
constexpr size_t WS_WDN1 = WS_WDN0 + (size_t)DFF * DM * 2;
constexpr size_t WS_ACT = WS_WDN1 + (size_t)DFF * DM * 2;
constexpr size_t WS_BIG = WS_ACT + (size_t)MT * DM * 2;
constexpr size_t WS_ROPE = WS_BIG + (size_t)MT * DFF * 2;
constexpr size_t WS_END = WS_ROPE + (size_t)2056 * 32 * 8;

constexpr size_t O_Y = 0;
constexpr size_t O_PSHIFT = (size_t)MT * DM;
constexpr size_t O_PWKV = O_PSHIFT + (size_t)NBP * APROJ;
constexpr size_t O_PRET = O_PWKV + (size_t)NBP * 8 * 4096;
constexpr size_t O_PCONV = O_PRET + (size_t)NBP * 8 * 4096;
constexpr size_t O_SSHIFT = O_PCONV + (size_t)NBP * 2 * DM;
constexpr size_t O_SWKV = O_SSHIFT + (size_t)NBS * APROJ;
constexpr size_t O_SRET = O_SWKV + (size_t)NBS * 8 * 4096;
constexpr size_t O_SCONV = O_SRET + (size_t)NBS * 8 * 4096;

struct Params { const float* in[30]; float* out; unsigned char* ws; int ph_lo, ph_hi; double inv_freq[32]; };

__device__ __forceinline__ float bf2f(bf16_t b) { return __uint_as_float(((unsigned)b) << 16); }
__device__ __forceinline__ unsigned cvt_pk_bf16(float lo, float hi) { unsigned r; asm volatile("v_cvt_pk_bf16_f32 %0, %1, %2" : "=v"(r) : "v"(lo), "v"(hi)); return r; }
__device__ __forceinline__ float wave_sum(float v) {
#pragma unroll
    for (int o = 32; o >= 1; o >>= 1) v += __shfl_xor(v, o);
    return v;
}

namespace pg8 {
constexpr int BM = 256, BK = 64, HALF = 128, HTB = HALF * BK * 2, STAGE_BYTES = 8 * HTB, NXCD = 8, WGM = 8;
__device__ __forceinline__ int lds_byte(int r, int c) { const int st = (r >> 4) * 2 + (c >> 5), rr = r & 15, cc = c & 31, ob = rr * 64 + cc * 2; return st * 1024 + (ob ^ (((ob >> 9) & 1) << 5)); }
__device__ __forceinline__ void stage_rc(int b, int& R, int& C) { const int st = b / 1024, sb = b % 1024, swz = sb ^ (((sb >> 9) & 1) << 5); R = (st >> 1) * 16 + swz / 64; C = (st & 1) * 32 + (swz % 64) / 2; }
__device__ __forceinline__ int perm32(int rho) { const int n = rho >> 4, i = rho & 15; return 8 * (i >> 2) + 4 * n + (i & 3); }
struct Unit { int pm, pn; };
struct Gemm { const bf16_t* A; const bf16_t* Bt; int M, N, K; };
struct StaticOrder {
    int nM, nN, nwg, G, c;
    __device__ void init(int M, int N, int G_, int c_) { nM = M / BM; nN = N / BM; nwg = nM * nN; G = G_; c = c_; }
    __device__ bool next(int i, Unit& u) const {
        const long L = (long)i * G + c; if (L >= nwg) return false;
        int wgid = (int)L; { const int q = nwg / NXCD, r = nwg % NXCD, xcd = wgid % NXCD, off = wgid / NXCD; wgid = (xcd < r ? xcd * (q + 1) : r * (q + 1) + (xcd - r) * q) + off; }
        const int nig = WGM * nN, gid = wgid / nig, fm = gid * WGM, gsz = (nM - fm) < WGM ? (nM - fm) : WGM;
        u.pm = fm + ((wgid % nig) % gsz); u.pn = (wgid % nig) / gsz; return true;
    }
};

struct Epi {
    int mode; bf16_t* O; int ldc; const float* xlo; const float* xhi; float* Z;
    __device__ __forceinline__ void operator()(const f32x4 (&acc)[2][2][4][2], const Unit& u, int wr, int wc, int fr, int fq) const {
        if (mode < 2) {
            const int row0 = u.pm * BM + wr * 64 + fr; const int col0 = u.pn * BM + wc * 32 + 8 * fq;
            const float lowclamp = mode == 1 ? 0.f : -3.0e38f;
#pragma unroll
            for (int ai = 0; ai < 2; ++ai)
#pragma unroll
                for (int m = 0; m < 4; ++m) { bf16_t* rowp = O + (size_t)(row0 + ai * HALF + m * 16) * ldc + col0;
#pragma unroll
                    for (int bj = 0; bj < 2; ++bj) { f32x4 v0 = acc[ai][bj][m][0], v1 = acc[ai][bj][m][1];
                        if (mode == 1) {
#pragma unroll
                            for (int j = 0; j < 4; ++j) { const float a = fmaxf(v0[j], lowclamp), b = fmaxf(v1[j], lowclamp); v0[j] = a * a; v1[j] = b * b; } }
                        u32x4 w; w.x = cvt_pk_bf16(v0[0], v0[1]); w.y = cvt_pk_bf16(v0[2], v0[3]); w.z = cvt_pk_bf16(v1[0], v1[1]); w.w = cvt_pk_bf16(v1[2], v1[3]);
                        *(u32x4*)(rowp + bj * HALF) = w; } }
        } else {
            const int row0 = u.pm * BM + wr * 64 + fr, col0 = u.pn * BM + wc * 32 + 4 * fq;
            const float* X = (u.pm * BM < MP) ? xlo : xhi;
#pragma unroll
            for (int ai = 0; ai < 2; ++ai)
#pragma unroll
                for (int m = 0; m < 4; ++m) { const size_t off = (size_t)(row0 + ai * HALF + m * 16) * DM + col0;
#pragma unroll
                    for (int bj = 0; bj < 2; ++bj)
#pragma unroll
                        for (int n = 0; n < 2; ++n) { const f32x4 x = *(const f32x4*)(X + off + bj * HALF + n * 16);
                            *(f32x4*)(Z + off + bj * HALF + n * 16) = x * ALPHA + acc[ai][bj][m][n]; }
                    asm volatile("" ::: "memory"); }
        }
    }
};

template <class Sched>
__device__ __forceinline__ void gemm_phase(LAS unsigned char* lds, const Gemm g, const Sched& S, const Epi& E, const int tid) {
    const bool PERM = E.mode < 2;
    const int wid = __builtin_amdgcn_readfirstlane(tid >> 6), lane = tid & 63, wr = wid >> 2, wc = wid & 3, fr = lane & 15, fq = lane >> 4;
    const int K = g.K, nt = K / BK;
    unsigned voffA[2], voffB[2];
#pragma unroll
    for (int i = 0; i < 2; ++i) { int R, C; stage_rc(tid * 16 + i * 8192, R, C); const int Rb = PERM ? ((R & ~31) + perm32(R & 31)) : R;
        voffA[i] = (unsigned)(R * K + C) * 2u; voffB[i] = (unsigned)(Rb * K + C) * 2u; }
    const size_t kstep = (size_t)(BK * 2);
    const size_t hstep = (size_t)HALF * K * 2;
    const size_t tstep = 2 * hstep;
    const unsigned ldsw = (unsigned)wid * 1024u;
    const int aoff = lds_byte(wr * 64 + fr, fq * 8), boff = lds_byte(wc * 32 + fr, fq * 8);
#define PG8_SA(b, h) (((b) * 2 + (h)) * HTB)
#define PG8_SB(b, h) ((4 + (b) * 2 + (h)) * HTB)
#define PG8_STAGE(bufoff, gbase, voff) do { _Pragma("unroll") for (int _i = 0; _i < 2; ++_i) \
        __builtin_amdgcn_global_load_lds((const unsigned*)((const char*)(gbase) + (voff)[_i]), (LAS unsigned*)(lds + (bufoff) + ldsw + _i * 8192), 16, 0, 0); } while (0)
#define PG8_LDA(dst, b, h) do { _Pragma("unroll") for (int m = 0; m < 4; ++m) _Pragma("unroll") for (int k = 0; k < 2; ++k) dst[m][k] = *(const LAS bf16x8*)(lds + PG8_SA(b, h) + aoff + m * 2048 + k * 1024); } while (0)
#define PG8_LDB(dst, b, h) do { _Pragma("unroll") for (int n = 0; n < 2; ++n) _Pragma("unroll") for (int k = 0; k < 2; ++k) dst[n][k] = *(const LAS bf16x8*)(lds + PG8_SB(b, h) + boff + n * 2048 + k * 1024); } while (0)
#define PG8_MMA(ai, bj, At, Bt) do { __builtin_amdgcn_s_setprio(1); _Pragma("unroll") for (int m = 0; m < 4; ++m) _Pragma("unroll") for (int n = 0; n < 2; ++n) _Pragma("unroll") for (int k = 0; k < 2; ++k) \
        acc[ai][bj][m][n] = __builtin_amdgcn_mfma_f32_16x16x32_bf16(Bt[n][k], At[m][k], acc[ai][bj][m][n], 0, 0, 0); __builtin_amdgcn_s_setprio(0); } while (0)
#define PG8_WAIT_V(n) asm volatile("s_waitcnt vmcnt(" #n ")" ::: "memory")
#define PG8_WAIT_L(n) asm volatile("s_waitcnt lgkmcnt(" #n ")" ::: "memory")
#define PG8_BAR __builtin_amdgcn_s_barrier()
#define PG8_SCHED __builtin_amdgcn_sched_barrier(0)
    Unit cur, nxt; int ui = 0;
    if (!S.next(0, cur)) return;
    f32x4 acc[2][2][4][2];
#pragma unroll
    for (int a = 0; a < 2; ++a)
#pragma unroll
        for (int b = 0; b < 2; ++b)
#pragma unroll
            for (int m = 0; m < 4; ++m)
#pragma unroll
                for (int n = 0; n < 2; ++n) acc[a][b][m][n] = (f32x4){0.f, 0.f, 0.f, 0.f};
    bf16x8 At[4][2], B0[2][2], B1[2][2];
    const char* cA = (const char*)g.A + (size_t)cur.pm * tstep; const char* cB = (const char*)g.Bt + (size_t)cur.pn * tstep;
    PG8_STAGE(PG8_SB(0, 0), cB, voffB); PG8_STAGE(PG8_SA(0, 0), cA, voffA); PG8_STAGE(PG8_SB(0, 1), cB + hstep, voffB); PG8_STAGE(PG8_SA(0, 1), cA + hstep, voffA);
    if (wr == 1) PG8_BAR;
    PG8_WAIT_V(4); PG8_BAR;
    PG8_STAGE(PG8_SB(1, 0), cB + kstep, voffB); PG8_STAGE(PG8_SA(1, 0), cA + kstep, voffA); PG8_STAGE(PG8_SB(1, 1), cB + hstep + kstep, voffB);
    PG8_WAIT_V(6); PG8_BAR;
    for (;;) {
        const bool has_next = S.next(ui + 1, nxt);
        const char* nA = has_next ? (const char*)g.A + (size_t)nxt.pm * tstep : cA; const char* nB = has_next ? (const char*)g.Bt + (size_t)nxt.pn * tstep : cB;
        for (int t = 0; t < nt; t += 2) {
            const bool last = (t == nt - 2);
            const char* a1 = cA + (size_t)(t + 1) * kstep;
            const char* a2 = last ? nA : cA + (size_t)(t + 2) * kstep; const char* b2 = last ? nB : cB + (size_t)(t + 2) * kstep;
            const char* a3 = a2 + kstep; const char* b3 = b2 + kstep;
            PG8_LDB(B0, 0, 0); PG8_SCHED; PG8_LDA(At, 0, 0); PG8_STAGE(PG8_SA(1, 1), a1 + hstep, voffA);
            PG8_WAIT_L(8); PG8_BAR; PG8_WAIT_L(0); PG8_MMA(0, 0, At, B0); PG8_BAR; PG8_SCHED;
            PG8_LDB(B1, 0, 1); PG8_STAGE(PG8_SB(0, 0), b2, voffB);
            PG8_BAR; PG8_WAIT_L(0); PG8_MMA(0, 1, At, B1); PG8_BAR;
            PG8_LDA(At, 0, 1); PG8_STAGE(PG8_SA(0, 0), a2, voffA);
            PG8_BAR; PG8_WAIT_L(0); PG8_MMA(1, 0, At, B0); PG8_BAR; PG8_SCHED;
            PG8_STAGE(PG8_SB(0, 1), b2 + hstep, voffB);
            PG8_WAIT_V(6); PG8_BAR; PG8_MMA(1, 1, At, B1); PG8_BAR;
            PG8_LDB(B0, 1, 0); PG8_SCHED; PG8_LDA(At, 1, 0); PG8_STAGE(PG8_SA(0, 1), a2 + hstep, voffA);
            PG8_WAIT_L(8); PG8_BAR; PG8_WAIT_L(0); PG8_MMA(0, 0, At, B0); PG8_BAR; PG8_SCHED;
            PG8_LDB(B1, 1, 1); PG8_STAGE(PG8_SB(1, 0), b3, voffB);
            PG8_BAR; PG8_WAIT_L(0); PG8_MMA(0, 1, At, B1); PG8_BAR;
            PG8_LDA(At, 1, 1); PG8_STAGE(PG8_SA(1, 0), a3, voffA);
            PG8_BAR; PG8_WAIT_L(0); PG8_MMA(1, 0, At, B0); PG8_BAR; PG8_SCHED;
            PG8_STAGE(PG8_SB(1, 1), b3 + hstep, voffB);
            PG8_WAIT_V(6); PG8_BAR; PG8_MMA(1, 1, At, B1); PG8_BAR;
        }
        E(acc, cur, wr, wc, fr, fq);
        if (!has_next) break;
#pragma unroll
        for (int a = 0; a < 2; ++a)
#pragma unroll
            for (int b = 0; b < 2; ++b)
#pragma unroll
                for (int m = 0; m < 4; ++m)
#pragma unroll
                    for (int n = 0; n < 2; ++n) acc[a][b][m][n] = (f32x4){0.f, 0.f, 0.f, 0.f};
        cur = nxt; cA = nA; cB = nB; ++ui;
    }
    PG8_WAIT_V(0);
    if (wr == 0) PG8_BAR;
    PG8_BAR;
#undef PG8_SA
#undef PG8_SB
#undef PG8_STAGE
#undef PG8_LDA
#undef PG8_LDB
#undef PG8_MMA
#undef PG8_WAIT_V
#undef PG8_WAIT_L
#undef PG8_BAR
#undef PG8_SCHED
}
}

__device__ __forceinline__ void phase_convert(const Params& p, float* L, const int tid, const int bid, const int G) {
    for (int tI = bid; tI < 6336; tI += G) {
        int j = tI; const float* W; bf16_t* Wt; int K, N;
        if (j < 960) { W = p.in[6]; Wt = (bf16_t*)(p.ws + WS_WIN); K = DM; N = NPROJ; }
        else if ((j -= 960) < 256) { W = p.in[20]; Wt = (bf16_t*)(p.ws + WS_WOUT); K = DM; N = DM; }
        else if ((j -= 256) < 768) { W = p.in[21]; Wt = (bf16_t*)(p.ws + WS_WCIN); K = DM; N = NCONV; }
        else if ((j -= 768) < 256) { W = p.in[23]; Wt = (bf16_t*)(p.ws + WS_WCOUT); K = DM; N = DM; }
        else if ((j -= 256) < 1024) { W = p.in[28]; Wt = (bf16_t*)(p.ws + WS_WUP0); K = DM; N = DFF; }
        else if ((j -= 1024) < 1024) { W = p.in[28] + (size_t)DM * DFF; Wt = (bf16_t*)(p.ws + WS_WUP1); K = DM; N = DFF; }
        else if ((j -= 1024) < 1024) { W = p.in[29]; Wt = (bf16_t*)(p.ws + WS_WDN0); K = DFF; N = DM; }
        else { j -= 1024; W = p.in[29] + (size_t)DM * DFF; Wt = (bf16_t*)(p.ws + WS_WDN1); K = DFF; N = DM; }
        const int tn = N / 64, k0 = (j / tn) * 64, n0 = (j % tn) * 64;
#pragma unroll
        for (int i = 0; i < 2; ++i) { const int e = tid + i * 512, r = e >> 4, c4 = e & 15;
            const float4 v = *(const float4*)(W + (size_t)(k0 + r) * N + n0 + c4 * 4);
            float* d = L + r * 65 + c4 * 4; d[0] = v.x; d[1] = v.y; d[2] = v.z; d[3] = v.w; }
        __syncthreads();
        { const int n = tid >> 3, k8 = tid & 7; float f[8];
#pragma unroll
          for (int q = 0; q < 8; ++q) f[q] = L[(k8 * 8 + q) * 65 + n];
          u32x4 w; w.x = cvt_pk_bf16(f[0], f[1]); w.y = cvt_pk_bf16(f[2], f[3]); w.z = cvt_pk_bf16(f[4], f[5]); w.w = cvt_pk_bf16(f[6], f[7]);
          *(u32x4*)(Wt + (size_t)(n0 + n) * K + k0 + k8 * 8) = w; }
        __syncthreads();
    }
    { bf16_t* xb = (bf16_t*)(p.ws + WS_ACT);
      const size_t n8 = (size_t)MT * DM / 8, np8 = (size_t)MP * DM / 8;
      for (size_t i = (size_t)bid * NTHREADS + tid; i < n8; i += (size_t)G * NTHREADS) {
          const float* src = (i < np8) ? p.in[0] + i * 8 : p.in[1] + (i - np8) * 8;
          const float4 a = *(const float4*)src, b = *(const float4*)(src + 4);
          u32x4 w; w.x = cvt_pk_bf16(a.x, a.y); w.y = cvt_pk_bf16(a.z, a.w); w.z = cvt_pk_bf16(b.x, b.y); w.w = cvt_pk_bf16(b.z, b.w);
          *(u32x4*)(xb + i * 8) = w; } }
    { float2* rope = (float2*)(p.ws + WS_ROPE);
      for (int i = bid * NTHREADS + tid; i < 2056 * 32; i += G * NTHREADS) {
          const int pidx = i >> 5, f = i & 31; const double pos = (double)(pidx < 2048 ? pidx : 16384 + (pidx - 2048));
          double rev = pos * p.inv_freq[f] * 0.15915494309189535; rev -= rint(rev);
          const float fr = (float)rev;
          rope[i] = make_float2(__builtin_amdgcn_cosf(fr), __builtin_amdgcn_sinf(fr)); } }
}

constexpr int TCH = 32;
__device__ __forceinline__ void phase_mixer(const Params& p, float* L, const int tid, const int bid, const int G) {
    const int lane = tid & 63, wave = tid >> 6;
    const bf16_t* proj = (const bf16_t*)(p.ws + WS_BIG);
    bf16_t* ycat = (bf16_t*)(p.ws + WS_ACT);
    const float2* rope = (const float2*)(p.ws + WS_ROPE);
    float* lora = L;
    float* sc_r = L + 8192; float* sc_w = sc_r + 2048; float* sc_k = sc_w + 2048; float* sc_v = sc_k + 2048; float* sc_a = sc_v + 2048; float* sc_b = sc_a + 2048;
    float* rt_q = sc_b + 2048; float* rt_k = rt_q + 2048; float* rt_v = rt_k + 2048;
    float* o_w = rt_v + 2048; float* o_r = o_w + 2048;
    float* st_l = o_r + 2048 + (wave & 1) * 4096 + lane;
    const float* mu = p.in[7];
    int it, step;
    if (G > 64) { if (bid < 64) { it = bid; step = 1 << 20; } else { it = bid; step = G - 64; } }
    else { it = bid; step = G; }
    for (; it < 64 + NBS * 8; it += step) {
        const bool smp = it >= 64; const int s = smp ? it - 64 : it; const int b = s >> 3, h = s & 7;
        const int T = smp ? TS : TP; const int rowbase = smp ? MP + b * TS : b * TP; const int pbase = smp ? 2048 : 0;
        const int hc = h * 64, c = lane, tg = wave;
        if (wave < 2) {
            int l2 = lane; asm volatile("" : "+v"(l2));
            if (smp && wave == 0) { const float* src = p.in[3] + (size_t)(b * 8 + h) * 4096 + (unsigned)l2 * 64u;
#pragma unroll 8
                for (int k = 0; k < 64; ++k) st_l[k * 64] = src[k]; }
            else if (smp) { const float* src = p.in[4] + (size_t)(b * 8 + h) * 4096 + (unsigned)l2;
#pragma unroll 8
                for (int k = 0; k < 64; ++k) st_l[k * 64] = src[k * 64]; }
            else {
#pragma unroll 8
                for (int k = 0; k < 64; ++k) st_l[k * 64] = 0.f; }
        }
        const float* shift0 = p.in[2] + (size_t)b * APROJ;
        const unsigned hcc = (unsigned)(hc + c);
        const float gamma = 1.0f - exp2f(-5.0f - (float)h);
        for (int t0 = 0; t0 < T; t0 += TCH) {
            const int tc = (T - t0) < TCH ? (T - t0) : TCH;
            for (int idx = tid; idx < tc * 256; idx += NTHREADS) { const int t = idx >> 8, j = idx & 255; const unsigned col = 1536u + (unsigned)j; const unsigned ro = (unsigned)(rowbase + t0 + t) * (unsigned)NPROJ;
                const float pc = bf2f(proj[ro + col]);
                const float pp = (t0 + t == 0) ? (smp ? shift0[col] : 0.f) : bf2f(proj[ro - (unsigned)NPROJ + col]);
                const float m = pc + (pp - pc) * mu[col];
                lora[t * 256 + j] = j < 64 ? tanhf(m) : (j < 128 ? m : 1.0f / (1.0f + __expf(-m))); }
            float mr[4], mk[4], mv[4], qg[4];
            { const float mu_r = mu[hcc], mu_k = mu[512u + hcc], mu_v = mu[1024u + hcc];
#pragma unroll
            for (int i = 0; i < 4; ++i) { const int t = tg * 4 + i;
                mr[i] = 0.f; mk[i] = 0.f; mv[i] = 0.f; qg[i] = 0.f;
                if (t < tc) { const unsigned ro = (unsigned)(rowbase + t0 + t) * (unsigned)NPROJ; const unsigned rp = ro - (unsigned)NPROJ; const bool first = (t0 + t == 0);
                    { const float pc = bf2f(proj[ro + hcc]); const float pp = first ? (smp ? shift0[hcc] : 0.f) : bf2f(proj[rp + hcc]); mr[i] = pc + (pp - pc) * mu_r; }
                    { const float pc = bf2f(proj[ro + 512u + hcc]); const float pp = first ? (smp ? shift0[512u + hcc] : 0.f) : bf2f(proj[rp + 512u + hcc]); mk[i] = pc + (pp - pc) * mu_k; }
                    { const float pc = bf2f(proj[ro + 1024u + hcc]); const float pp = first ? (smp ? shift0[1024u + hcc] : 0.f) : bf2f(proj[rp + 1024u + hcc]); mv[i] = pc + (pp - pc) * mu_v; }
                    const float2 cs = rope[(unsigned)(pbase + t0 + t) * 32u + (unsigned)(c & 31)];
                    const float sgn = (c < 32) ? -1.f : 1.f;
                    const unsigned hco = (unsigned)(hc + (c ^ 32));
                    const float qs = bf2f(proj[ro + (unsigned)APROJ + hcc]), qo = bf2f(proj[ro + (unsigned)APROJ + hco]);
                    const float ks = bf2f(proj[ro + (unsigned)(APROJ + 512) + hcc]), ko = bf2f(proj[ro + (unsigned)(APROJ + 512) + hco]);
                    rt_q[t * 64 + c] = qs * cs.x + sgn * qo * cs.y;
                    rt_k[t * 64 + c] = (ks * cs.x + sgn * ko * cs.y) * 0.125f;
                    rt_v[t * 64 + c] = bf2f(proj[ro + (unsigned)(APROJ + 1024) + hcc]);
                    qg[i] = bf2f(proj[ro + (unsigned)(APROJ + 1536) + hcc]); } } }
            __syncthreads();
            float gv[4], bonus[4];
            { float aw[4], aa[4], ag[4];
              const float kkc = p.in[13][hcc], kac = p.in[14][hcc], rkc = p.in[15][hcc], w0c = p.in[8][hcc], a0c = p.in[10][hcc];
              const float* w2 = p.in[9]; const float* a2 = p.in[11]; const float* g2 = p.in[12];
#pragma unroll
              for (int i = 0; i < 4; ++i) { aw[i] = w0c; aa[i] = a0c; ag[i] = 0.f; }
              const float* lr = lora + tg * 4 * 256;
#pragma unroll 4
              for (int j = 0; j < 64; ++j) { const float w2v = w2[(unsigned)j * 512u + hcc], a2v = a2[(unsigned)j * 512u + hcc];
#pragma unroll
                  for (int i = 0; i < 4; ++i) { aw[i] += lr[i * 256 + j] * w2v; aa[i] += lr[i * 256 + 64 + j] * a2v; } }
#pragma unroll 4
              for (int j = 0; j < 128; ++j) { const float g2v = g2[(unsigned)j * 512u + hcc];
#pragma unroll
                  for (int i = 0; i < 4; ++i) ag[i] += lr[i * 256 + 128 + j] * g2v; }
#pragma unroll
              for (int i = 0; i < 4; ++i) { const int t = tg * 4 + i;
                  const float z = -aw[i]; const float sp = fmaxf(z, 0.f) + log1pf(__expf(-fabsf(z)));
                  const float wl = -sp - 0.5f; const float decay = __expf(-__expf(wl));
                  const float a = 1.0f / (1.0f + __expf(-aa[i]));
                  const float kkr = mk[i] * kkc; const float ss = wave_sum(kkr * kkr); const float kk = kkr * rsqrtf(fmaxf(ss, 1e-24f));
                  const float kp = mk[i] * (1.0f + (a - 1.0f) * kac);
                  bonus[i] = wave_sum(mr[i] * kp * rkc); gv[i] = ag[i];
                  if (t < tc) { sc_r[t * 64 + c] = mr[i]; sc_w[t * 64 + c] = decay; sc_k[t * 64 + c] = kp; sc_v[t * 64 + c] = mv[i]; sc_a[t * 64 + c] = -kk; sc_b[t * 64 + c] = kk * a; } } }
            __syncthreads();
            if (wave < 2) {
              float St[64];
#pragma unroll
              for (int k = 0; k < 64; ++k) St[k] = st_l[k * 64];
              if (wave == 0) {
                for (int t = 0; t < tc; ++t) {
                    const float4* A4 = (const float4*)(sc_a + t * 64); const float4* W4 = (const float4*)(sc_w + t * 64); const float4* B4 = (const float4*)(sc_b + t * 64);
                    const float4* K4 = (const float4*)(sc_k + t * 64); const float4* R4 = (const float4*)(sc_r + t * 64);
                    float s0 = 0.f, s1 = 0.f, s2 = 0.f, s3 = 0.f;
#pragma unroll
                    for (int k4 = 0; k4 < 16; ++k4) { const float4 a = A4[k4]; s0 += St[4 * k4] * a.x; s1 += St[4 * k4 + 1] * a.y; s2 += St[4 * k4 + 2] * a.z; s3 += St[4 * k4 + 3] * a.w; if ((k4 & 7) == 7) asm volatile("" ::: "memory"); }
                    const float sa = (s0 + s1) + (s2 + s3); const float vv = sc_v[t * 64 + lane];
                    float o0 = 0.f, o1 = 0.f, o2 = 0.f, o3 = 0.f;
#pragma unroll
                    for (int k4 = 0; k4 < 16; ++k4) { const float4 w = W4[k4], bb = B4[k4], kq = K4[k4], r = R4[k4];
                        St[4 * k4] = St[4 * k4] * w.x + sa * bb.x + vv * kq.x; o0 += St[4 * k4] * r.x;
                        St[4 * k4 + 1] = St[4 * k4 + 1] * w.y + sa * bb.y + vv * kq.y; o1 += St[4 * k4 + 1] * r.y;
                        St[4 * k4 + 2] = St[4 * k4 + 2] * w.z + sa * bb.z + vv * kq.z; o2 += St[4 * k4 + 2] * r.z;
                        St[4 * k4 + 3] = St[4 * k4 + 3] * w.w + sa * bb.w + vv * kq.w; o3 += St[4 * k4 + 3] * r.w; if (k4 & 1) asm volatile("" ::: "memory"); }
                    o_w[t * 64 + lane] = (o0 + o1) + (o2 + o3);
                }
              } else {
                for (int t = 0; t < tc; ++t) {
                    const float4* K4 = (const float4*)(rt_k + t * 64); const float4* Q4 = (const float4*)(rt_q + t * 64);
                    const float vv = rt_v[t * 64 + lane];
                    float o0 = 0.f, o1 = 0.f, o2 = 0.f, o3 = 0.f;
#pragma unroll
                    for (int k4 = 0; k4 < 16; ++k4) { const float4 kq = K4[k4], q = Q4[k4];
                        St[4 * k4] = St[4 * k4] * gamma + kq.x * vv; o0 += St[4 * k4] * q.x;
                        St[4 * k4 + 1] = St[4 * k4 + 1] * gamma + kq.y * vv; o1 += St[4 * k4 + 1] * q.y;
                        St[4 * k4 + 2] = St[4 * k4 + 2] * gamma + kq.z * vv; o2 += St[4 * k4 + 2] * q.z;
                        St[4 * k4 + 3] = St[4 * k4 + 3] * gamma + kq.w * vv; o3 += St[4 * k4 + 3] * q.w; if ((k4 & 3) == 3) asm volatile("" ::: "memory"); }
                    o_r[t * 64 + lane] = (o0 + o1) + (o2 + o3);
                }
              }
#pragma unroll
              for (int k = 0; k < 64; ++k) st_l[k * 64] = St[k];
            }
            __syncthreads();
            { const float lxg = p.in[16][hcc], lxb = p.in[17][hcc], gng = p.in[18][hcc], gnb = p.in[19][hcc];
#pragma unroll
            for (int i = 0; i < 4; ++i) { const int t = tg * 4 + i;
                if (t < tc) { const unsigned row = (unsigned)(rowbase + t0 + t);
                    { const float o = o_w[t * 64 + c]; const float mean = wave_sum(o) * (1.f / 64.f); const float d = o - mean; const float var = wave_sum(d * d) * (1.f / 64.f);
                      const float yn = d * rsqrtf(var + 64e-5f) * lxg + lxb; const float ya = (yn + bonus[i] * mv[i]) * gv[i];
                      const float ya2 = __shfl_down(ya, 1); if (!(c & 1)) *(unsigned*)(ycat + (row * (unsigned)DM + hcc)) = cvt_pk_bf16(ya, ya2); }
                    { const float o = o_r[t * 64 + c]; const float mean = wave_sum(o) * (1.f / 64.f); const float d = o - mean; const float var = wave_sum(d * d) * (1.f / 64.f);
                      const float yn = d * rsqrtf(var + 1e-5f) * gng + gnb; const float gt = qg[i]; const float yb = gt / (1.0f + __expf(-gt)) * yn;
                      const float yb2 = __shfl_down(yb, 1); if (!(c & 1)) *(unsigned*)(ycat + (row * (unsigned)DM + 512u + hcc)) = cvt_pk_bf16(yb, yb2); } } } }
        }
        float* o_wkv = p.out + (smp ? O_SWKV : O_PWKV); float* o_ret = p.out + (smp ? O_SRET : O_PRET);
        int l3 = lane; asm volatile("" : "+v"(l3));
        if (wave == 0) { float* dst = o_wkv + (size_t)(b * 8 + h) * 4096 + (unsigned)l3 * 64u;
#pragma unroll 4
            for (int k4 = 0; k4 < 16; ++k4) *(float4*)(dst + 4 * k4) = make_float4(st_l[(4 * k4) * 64], st_l[(4 * k4 + 1) * 64], st_l[(4 * k4 + 2) * 64], st_l[(4 * k4 + 3) * 64]); }
        else if (wave == 1) { float* dst = o_ret + (size_t)(b * 8 + h) * 4096 + (unsigned)l3;
#pragma unroll 8
            for (int k = 0; k < 64; ++k) dst[k * 64] = st_l[k * 64]; }
        if (h == 0) { float* dst = p.out + (smp ? O_SSHIFT : O_PSHIFT) + (size_t)b * APROJ; const bf16_t* pr = proj + (size_t)(rowbase + T - 1) * NPROJ;
            for (int j = tid; j < APROJ; j += NTHREADS) dst[j] = bf2f(pr[j]); }
        __syncthreads();
    }
}

__device__ __forceinline__ void phase_ln(float* X, const float* g, const float* bta, bf16_t* xb, const int tid, const int bid, const int G) {
    const int lane = tid & 63, wave = tid >> 6;
    f32x4 gg[4], bb[4];
#pragma unroll
    for (int i = 0; i < 4; ++i) { gg[i] = *(const f32x4*)(g + i * 256 + lane * 4); bb[i] = *(const f32x4*)(bta + i * 256 + lane * 4); }
    for (int row = bid * 8 + wave; row < MT; row += G * 8) {
        float* xr = X + (size_t)row * DM; f32x4 v[4]; float s = 0.f;
#pragma unroll
        for (int i = 0; i < 4; ++i) { v[i] = *(const f32x4*)(xr + i * 256 + lane * 4); s += (v[i][0] + v[i][1]) + (v[i][2] + v[i][3]); }
        const float mean = wave_sum(s) * (1.f / 1024.f); float q = 0.f;
#pragma unroll
        for (int i = 0; i < 4; ++i) { v[i] -= mean; q += (v[i][0] * v[i][0] + v[i][1] * v[i][1]) + (v[i][2] * v[i][2] + v[i][3] * v[i][3]); }
        const float rstd = rsqrtf(wave_sum(q) * (1.f / 1024.f) + 1e-5f);
#pragma unroll
        for (int i = 0; i < 4; ++i) { const f32x4 y = v[i] * rstd * gg[i] + bb[i]; *(f32x4*)(xr + i * 256 + lane * 4) = y;
            u32x2 w; w.x = cvt_pk_bf16(y[0], y[1]); w.y = cvt_pk_bf16(y[2], y[3]); *(u32x2*)(xb + (size_t)row * DM + i * 256 + lane * 4) = w; }
    }
}

__device__ __forceinline__ void phase_conv(const Params& p, const int tid, const int bid, const int G) {
    const bf16_t* cp = (const bf16_t*)(p.ws + WS_BIG);
    bf16_t* vb = (bf16_t*)(p.ws + WS_ACT);
    const float* cw = p.in[22];
    const size_t total = (size_t)MT * 128;
    for (size_t idx = (size_t)bid * NTHREADS + tid; idx < total; idx += (size_t)G * NTHREADS) {
        const int row = (int)(idx >> 7), c0 = (int)(idx & 127) * 8;
        const bool smp = row >= MP; const int T = smp ? TS : TP; const int b = smp ? (row - MP) / TS : row / TP; const int t = smp ? (row - MP) % TS : row % TP;
        float u[3][8];
#pragma unroll
        for (int d = 0; d < 3; ++d) { const int tt = t - 2 + d;
            if (tt >= 0) { const bf16_t* r = cp + (size_t)(row - 2 + d) * NCONV; const u32x4 cgv = *(const u32x4*)(r + 1024 + c0), hv = *(const u32x4*)(r + 2048 + c0);
#pragma unroll
                for (int q = 0; q < 4; ++q) { u[d][2 * q] = __uint_as_float(cgv[q] << 16) * __uint_as_float(hv[q] << 16); u[d][2 * q + 1] = __uint_as_float(cgv[q] & 0xffff0000u) * __uint_as_float(hv[q] & 0xffff0000u); } }
            else { if (smp) { const float* sr = p.in[5] + ((size_t)b * 2 + (tt + 2)) * DM + c0;
#pragma unroll
                    for (int q = 0; q < 8; ++q) u[d][q] = sr[q]; }
                else {
#pragma unroll
                    for (int q = 0; q < 8; ++q) u[d][q] = 0.f; } } }
        const u32x4 bgv = *(const u32x4*)(cp + (size_t)row * NCONV + c0); float o[8];
#pragma unroll
        for (int q = 0; q < 8; ++q) { const float bg = (q & 1) ? __uint_as_float(bgv[q >> 1] & 0xffff0000u) : __uint_as_float(bgv[q >> 1] << 16);
            o[q] = bg * (u[0][q] * cw[c0 + q] + u[1][q] * cw[DM + c0 + q] + u[2][q] * cw[2 * DM + c0 + q]); }
        u32x4 w; w.x = cvt_pk_bf16(o[0], o[1]); w.y = cvt_pk_bf16(o[2], o[3]); w.z = cvt_pk_bf16(o[4], o[5]); w.w = cvt_pk_bf16(o[6], o[7]);
        *(u32x4*)(vb + (size_t)row * DM + c0) = w;
        if (t >= T - 2) { float* dst = p.out + (smp ? O_SCONV : O_PCONV) + ((size_t)b * 2 + (t - (T - 2))) * DM + c0;
#pragma unroll
            for (int q = 0; q < 8; ++q) dst[q] = u[2][q]; }
    }
}

__global__ void __launch_bounds__(NTHREADS, 2) mega(Params p_arg) {
    extern __shared__ __attribute__((aligned(16))) unsigned char lds[];
    cg::grid_group grid = cg::this_grid();
    LAS unsigned char* ldsl = (LAS unsigned char*)lds;
    float* L = (float*)lds;
    const int lo = p_arg.ph_lo, hi = p_arg.ph_hi;
    for (int ph = lo; ph < hi; ++ph) {
        int tid = threadIdx.x, bid = blockIdx.x, G = gridDim.x;
        asm volatile("" : "+v"(tid), "+s"(bid), "+s"(G));
        const __attribute__((address_space(4))) Params* pk = (const __attribute__((address_space(4))) Params*)__builtin_amdgcn_kernarg_segment_ptr();
        asm volatile("" : "+s"(pk));
        const Params& p = *(const Params*)pk;
        bf16_t* act = (bf16_t*)(p.ws + WS_ACT); bf16_t* big = (bf16_t*)(p.ws + WS_BIG);
        float* Y = p.out + O_Y;
        if (ph == 0) phase_convert(p, L, tid, bid, G);
        else if (ph == 2) phase_mixer(p, L, tid, bid, G);
        else if (ph == 9) phase_conv(p, tid, bid, G);
        else if (ph == 4 || ph == 7 || ph == 11 || ph == 14) {
            const int l = ph >= 11 ? 1 : 0; const bool second = (ph == 7 || ph == 14);
            phase_ln(Y, (second ? p.in[26] : p.in[24]) + l * DM, (second ? p.in[27] : p.in[25]) + l * DM, act, tid, bid, G);
        } else {
            pg8::Gemm g; pg8::Epi E; E.O = big; E.xlo = Y; E.xhi = Y; E.Z = Y; g.M = MT; g.A = act; g.K = DM;
            size_t wo;
            switch (ph) {
                case 1: wo = WS_WIN; g.N = NPROJ; E.mode = 0; break;
                case 3: wo = WS_WOUT; g.N = DM; E.mode = 2; E.xlo = p.in[0]; E.xhi = p.in[1] - (size_t)MP * DM; break;
                case 5: wo = WS_WUP0; g.N = DFF; E.mode = 1; break;
                case 6: wo = WS_WDN0; g.N = DM; g.K = DFF; g.A = big; E.mode = 2; break;
                case 8: wo = WS_WCIN; g.N = NCONV; E.mode = 0; break;
                case 10: wo = WS_WCOUT; g.N = DM; E.mode = 2; break;
                case 12: wo = WS_WUP1; g.N = DFF; E.mode = 1; break;
                default: wo = WS_WDN1; g.N = DM; g.K = DFF; g.A = big; E.mode = 2; break;
            }
            g.Bt = (const bf16_t*)(p.ws + wo); E.ldc = g.N;
            pg8::StaticOrder S; S.init(MT, g.N, G, bid);
            pg8::gemm_phase(ldsl, g, S, E, tid);
        }
        if (ph + 1 < hi) grid.sync();
    }
}
constexpr int NPHASES = 15;

#ifndef PER_PHASE_LAUNCH
#define PER_PHASE_LAUNCH 0
#endif

extern "C" void kernel_launch(void* const* d_in, const int* in_sizes, int n_in, void* d_out, int out_size, void* d_ws, size_t ws_size, hipStream_t stream) {
    static int grid = 0;
    if (grid == 0) {
        if (n_in != 30 || ws_size < WS_END) { fprintf(stderr, "kernel_launch: unexpected n_in %d or ws_size %zu (need %zu)\n", n_in, ws_size, (size_t)WS_END); grid = -1; return; }
        int dev = 0, cus = 0, per_cu = 0;
        hipGetDevice(&dev);
        hipDeviceGetAttribute(&cus, hipDeviceAttributeMultiprocessorCount, dev);
        if (hipFuncSetAttribute((const void*)mega, hipFuncAttributeMaxDynamicSharedMemorySize, LDS_BYTES) != hipSuccess) { fprintf(stderr, "kernel_launch: hipFuncSetAttribute failed\n"); grid = -1; return; }
        if (hipOccupancyMaxActiveBlocksPerMultiprocessor(&per_cu, (const void*)mega, NTHREADS, LDS_BYTES) != hipSuccess || per_cu < 1) { fprintf(stderr, "kernel_launch: occupancy query failed (%d)\n", per_cu); (void)hipGetLastError(); per_cu = 1; }
        if (per_cu > 1) per_cu = 1;
        grid = cus * per_cu;
    }
    if (grid < 0) return;
    Params p{};
    for (int i = 0; i < 30; ++i) p.in[i] = (const float*)d_in[i];
    p.out = (float*)d_out; p.ws = (unsigned char*)d_ws;
    for (int f = 0; f < 32; ++f) p.inv_freq[f] = pow(10000.0, -(double)f / 32.0);
#if PER_PHASE_LAUNCH
    for (int ph = 0; ph < NPHASES; ++ph) { p.ph_lo = ph; p.ph_hi = ph + 1; hipLaunchKernelGGL(mega, dim3(grid), dim3(NTHREADS), LDS_BYTES, stream, p); }
#else
    p.ph_lo = 0; p.ph_hi = NPHASES;
    void* args[] = {&p};
    hipError_t e = hipLaunchCooperativeKernel((const void*)mega, dim3(grid), dim3(NTHREADS), args, LDS_BYTES, stream);
    if (e != hipSuccess) fprintf(stderr, "cooperative launch failed: %s (grid %d)\n", hipGetErrorString(e), grid);
#endif
}
```

```cpp
#include <hip/hip_runtime.h>
#include <hip/hip_cooperative_groups.h>
#include <cstdio>
#include <cmath>
namespace cg = cooperative_groups;

#ifndef PROBE_MASK
#define PROBE_MASK 0
#endif
#define LAS __attribute__((address_space(3)))
typedef unsigned short bf16_t;
typedef short bf16x8 __attribute__((ext_vector_type(8)));
typedef float f32x4 __attribute__((ext_vector_type(4)));
typedef unsigned u32x4 __attribute__((ext_vector_type(4)));
typedef unsigned u32x2 __attribute__((ext_vector_type(2)));

constexpr int DM = 1024, MP = 16384, MS = 1024, MT = MP + MS;
constexpr int TP = 2048, TS = 8, NBP = 8, NBS = 128;
constexpr int APROJ = 1792, NPROJ = 3840, DFF = 4096, NCONV = 3072;
constexpr float ALPHA = 1.4142135623730951f;
constexpr int LDS_BYTES = 155648 + 256;
constexpr int NTHREADS = 512;

constexpr size_t WS_WIN = 0;
constexpr size_t WS_WOUT = WS_WIN + (size_t)NPROJ * DM * 2;
constexpr size_t WS_WCIN = WS_WOUT + (size_t)DM * DM * 2;
constexpr size_t WS_WCOUT = WS_WCIN + (size_t)NCONV * DM * 2;
constexpr size_t WS_WUP0 = WS_WCOUT + (size_t)DM * DM * 2;
constexpr size_t WS_WUP1 = WS_WUP0 + (size_t)DFF * DM * 2;
constexpr size_t WS_WDN0 = WS_WUP1 + (size_t)DFF * DM * 2;
constexpr size_t WS_WDN1 = WS_WDN0 + (size_t)DFF * DM * 2;
constexpr size_t WS_ACT = WS_WDN1 + (size_t)DFF * DM * 2;
constexpr size_t WS_BIG = WS_ACT + (size_t)MT * DM * 2;
constexpr size_t WS_ROPE = WS_BIG + (size_t)MT * DFF * 2;
constexpr size_t WS_END = WS_ROPE + (size_t)2056 * 32 * 8;

constexpr size_t WS_R3 = (WS_END + 255) & ~(size_t)255;
constexpr size_t WS_STAMP = WS_R3 + (size_t)2048 * 8192;
constexpr size_t WS_W2T = WS_STAMP + 256;
constexpr size_t WS_A2T = WS_W2T + 512 * 64 * 2;
constexpr size_t WS_G2T = WS_A2T + 512 * 64 * 2;
constexpr size_t WS_BAR = WS_G2T + 512 * 128 * 2;
constexpr size_t WS_END2 = WS_BAR + 3456 * 4;

constexpr size_t O_Y = 0;
constexpr size_t O_PSHIFT = (size_t)MT * DM;
constexpr size_t O_PWKV = O_PSHIFT + (size_t)NBP * APROJ;
constexpr size_t O_PRET = O_PWKV + (size_t)NBP * 8 * 4096;
constexpr size_t O_PCONV = O_PRET + (size_t)NBP * 8 * 4096;
constexpr size_t O_SSHIFT = O_PCONV + (size_t)NBP * 2 * DM;
constexpr size_t O_SWKV = O_SSHIFT + (size_t)NBS * APROJ;
constexpr size_t O_SRET = O_SWKV + (size_t)NBS * 8 * 4096;
constexpr size_t O_SCONV = O_SRET + (size_t)NBS * 8 * 4096;

struct Params { const float* in[30]; float* out; unsigned char* ws; int ph_lo, ph_hi; double inv_freq[32]; };

__device__ __forceinline__ float bf2f(bf16_t b) { return __uint_as_float(((unsigned)b) << 16); }
typedef __bf16 bf16x2_t __attribute__((ext_vector_type(2)));
typedef float f32x2_t __attribute__((ext_vector_type(2)));
__device__ __forceinline__ unsigned cvt_pk_bf16(float lo, float hi) { const f32x2_t v = {lo, hi}; const bf16x2_t b = __builtin_convertvector(v, bf16x2_t); return __builtin_bit_cast(unsigned, b); }
__device__ __forceinline__ float wave_sum(float v) {
#pragma unroll
    for (int o = 32; o >= 1; o >>= 1) v += __shfl_xor(v, o);
    return v;
}

namespace pg8 {
constexpr int BM = 256, BK = 64, HALF = 128, HTB = HALF * BK * 2, STAGE_BYTES = 8 * HTB, NXCD = 8, WGM = 8;
__device__ __forceinline__ int lds_byte(int r, int c) { const int st = (r >> 4) * 2 + (c >> 5), rr = r & 15, cc = c & 31, ob = rr * 64 + cc * 2; return st * 1024 + (ob ^ (((ob >> 9) & 1) << 5)); }
__device__ __forceinline__ void stage_rc(int b, int& R, int& C) { const int st = b / 1024, sb = b % 1024, swz = sb ^ (((sb >> 9) & 1) << 5); R = (st >> 1) * 16 + swz / 64; C = (st & 1) * 32 + (swz % 64) / 2; }
__device__ __forceinline__ int perm32(int rho) { const int n = rho >> 4, i = rho & 15; return 8 * (i >> 2) + 4 * n + (i & 3); }
struct Unit { int pm, pn; };
struct Gemm { const bf16_t* A; const bf16_t* Bt; int M, N, K; };
struct StaticOrder {
    int nM, nN, nwg, G, c, lim;
    __device__ void init(int M, int N, int G_, int c_) { nM = M / BM; nN = N / BM; nwg = nM * nN; G = G_; c = c_; lim = nwg; }
    __device__ void map(int L, Unit& u) const {
        int wgid = L; { const int q = nwg / NXCD, r = nwg % NXCD, xcd = wgid % NXCD, off = wgid / NXCD; wgid = (xcd < r ? xcd * (q + 1) : r * (q + 1) + (xcd - r) * q) + off; }
        const int nig = WGM * nN, gid = wgid / nig, fm = gid * WGM, gsz = (nM - fm) < WGM ? (nM - fm) : WGM;
        u.pm = fm + ((wgid % nig) % gsz); u.pn = (wgid % nig) / gsz;
    }
    __device__ bool next(int i, Unit& u) const { const long L = (long)i * G + c; if (L >= lim) return false; map((int)L, u); return true; }
};

struct Epi {
    int mode; bf16_t* O; int ldc; const float* xlo; const float* xhi; float* Z;
    __device__ __forceinline__ void operator()(const f32x4 (&acc)[2][2][4][2], const Unit& u, int wr, int wc, int fr, int fq) const {
        if (mode < 2) {
            const int row0 = u.pm * BM + wr * 64 + fr; const int col0 = u.pn * BM + wc * 32 + 8 * fq;
            const float lowclamp = mode == 1 ? 0.f : -3.0e38f;
#pragma unroll
            for (int ai = 0; ai < 2; ++ai)
#pragma unroll
                for (int m = 0; m < 4; ++m) { bf16_t* rowp = O + (size_t)(row0 + ai * HALF + m * 16) * ldc + col0;
#pragma unroll
                    for (int bj = 0; bj < 2; ++bj) { f32x4 v0 = acc[ai][bj][m][0], v1 = acc[ai][bj][m][1];
                        if (mode == 1) {
#pragma unroll
                            for (int j = 0; j < 4; ++j) { const float a = fmaxf(v0[j], lowclamp), b = fmaxf(v1[j], lowclamp); v0[j] = a * a; v1[j] = b * b; } }
                        u32x4 w; w.x = cvt_pk_bf16(v0[0], v0[1]); w.y = cvt_pk_bf16(v0[2], v0[3]); w.z = cvt_pk_bf16(v1[0], v1[1]); w.w = cvt_pk_bf16(v1[2], v1[3]);
                        *(u32x4*)(rowp + bj * HALF) = w; } }
        } else {
            const int row0 = u.pm * BM + wr * 64 + fr, col0 = u.pn * BM + wc * 32 + 4 * fq;
            const float* X = (u.pm * BM < MP) ? xlo : xhi;
#pragma unroll
            for (int ai = 0; ai < 2; ++ai)
#pragma unroll
                for (int mp = 0; mp < 2; ++mp) {
                    f32x4 x[2][2][2];
#pragma unroll
                    for (int mm = 0; mm < 2; ++mm) { const size_t off = (size_t)(row0 + ai * HALF + (mp * 2 + mm) * 16) * DM + col0;
#pragma unroll
                        for (int bj = 0; bj < 2; ++bj)
#pragma unroll
                            for (int n = 0; n < 2; ++n) x[mm][bj][n] = *(const f32x4*)(X + off + bj * HALF + n * 16); }
#pragma unroll
                    for (int mm = 0; mm < 2; ++mm) { const int m = mp * 2 + mm; const size_t off = (size_t)(row0 + ai * HALF + m * 16) * DM + col0;
#pragma unroll
                        for (int bj = 0; bj < 2; ++bj)
#pragma unroll
                            for (int n = 0; n < 2; ++n) *(f32x4*)(Z + off + bj * HALF + n * 16) = x[mm][bj][n] * ALPHA + acc[ai][bj][m][n]; }
                    asm volatile("" ::: "memory"); }
        }
    }
};

template <class Sched>
__device__ __forceinline__ void gemm_phase(LAS unsigned char* lds, const Gemm g, const Sched& S, const Epi& E, const int tid) {
    const bool PERM = E.mode < 2;
    const int wid = __builtin_amdgcn_readfirstlane(tid >> 6), lane = tid & 63, wr = wid >> 2, wc = wid & 3, fr = lane & 15, fq = lane >> 4;
    const int K = g.K, nt = K / BK;
    unsigned voffA[2], voffB[2];
#pragma unroll
    for (int i = 0; i < 2; ++i) { int R, C; stage_rc(tid * 16 + i * 8192, R, C); const int Rb = PERM ? ((R & ~31) + perm32(R & 31)) : R;
        voffA[i] = (unsigned)(R * K + C) * 2u; voffB[i] = (unsigned)(Rb * K + C) * 2u; }
    const size_t kstep = (size_t)(BK * 2);
    const size_t hstep = (size_t)HALF * K * 2;
    const size_t tstep = 2 * hstep;
    const unsigned ldsw = (unsigned)wid * 1024u;
    const int aoff = lds_byte(wr * 64 + fr, fq * 8), boff = lds_byte(wc * 32 + fr, fq * 8);
#define PG8_SA(b, h) (((b) * 2 + (h)) * HTB)
#define PG8_SB(b, h) ((4 + (b) * 2 + (h)) * HTB)
#define PG8_STAGE(bufoff, gbase, voff) do { _Pragma("unroll") for (int _i = 0; _i < 2; ++_i) \
        __builtin_amdgcn_global_load_lds((const unsigned*)((const char*)(gbase) + (voff)[_i]), (LAS unsigned*)(lds + (bufoff) + ldsw + _i * 8192), 16, 0, 0); } while (0)
#define PG8_LDA(dst, b, h) do { _Pragma("unroll") for (int m = 0; m < 4; ++m) _Pragma("unroll") for (int k = 0; k < 2; ++k) dst[m][k] = *(const LAS bf16x8*)(lds + PG8_SA(b, h) + aoff + m * 2048 + k * 1024); } while (0)
#define PG8_LDB(dst, b, h) do { _Pragma("unroll") for (int n = 0; n < 2; ++n) _Pragma("unroll") for (int k = 0; k < 2; ++k) dst[n][k] = *(const LAS bf16x8*)(lds + PG8_SB(b, h) + boff + n * 2048 + k * 1024); } while (0)
#define PG8_MMA(ai, bj, At, Bt) do { __builtin_amdgcn_s_setprio(1); _Pragma("unroll") for (int m = 0; m < 4; ++m) _Pragma("unroll") for (int n = 0; n < 2; ++n) _Pragma("unroll") for (int k = 0; k < 2; ++k) \
        acc[ai][bj][m][n] = __builtin_amdgcn_mfma_f32_16x16x32_bf16(Bt[n][k], At[m][k], acc[ai][bj][m][n], 0, 0, 0); __builtin_amdgcn_s_setprio(0); } while (0)
#define PG8_WAIT_V(n) asm volatile("s_waitcnt vmcnt(" #n ")" ::: "memory")
#define PG8_WAIT_L(n) asm volatile("s_waitcnt lgkmcnt(" #n ")" ::: "memory")
#define PG8_BAR __builtin_amdgcn_s_barrier()
#define PG8_SCHED __builtin_amdgcn_sched_barrier(0)
    Unit cur, nxt; int ui = 0;
    if (!S.next(0, cur)) return;
    f32x4 acc[2][2][4][2];
#pragma unroll
    for (int a = 0; a < 2; ++a)
#pragma unroll
        for (int b = 0; b < 2; ++b)
#pragma unroll
            for (int m = 0; m < 4; ++m)
#pragma unroll
                for (int n = 0; n < 2; ++n) acc[a][b][m][n] = (f32x4){0.f, 0.f, 0.f, 0.f};
    bf16x8 At[4][2], B0[2][2], B1[2][2];
    const char* cA = (const char*)g.A + (size_t)cur.pm * tstep; const char* cB = (const char*)g.Bt + (size_t)cur.pn * tstep;
    PG8_STAGE(PG8_SB(0, 0), cB, voffB); PG8_STAGE(PG8_SA(0, 0), cA, voffA); PG8_STAGE(PG8_SB(0, 1), cB + hstep, voffB); PG8_STAGE(PG8_SA(0, 1), cA + hstep, voffA);
    if (wr == 1) PG8_BAR;
    PG8_WAIT_V(4); PG8_BAR;
    PG8_STAGE(PG8_SB(1, 0), cB + kstep, voffB); PG8_STAGE(PG8_SA(1, 0), cA + kstep, voffA); PG8_STAGE(PG8_SB(1, 1), cB + hstep + kstep, voffB);
    PG8_WAIT_V(6); PG8_BAR;
    for (;;) {
        const bool has_next = S.next(ui + 1, nxt);
        const char* nA = has_next ? (const char*)g.A + (size_t)nxt.pm * tstep : cA; const char* nB = has_next ? (const char*)g.Bt + (size_t)nxt.pn * tstep : cB;
        for (int t = 0; t < nt; t += 2) {
            const bool last = (t == nt - 2);
            const char* a1 = cA + (size_t)(t + 1) * kstep;
            const char* a2 = last ? nA : cA + (size_t)(t + 2) * kstep; const char* b2 = last ? nB : cB + (size_t)(t + 2) * kstep;
            const char* a3 = a2 + kstep; const char* b3 = b2 + kstep;
            PG8_LDB(B0, 0, 0); PG8_SCHED; PG8_LDA(At, 0, 0); PG8_STAGE(PG8_SA(1, 1), a1 + hstep, voffA);
            PG8_WAIT_L(8); PG8_BAR; PG8_WAIT_L(0); PG8_MMA(0, 0, At, B0); PG8_BAR; PG8_SCHED;
            PG8_LDB(B1, 0, 1); PG8_STAGE(PG8_SB(0, 0), b2, voffB);
            PG8_BAR; PG8_WAIT_L(0); PG8_MMA(0, 1, At, B1); PG8_BAR;
            PG8_LDA(At, 0, 1); PG8_STAGE(PG8_SA(0, 0), a2, voffA);
            PG8_BAR; PG8_WAIT_L(0); PG8_MMA(1, 0, At, B0); PG8_BAR; PG8_SCHED;
            PG8_STAGE(PG8_SB(0, 1), b2 + hstep, voffB);
            PG8_WAIT_V(6); PG8_BAR; PG8_MMA(1, 1, At, B1); PG8_BAR;
            PG8_LDB(B0, 1, 0); PG8_SCHED; PG8_LDA(At, 1, 0); PG8_STAGE(PG8_SA(0, 1), a2 + hstep, voffA);
            PG8_WAIT_L(8); PG8_BAR; PG8_WAIT_L(0); PG8_MMA(0, 0, At, B0); PG8_BAR; PG8_SCHED;
            PG8_LDB(B1, 1, 1); PG8_STAGE(PG8_SB(1, 0), b3, voffB);
            PG8_BAR; PG8_WAIT_L(0); PG8_MMA(0, 1, At, B1); PG8_BAR;
            PG8_LDA(At, 1, 1); PG8_STAGE(PG8_SA(1, 0), a3, voffA);
            PG8_BAR; PG8_WAIT_L(0); PG8_MMA(1, 0, At, B0); PG8_BAR; PG8_SCHED;
            PG8_STAGE(PG8_SB(1, 1), b3 + hstep, voffB);
            PG8_WAIT_V(6); PG8_BAR; PG8_MMA(1, 1, At, B1); PG8_BAR;
        }
        E(acc, cur, wr, wc, fr, fq);
        if (!has_next) break;
#pragma unroll
        for (int a = 0; a < 2; ++a)
#pragma unroll
            for (int b = 0; b < 2; ++b)
#pragma unroll
                for (int m = 0; m < 4; ++m)
#pragma unroll
                    for (int n = 0; n < 2; ++n) acc[a][b][m][n] = (f32x4){0.f, 0.f, 0.f, 0.f};
        cur = nxt; cA = nA; cB = nB; ++ui;
    }
    PG8_WAIT_V(0);
    if (wr == 0) PG8_BAR;
    PG8_BAR;
#undef PG8_SA
#undef PG8_SB
#undef PG8_STAGE
#undef PG8_LDA
#undef PG8_LDB
#undef PG8_MMA
#undef PG8_WAIT_V
#undef PG8_WAIT_L
#undef PG8_BAR
#undef PG8_SCHED
}
}

__device__ __forceinline__ void gemm64_resid(LAS unsigned char* lds, const bf16_t* A, const bf16_t* Bt, const int K, const int row0, const int col0, const float* X, float* Z, const int tid) {
    const int wave = tid >> 6, lane = tid & 63, fr = lane & 15, fq = lane >> 4;
    const int kper = K >> 3;
    f32x4 acc[4][4];
#pragma unroll
    for (int m = 0; m < 4; ++m)
#pragma unroll
        for (int n = 0; n < 4; ++n) acc[m][n] = (f32x4){0.f, 0.f, 0.f, 0.f};
    const bf16_t* Ap = A + (size_t)(row0 + fr) * K + wave * kper + fq * 8;
    const bf16_t* Bp = Bt + (size_t)(col0 + fr) * K + wave * kper + fq * 8;
    const size_t rs16 = (size_t)16 * K;
#pragma unroll 2
    for (int ks = 0; ks < (kper >> 5); ++ks) {
        bf16x8 a[4], b[4];
#pragma unroll
        for (int m = 0; m < 4; ++m) { a[m] = *(const bf16x8*)(Ap + m * rs16 + ks * 32); b[m] = *(const bf16x8*)(Bp + m * rs16 + ks * 32); }
#pragma unroll
        for (int m = 0; m < 4; ++m)
#pragma unroll
            for (int n = 0; n < 4; ++n) acc[m][n] = __builtin_amdgcn_mfma_f32_16x16x32_bf16(a[m], b[n], acc[m][n], 0, 0, 0);
    }
    LAS unsigned char* part = lds + wave * (64 * 272);
#pragma unroll
    for (int m = 0; m < 4; ++m)
#pragma unroll
        for (int n = 0; n < 4; ++n)
#pragma unroll
            for (int jj = 0; jj < 4; ++jj) *(LAS float*)(part + (m * 16 + fq * 4 + jj) * 272 + (n * 16 + fr) * 4) = acc[m][n][jj];
    __syncthreads();
    { const int r = tid >> 3, c8 = (tid & 7) * 8; f32x4 s0 = (f32x4){0.f, 0.f, 0.f, 0.f}, s1 = s0;
#pragma unroll
      for (int w = 0; w < 8; ++w) { s0 += *(const LAS f32x4*)(lds + w * (64 * 272) + r * 272 + c8 * 4); s1 += *(const LAS f32x4*)(lds + w * (64 * 272) + r * 272 + c8 * 4 + 16); }
      const size_t off = (size_t)(row0 + r) * DM + col0 + c8;
      const f32x4 x0 = *(const f32x4*)(X + off), x1 = *(const f32x4*)(X + off + 4);
      *(f32x4*)(Z + off) = x0 * ALPHA + s0; *(f32x4*)(Z + off + 4) = x1 * ALPHA + s1; }
    __syncthreads();
}

__device__ __forceinline__ void phase_convert(const Params& p, float* L, const int tid, const int bid, const int G, const int tile_lo, const int tile_hi, const bool misc) {
    for (int tB = tile_lo + bid * 4; tB < tile_hi; tB += G * 4) {
        float4 v[4][2]; bf16_t* wt[4]; int kk[4], kb[4], nb[4];
#pragma unroll
        for (int q = 0; q < 4; ++q) { const int tI = tB + q; wt[q] = nullptr; kk[q] = 0; kb[q] = 0; nb[q] = 0;
            if (tI < tile_hi) {
                int j = tI; const float* W; bf16_t* Wt; int K, N;
                if (j < 960) { W = p.in[6]; Wt = (bf16_t*)(p.ws + WS_WIN); K = DM; N = NPROJ; }
                else if ((j -= 960) < 256) { W = p.in[20]; Wt = (bf16_t*)(p.ws + WS_WOUT); K = DM; N = DM; }
                else if ((j -= 256) < 768) { W = p.in[21]; Wt = (bf16_t*)(p.ws + WS_WCIN); K = DM; N = NCONV; }
                else if ((j -= 768) < 256) { W = p.in[23]; Wt = (bf16_t*)(p.ws + WS_WCOUT); K = DM; N = DM; }
                else if ((j -= 256) < 1024) { W = p.in[28]; Wt = (bf16_t*)(p.ws + WS_WUP0); K = DM; N = DFF; }
                else if ((j -= 1024) < 1024) { W = p.in[28] + (size_t)DM * DFF; Wt = (bf16_t*)(p.ws + WS_WUP1); K = DM; N = DFF; }
                else if ((j -= 1024) < 1024) { W = p.in[29]; Wt = (bf16_t*)(p.ws + WS_WDN0); K = DFF; N = DM; }
                else { j -= 1024; W = p.in[29] + (size_t)DM * DFF; Wt = (bf16_t*)(p.ws + WS_WDN1); K = DFF; N = DM; }
                const int tn = N / 64, k0 = (j / tn) * 64, n0 = (j % tn) * 64;
                wt[q] = Wt; kk[q] = K; kb[q] = k0; nb[q] = n0;
#pragma unroll
                for (int i = 0; i < 2; ++i) { const int e = tid + i * 512, r = e >> 4, c4 = e & 15; v[q][i] = *(const float4*)(W + (size_t)(k0 + r) * N + n0 + c4 * 4); } } }
#pragma unroll
        for (int q = 0; q < 4; ++q) if (wt[q]) {
#pragma unroll
            for (int i = 0; i < 2; ++i) { const int e = tid + i * 512, r = e >> 4, c4 = e & 15; float* d = L + q * 4160 + r * 65 + c4 * 4; d[0] = v[q][i].x; d[1] = v[q][i].y; d[2] = v[q][i].z; d[3] = v[q][i].w; } }
        __syncthreads();
#pragma unroll
        for (int q = 0; q < 4; ++q) if (wt[q]) { const int n = tid >> 3, k8 = tid & 7; float f[8];
#pragma unroll
            for (int z = 0; z < 8; ++z) f[z] = L[q * 4160 + (k8 * 8 + z) * 65 + n];
            u32x4 w; w.x = cvt_pk_bf16(f[0], f[1]); w.y = cvt_pk_bf16(f[2], f[3]); w.z = cvt_pk_bf16(f[4], f[5]); w.w = cvt_pk_bf16(f[6], f[7]);
            *(u32x4*)(wt[q] + (size_t)(nb[q] + n) * kk[q] + kb[q] + k8 * 8) = w; }
        __syncthreads();
    }
    if (!misc) return;
    { bf16_t* xb = (bf16_t*)(p.ws + WS_ACT);
      const size_t n8 = (size_t)MT * DM / 8, np8 = (size_t)MP * DM / 8;
      for (size_t i = (size_t)bid * NTHREADS + tid; i < n8; i += (size_t)G * NTHREADS) {
          const float* src = (i < np8) ? p.in[0] + i * 8 : p.in[1] + (i - np8) * 8;
          const float4 a = *(const float4*)src, b = *(const float4*)(src + 4);
          u32x4 w; w.x = cvt_pk_bf16(a.x, a.y); w.y = cvt_pk_bf16(a.z, a.w); w.z = cvt_pk_bf16(b.x, b.y); w.w = cvt_pk_bf16(b.z, b.w);
          *(u32x4*)(xb + i * 8) = w; } }
    { bf16_t* w2t = (bf16_t*)(p.ws + WS_W2T); bf16_t* a2t = (bf16_t*)(p.ws + WS_A2T); bf16_t* g2t = (bf16_t*)(p.ws + WS_G2T);
      for (int i = bid * NTHREADS + tid; i < 512 * 256; i += G * NTHREADS) { const int c = i >> 8, j = i & 255;
          if (j < 64) w2t[c * 64 + j] = (bf16_t)(cvt_pk_bf16(p.in[9][j * 512 + c], 0.f) & 0xffffu);
          else if (j < 128) a2t[c * 64 + (j - 64)] = (bf16_t)(cvt_pk_bf16(p.in[11][(j - 64) * 512 + c], 0.f) & 0xffffu);
          else g2t[c * 128 + (j - 128)] = (bf16_t)(cvt_pk_bf16(p.in[12][(j - 128) * 512 + c], 0.f) & 0xffffu); } }
    { float2* rope = (float2*)(p.ws + WS_ROPE);
      for (int i = bid * NTHREADS + tid; i < 2056 * 32; i += G * NTHREADS) {
          const int pidx = i >> 5, f = i & 31; const double pos = (double)(pidx < 2048 ? pidx : 16384 + (pidx - 2048));
          double rev = pos * p.inv_freq[f] * 0.15915494309189535; rev -= rint(rev);
          const float fr = (float)rev;
          rope[i] = make_float2(__builtin_amdgcn_cosf(fr), __builtin_amdgcn_sinf(fr)); } }
}

__device__ __forceinline__ void st_lds_bf16(LAS unsigned char* base, int byteoff, float v) { *(LAS bf16_t*)(base + byteoff) = (bf16_t)(cvt_pk_bf16(v, 0.f) & 0xffffu); }
constexpr int LRS = 528;
constexpr int S_LIN = 30720, S_AW = S_LIN + 16 * 528, S_AA = S_AW + 2048, S_AG = S_AA + 2048;
__device__ __forceinline__ void phase_sample(const Params& p, LAS unsigned char* lds, const int tid_in, const int bid, const int G) {
    const bf16_t* proj = (const bf16_t*)(p.ws + WS_BIG);
    bf16_t* ycat = (bf16_t*)(p.ws + WS_ACT);
    const float2* rope = (const float2*)(p.ws + WS_ROPE);
    const float* mu = p.in[7];
    LAS float* lora = (LAS float*)lds;
    LAS float* sc_r = lora + 2048; LAS float* sc_w = sc_r + 512; LAS float* sc_k = sc_w + 512; LAS float* sc_v = sc_k + 512; LAS float* sc_a = sc_v + 512; LAS float* sc_b = sc_a + 512;
    LAS float* rt_q = sc_b + 512; LAS float* rt_k = rt_q + 512; LAS float* rt_v = rt_k + 512; LAS float* o_w = rt_v + 512; LAS float* o_r = o_w + 512;
    for (int it = bid; it < NBS * 8; it += G) {
        int tid = tid_in; asm volatile("" : "+v"(tid));
        const int lane = tid & 63, wave = tid >> 6, c = lane, t = wave;
        const int b = it >> 3, h = it & 7, hc = h * 64; const unsigned hcc = (unsigned)(hc + c);
        const int rowbase = MP + b * TS;
        const float* shift0 = p.in[2] + (size_t)b * APROJ;
#pragma unroll
        for (int q = 0; q < 4; ++q) { const int idx = tid + q * NTHREADS; const int tt = idx >> 8, j = idx & 255; const unsigned col = 1536u + (unsigned)j; const unsigned ro = (unsigned)(rowbase + tt) * (unsigned)NPROJ;
            const float pc = bf2f(proj[ro + col]); const float pp = (tt == 0) ? shift0[col] : bf2f(proj[ro - (unsigned)NPROJ + col]);
            const float m = pc + (pp - pc) * mu[col];
            st_lds_bf16(lds + S_LIN, tt * LRS + j * 2, j < 64 ? (1.0f - 2.0f / (__expf(2.0f * m) + 1.0f)) : (j < 128 ? m : 1.0f / (1.0f + __expf(-m)))); }
        float mr, mk, mv, qg;
        { const unsigned ro = (unsigned)(rowbase + t) * (unsigned)NPROJ; const unsigned rp = ro - (unsigned)NPROJ; const bool first = (t == 0);
          { const float pc = bf2f(proj[ro + hcc]); const float pp = first ? shift0[hcc] : bf2f(proj[rp + hcc]); mr = pc + (pp - pc) * mu[hcc]; }
          { const float pc = bf2f(proj[ro + 512u + hcc]); const float pp = first ? shift0[512u + hcc] : bf2f(proj[rp + 512u + hcc]); mk = pc + (pp - pc) * mu[512u + hcc]; }
          { const float pc = bf2f(proj[ro + 1024u + hcc]); const float pp = first ? shift0[1024u + hcc] : bf2f(proj[rp + 1024u + hcc]); mv = pc + (pp - pc) * mu[1024u + hcc]; }
          const float2 cs = rope[(unsigned)(2048 + t) * 32u + (unsigned)(c & 31)]; const float sgn = (c < 32) ? -1.f : 1.f; const unsigned hco = (unsigned)(hc + (c ^ 32));
          const float qs = bf2f(proj[ro + (unsigned)APROJ + hcc]), qo = bf2f(proj[ro + (unsigned)APROJ + hco]);
          const float ks = bf2f(proj[ro + (unsigned)(APROJ + 512) + hcc]), ko = bf2f(proj[ro + (unsigned)(APROJ + 512) + hco]);
          rt_q[t * 64 + c] = qs * cs.x + sgn * qo * cs.y; rt_k[t * 64 + c] = (ks * cs.x + sgn * ko * cs.y) * 0.125f;
          rt_v[t * 64 + c] = bf2f(proj[ro + (unsigned)(APROJ + 1024) + hcc]); qg = bf2f(proj[ro + (unsigned)(APROJ + 1536) + hcc]); }
        __syncthreads();
        float gv, bonus;
        { const int fr = lane & 15, fq = lane >> 4, nt = wave & 3; const unsigned cr = (unsigned)(hc + nt * 16 + fr);
          const bf16_t* w2t = (const bf16_t*)(p.ws + WS_W2T); const bf16_t* a2t = (const bf16_t*)(p.ws + WS_A2T); const bf16_t* g2t = (const bf16_t*)(p.ws + WS_G2T);
          if (wave < 4) { f32x4 dw = (f32x4){0.f, 0.f, 0.f, 0.f}, da = dw;
#pragma unroll
              for (int ks = 0; ks < 2; ++ks) { const bf16x8 x0 = *(const LAS bf16x8*)(lds + S_LIN + fr * LRS + (ks * 32 + fq * 8) * 2), x1 = *(const LAS bf16x8*)(lds + S_LIN + fr * LRS + (64 + ks * 32 + fq * 8) * 2);
                  dw = __builtin_amdgcn_mfma_f32_16x16x32_bf16(x0, *(const bf16x8*)(w2t + cr * 64u + (unsigned)(ks * 32 + fq * 8)), dw, 0, 0, 0);
                  da = __builtin_amdgcn_mfma_f32_16x16x32_bf16(x1, *(const bf16x8*)(a2t + cr * 64u + (unsigned)(ks * 32 + fq * 8)), da, 0, 0, 0); }
              if (fq < 2) {
#pragma unroll
                  for (int jj = 0; jj < 4; ++jj) { *(LAS float*)(lds + S_AW + (fq * 4 + jj) * 256 + (nt * 16 + fr) * 4) = dw[jj]; *(LAS float*)(lds + S_AA + (fq * 4 + jj) * 256 + (nt * 16 + fr) * 4) = da[jj]; } } }
          else { f32x4 dg = (f32x4){0.f, 0.f, 0.f, 0.f};
#pragma unroll
              for (int ks = 0; ks < 4; ++ks) { const bf16x8 x2 = *(const LAS bf16x8*)(lds + S_LIN + fr * LRS + (128 + ks * 32 + fq * 8) * 2);
                  dg = __builtin_amdgcn_mfma_f32_16x16x32_bf16(x2, *(const bf16x8*)(g2t + cr * 128u + (unsigned)(ks * 32 + fq * 8)), dg, 0, 0, 0); }
              if (fq < 2) {
#pragma unroll
                  for (int jj = 0; jj < 4; ++jj) *(LAS float*)(lds + S_AG + (fq * 4 + jj) * 256 + (nt * 16 + fr) * 4) = dg[jj]; } } }
        __syncthreads();
        { const float aw = p.in[8][hcc] + *(const LAS float*)(lds + S_AW + t * 256 + c * 4), aa = p.in[10][hcc] + *(const LAS float*)(lds + S_AA + t * 256 + c * 4), ag = *(const LAS float*)(lds + S_AG + t * 256 + c * 4);
          const float z = -aw; const float sp = fmaxf(z, 0.f) + log1pf(__expf(-fabsf(z)));
          const float decay = __expf(-__expf(-sp - 0.5f));
          const float al = 1.0f / (1.0f + __expf(-aa));
          const float kkr = mk * p.in[13][hcc]; const float ss = wave_sum(kkr * kkr); const float kk = kkr * rsqrtf(fmaxf(ss, 1e-24f));
          const float kp = mk * (1.0f + (al - 1.0f) * p.in[14][hcc]);
          bonus = wave_sum(mr * kp * p.in[15][hcc]); gv = ag;
          sc_r[t * 64 + c] = mr; sc_w[t * 64 + c] = decay; sc_k[t * 64 + c] = kp; sc_v[t * 64 + c] = mv; sc_a[t * 64 + c] = -kk; sc_b[t * 64 + c] = kk * al; }
        __syncthreads();
        { const int wv = wave & 3, rloc = lane >> 2, kc = lane & 3, row = wv * 16 + rloc;
          float St[16];
          if (wave < 4) {
              const float* src = p.in[3] + (size_t)(b * 8 + h) * 4096 + (unsigned)(row * 64 + kc * 16);
#pragma unroll
              for (int i4 = 0; i4 < 4; ++i4) { const f32x4 v4 = *(const f32x4*)(src + i4 * 4); St[i4 * 4] = v4[0]; St[i4 * 4 + 1] = v4[1]; St[i4 * 4 + 2] = v4[2]; St[i4 * 4 + 3] = v4[3]; }
              for (int s = 0; s < TS; ++s) {
                  const LAS f32x4* A4 = (const LAS f32x4*)(sc_a + s * 64 + kc * 16); const LAS f32x4* W4 = (const LAS f32x4*)(sc_w + s * 64 + kc * 16); const LAS f32x4* B4 = (const LAS f32x4*)(sc_b + s * 64 + kc * 16);
                  const LAS f32x4* K4 = (const LAS f32x4*)(sc_k + s * 64 + kc * 16); const LAS f32x4* R4 = (const LAS f32x4*)(sc_r + s * 64 + kc * 16);
                  float sa = 0.f;
#pragma unroll
                  for (int i4 = 0; i4 < 4; ++i4) { const f32x4 a = A4[i4]; sa += (St[i4 * 4] * a[0] + St[i4 * 4 + 1] * a[1]) + (St[i4 * 4 + 2] * a[2] + St[i4 * 4 + 3] * a[3]); }
                  sa += __shfl_xor(sa, 1); sa += __shfl_xor(sa, 2);
                  const float vv = sc_v[s * 64 + row]; float o = 0.f;
#pragma unroll
                  for (int i4 = 0; i4 < 4; ++i4) { const f32x4 w = W4[i4], bb = B4[i4], kq = K4[i4], r = R4[i4];
#pragma unroll
                      for (int q = 0; q < 4; ++q) { St[i4 * 4 + q] = St[i4 * 4 + q] * w[q] + sa * bb[q] + vv * kq[q]; o += St[i4 * 4 + q] * r[q]; } }
                  o += __shfl_xor(o, 1); o += __shfl_xor(o, 2);
                  if (kc == 0) o_w[s * 64 + row] = o;
              }
              float* dst = p.out + O_SWKV + (size_t)(b * 8 + h) * 4096 + (unsigned)(row * 64 + kc * 16);
#pragma unroll
              for (int i4 = 0; i4 < 4; ++i4) *(f32x4*)(dst + i4 * 4) = (f32x4){St[i4 * 4], St[i4 * 4 + 1], St[i4 * 4 + 2], St[i4 * 4 + 3]};
          } else {
              const float gamma = 1.0f - exp2f(-5.0f - (float)h);
              const float* src = p.in[4] + (size_t)(b * 8 + h) * 4096 + (unsigned)(kc * 16 * 64 + row);
#pragma unroll
              for (int i = 0; i < 16; ++i) St[i] = src[i * 64];
              for (int s = 0; s < TS; ++s) {
                  const LAS f32x4* K4 = (const LAS f32x4*)(rt_k + s * 64 + kc * 16); const LAS f32x4* Q4 = (const LAS f32x4*)(rt_q + s * 64 + kc * 16);
                  const float vv = rt_v[s * 64 + row]; float o = 0.f;
#pragma unroll
                  for (int i4 = 0; i4 < 4; ++i4) { const f32x4 kq = K4[i4], q4 = Q4[i4];
#pragma unroll
                      for (int q = 0; q < 4; ++q) { St[i4 * 4 + q] = St[i4 * 4 + q] * gamma + kq[q] * vv; o += St[i4 * 4 + q] * q4[q]; } }
                  o += __shfl_xor(o, 1); o += __shfl_xor(o, 2);
                  if (kc == 0) o_r[s * 64 + row] = o;
              }
              float* dst = p.out + O_SRET + (size_t)(b * 8 + h) * 4096 + (unsigned)(kc * 16 * 64 + row);
#pragma unroll
              for (int i = 0; i < 16; ++i) dst[i * 64] = St[i];
          } }
        __syncthreads();
        { const unsigned row = (unsigned)(rowbase + t);
          { const float o = o_w[t * 64 + c]; const float mean = wave_sum(o) * (1.f / 64.f); const float d = o - mean; const float var = wave_sum(d * d) * (1.f / 64.f);
            const float ya = (d * rsqrtf(var + 64e-5f) * p.in[16][hcc] + p.in[17][hcc] + bonus * mv) * gv;
            const float ya2 = __shfl_down(ya, 1); if (!(c & 1)) *(unsigned*)(ycat + (row * (unsigned)DM + hcc)) = cvt_pk_bf16(ya, ya2); }
          { const float o = o_r[t * 64 + c]; const float mean = wave_sum(o) * (1.f / 64.f); const float d = o - mean; const float var = wave_sum(d * d) * (1.f / 64.f);
            const float yb = qg / (1.0f + __expf(-qg)) * (d * rsqrtf(var + 1e-5f) * p.in[18][hcc] + p.in[19][hcc]);
            const float yb2 = __shfl_down(yb, 1); if (!(c & 1)) *(unsigned*)(ycat + (row * (unsigned)DM + 512u + hcc)) = cvt_pk_bf16(yb, yb2); } }
        if (h == 0) { float* dst = p.out + O_SSHIFT + (size_t)b * APROJ; const bf16_t* pr = proj + (size_t)(rowbase + TS - 1) * NPROJ;
            for (int j = tid; j < APROJ; j += NTHREADS) dst[j] = bf2f(pr[j]); }
        __syncthreads();
    }
}

constexpr int RS = 144;
constexpr int UNIT = 64 * RS;
constexpr int FRS = 272;
constexpr int U_AT = 0, U_BT = UNIT, U_KT = 2 * UNIT, U_RT = 3 * UNIT, U_VT = 4 * UNIT, U_BH = 5 * UNIT, U_KH = 6 * UNIT;
constexpr int U_LAK = 7 * UNIT, U_MRB = 8 * UNIT, U_MRK = 9 * UNIT, U_PT = 10 * UNIT, U_QT = 11 * UNIT;
constexpr int F_LAB = 12 * UNIT, F_X = F_LAB + 64 * FRS, F_MISC = F_X + 64 * FRS;
constexpr int L_LIN = 7 * UNIT, F_AW = L_LIN + 64 * LRS, F_AA = F_AW + 64 * FRS;
static_assert(F_MISC + 2304 <= LDS_BYTES && F_AA + 64 * FRS <= F_MISC, "LDS map");

__device__ __forceinline__ f32x4 mm2(const LAS unsigned char* A, const LAS unsigned char* B, int arow, int brow, int fq, f32x4 acc) {
#pragma unroll
    for (int ks = 0; ks < 2; ++ks) {
        const bf16x8 a = *(const LAS bf16x8*)(A + arow * RS + (ks * 32 + fq * 8) * 2);
        const bf16x8 b = *(const LAS bf16x8*)(B + brow * RS + (ks * 32 + fq * 8) * 2);
        acc = __builtin_amdgcn_mfma_f32_16x16x32_bf16(a, b, acc, 0, 0, 0);
    }
    return acc;
}
#ifndef SAN
#define SAN 0
#endif
template <int CAT> __device__ __forceinline__ u32x2 pk4c(f32x4 v) { u32x2 w;
    if (SAN & (1 << CAT)) {
#pragma unroll
        for (int q = 0; q < 4; ++q) v[q] = (fabsf(v[q]) <= 3.0e38f) ? v[q] : 0.f; }
    w.x = cvt_pk_bf16(v[0], v[1]); w.y = cvt_pk_bf16(v[2], v[3]); return w; }

__device__ __forceinline__ void phase_mix_local(const Params& p, LAS unsigned char* lds, const int tid_in, const int bid, const int G) {
    bf16_t* proj = (bf16_t*)(p.ws + WS_BIG);
    const float2* rope = (const float2*)(p.ws + WS_ROPE);
    const float* mu = p.in[7];
    for (int item = bid; item < 2048; item += G) {
        int tid = tid_in; asm volatile("" : "+v"(tid));
        const int lane = tid & 63, wave = tid >> 6, fr = lane & 15, fq = lane >> 4;
        const int c = lane, tg = wave;
        const int mt = wave & 3, nt0 = (wave >> 2) * 2;
        const int bh = item >> 5, ch = item & 31, b = bh >> 3, h = bh & 7, hc = h * 64;
        const unsigned hcc = (unsigned)(hc + c);
        const int rowbase = b * TP + ch * 64;
        unsigned char* r1 = p.ws + WS_ACT + (size_t)item * 16384;
        unsigned char* r2 = (unsigned char*)(p.out + O_Y) + (size_t)item * 24576;
        unsigned char* r3 = p.ws + WS_R3 + (size_t)item * 8192;
        unsigned qbr[8]; u32x2 hrs[2], prs[2]; f32x4 dgs[2]; float bvs[8];
        {
            const float l2g = log2f(1.0f - exp2f(-5.0f - (float)h));
            float qv[8], kv[8], vv[8];
#pragma unroll
            for (int i = 0; i < 8; ++i) { const int t = tg * 8 + i; const unsigned ro = (unsigned)(rowbase + t) * (unsigned)NPROJ;
                const float2 cs = rope[(unsigned)(ch * 64 + t) * 32u + (unsigned)(c & 31)];
                const float sgn = (c < 32) ? -1.f : 1.f; const unsigned hco = (unsigned)(hc + (c ^ 32));
                const float qs = bf2f(proj[ro + (unsigned)APROJ + hcc]), qo = bf2f(proj[ro + (unsigned)APROJ + hco]);
                const float ks = bf2f(proj[ro + (unsigned)(APROJ + 512) + hcc]), ko = bf2f(proj[ro + (unsigned)(APROJ + 512) + hco]);
                qv[i] = qs * cs.x + sgn * qo * cs.y; kv[i] = (ks * cs.x + sgn * ko * cs.y) * 0.125f; vv[i] = bf2f(proj[ro + (unsigned)(APROJ + 1024) + hcc]); }
            asm volatile("s_waitcnt vmcnt(0)" ::: "memory");
            __syncthreads();
            { float vt[8], kh[8];
#pragma unroll
              for (int i = 0; i < 8; ++i) { const int t = tg * 8 + i; const unsigned ro = (unsigned)(rowbase + t) * (unsigned)NPROJ;
                  const float qd = qv[i] * exp2f(l2g * (float)(t + 1));
                  const unsigned qb = cvt_pk_bf16(qd, 0.f) & 0xffffu;
                  qbr[i] = qb;
                  *(LAS bf16_t*)(lds + U_RT + t * RS + c * 2) = (bf16_t)qb;
                  st_lds_bf16(lds + U_KT, t * RS + c * 2, kv[i] * exp2f(-l2g * (float)(t + 1)));
                  vt[i] = vv[i]; kh[i] = kv[i] * exp2f(l2g * (float)(63 - t)); }
              u32x4 w; w.x = cvt_pk_bf16(vt[0], vt[1]); w.y = cvt_pk_bf16(vt[2], vt[3]); w.z = cvt_pk_bf16(vt[4], vt[5]); w.w = cvt_pk_bf16(vt[6], vt[7]);
              *(LAS u32x4*)(lds + U_VT + c * RS + tg * 16) = w;
              w.x = cvt_pk_bf16(kh[0], kh[1]); w.y = cvt_pk_bf16(kh[2], kh[3]); w.z = cvt_pk_bf16(kh[4], kh[5]); w.w = cvt_pk_bf16(kh[6], kh[7]);
              *(LAS u32x4*)(lds + U_KH + c * RS + tg * 16) = w; }
            __syncthreads();
#pragma unroll
            for (int n = 0; n < 2; ++n) { const int nt = nt0 + n; f32x4 acc = (f32x4){0.f, 0.f, 0.f, 0.f};
                acc = mm2(lds + U_KT, lds + U_RT, mt * 16 + fr, nt * 16 + fr, fq, acc);
                const int t = nt * 16 + fr, j0 = mt * 16 + fq * 4;
#pragma unroll
                for (int jj = 0; jj < 4; ++jj) if (j0 + jj > t) acc[jj] = 0.f;
                *(LAS u32x2*)(lds + U_MRK + t * RS + j0 * 2) = pk4c<1>(acc); }
            __syncthreads();
#pragma unroll
            for (int n = 0; n < 2; ++n) { const int nt = nt0 + n;
                { f32x4 acc = (f32x4){0.f, 0.f, 0.f, 0.f};
                  acc = mm2(lds + U_VT, lds + U_MRK, mt * 16 + fr, nt * 16 + fr, fq, acc);
                  const int t = nt * 16 + fr, v0 = mt * 16 + fq * 4;
                  (void)t; (void)v0; hrs[n] = pk4c<1>(acc); }
                { f32x4 acc = (f32x4){0.f, 0.f, 0.f, 0.f};
                  acc = mm2(lds + U_KH, lds + U_VT, mt * 16 + fr, nt * 16 + fr, fq, acc);
                  const int v = nt * 16 + fr, k0 = mt * 16 + fq * 4;
                  (void)v; (void)k0; prs[n] = pk4c<1>(acc); } }
            __syncthreads();
        }
        {
            { const int j = tid & 255, t0 = (tid >> 8) * 32; const unsigned col = 1536u + (unsigned)j; const float muc = mu[col];
              const unsigned ro0 = (unsigned)(rowbase + t0) * (unsigned)NPROJ + col;
              float pv[33];
              pv[0] = (ch == 0 && t0 == 0) ? 0.f : bf2f(proj[ro0 - (unsigned)NPROJ]);
#pragma unroll
              for (int i = 0; i < 32; ++i) pv[i + 1] = bf2f(proj[ro0 + (unsigned)i * (unsigned)NPROJ]);
#pragma unroll
              for (int i = 0; i < 32; ++i) { const float m = pv[i + 1] + (pv[i] - pv[i + 1]) * muc;
                  st_lds_bf16(lds + L_LIN, (t0 + i) * LRS + j * 2, j < 64 ? (1.0f - 2.0f / (__expf(2.0f * m) + 1.0f)) : (j < 128 ? m : 1.0f / (1.0f + __expf(-m)))); } }
            float mr[8], mk[8], mv[8];
            { const float mu_r = mu[hcc], mu_k = mu[512u + hcc], mu_v = mu[1024u + hcc];
#pragma unroll
              for (int i = 0; i < 8; ++i) { const int t = tg * 8 + i; const unsigned ro = (unsigned)(rowbase + t) * (unsigned)NPROJ; const unsigned rp = ro - (unsigned)NPROJ; const bool first = (ch == 0 && t == 0);
                  { const float pc = bf2f(proj[ro + hcc]); const float pp = first ? 0.f : bf2f(proj[rp + hcc]); mr[i] = pc + (pp - pc) * mu_r; }
                  { const float pc = bf2f(proj[ro + 512u + hcc]); const float pp = first ? 0.f : bf2f(proj[rp + 512u + hcc]); mk[i] = pc + (pp - pc) * mu_k; }
                  { const float pc = bf2f(proj[ro + 1024u + hcc]); const float pp = first ? 0.f : bf2f(proj[rp + 1024u + hcc]); mv[i] = pc + (pp - pc) * mu_v; } } }
            __syncthreads();
            { const bf16_t* w2t = (const bf16_t*)(p.ws + WS_W2T); const bf16_t* a2t = (const bf16_t*)(p.ws + WS_A2T); const bf16_t* g2t = (const bf16_t*)(p.ws + WS_G2T);
#pragma unroll
              for (int n = 0; n < 2; ++n) { const int nt = nt0 + n; const unsigned cr = (unsigned)(hc + nt * 16 + fr);
                  f32x4 dw = (f32x4){0.f, 0.f, 0.f, 0.f}, da = dw, dg = dw;
#pragma unroll
                  for (int ks = 0; ks < 2; ++ks) {
                      const bf16x8 x0 = *(const LAS bf16x8*)(lds + L_LIN + (mt * 16 + fr) * LRS + (ks * 32 + fq * 8) * 2), x1 = *(const LAS bf16x8*)(lds + L_LIN + (mt * 16 + fr) * LRS + (64 + ks * 32 + fq * 8) * 2);
                      dw = __builtin_amdgcn_mfma_f32_16x16x32_bf16(x0, *(const bf16x8*)(w2t + cr * 64u + (unsigned)(ks * 32 + fq * 8)), dw, 0, 0, 0);
                      da = __builtin_amdgcn_mfma_f32_16x16x32_bf16(x1, *(const bf16x8*)(a2t + cr * 64u + (unsigned)(ks * 32 + fq * 8)), da, 0, 0, 0); }
#pragma unroll
                  for (int ks = 0; ks < 4; ++ks) { const bf16x8 x2 = *(const LAS bf16x8*)(lds + L_LIN + (mt * 16 + fr) * LRS + (128 + ks * 32 + fq * 8) * 2);
                      dg = __builtin_amdgcn_mfma_f32_16x16x32_bf16(x2, *(const bf16x8*)(g2t + cr * 128u + (unsigned)(ks * 32 + fq * 8)), dg, 0, 0, 0); }
#pragma unroll
                  for (int jj = 0; jj < 4; ++jj) { const int t = mt * 16 + fq * 4 + jj, cc = nt * 16 + fr;
                      *(LAS float*)(lds + F_AW + t * FRS + cc * 4) = dw[jj]; *(LAS float*)(lds + F_AA + t * FRS + cc * 4) = da[jj];
                      }
                  dgs[n] = dg; } }
            __syncthreads();
            float lw[8], kp[8], na[8], bb[8];
            { float aw[8], aa[8];
              const float kkc = p.in[13][hcc], kac = p.in[14][hcc], rkc = p.in[15][hcc], w0c = p.in[8][hcc], a0c = p.in[10][hcc];
#pragma unroll
              for (int i = 0; i < 8; ++i) { const int t = tg * 8 + i; aw[i] = w0c + *(const LAS float*)(lds + F_AW + t * FRS + c * 4); aa[i] = a0c + *(const LAS float*)(lds + F_AA + t * FRS + c * 4); }
              float al8[8], ss8[8], bo8[8], kkr8[8];
#pragma unroll
              for (int i = 0; i < 8; ++i) {
                  const float z = -aw[i]; const float sp = fmaxf(z, 0.f) + log1pf(__expf(-fabsf(z)));
                  lw[i] = -__expf(-sp - 0.5f);
                  al8[i] = 1.0f / (1.0f + __expf(-aa[i]));
                  kkr8[i] = mk[i] * kkc; ss8[i] = kkr8[i] * kkr8[i];
                  kp[i] = mk[i] * (1.0f + (al8[i] - 1.0f) * kac); bo8[i] = mr[i] * kp[i] * rkc; }
#pragma unroll
              for (int o = 32; o >= 1; o >>= 1) {
#pragma unroll
                  for (int i = 0; i < 8; ++i) { ss8[i] += __shfl_xor(ss8[i], o); bo8[i] += __shfl_xor(bo8[i], o); } }
#pragma unroll
              for (int i = 0; i < 8; ++i) { const int t = tg * 8 + i;
                  const float kk = kkr8[i] * rsqrtf(fmaxf(ss8[i], 1e-24f));
                  na[i] = -kk; bb[i] = kk * al8[i];
                  (void)t; bvs[i] = bo8[i] * mv[i]; } }
            LAS float* wend = (LAS float*)(lds + F_MISC); LAS float* part = wend + 64;
            float cl[8];
            { float s = 0.f;
#pragma unroll
              for (int i = 0; i < 8; ++i) { s += lw[i]; cl[i] = s; }
              part[tg * 64 + c] = s; }
            __syncthreads();
            float base = 0.f, tot = 0.f;
#pragma unroll
            for (int g8 = 0; g8 < 8; ++g8) { const float pv = part[g8 * 64 + c]; tot += pv; if (g8 < tg) base += pv; }
            if (tg == 0) wend[c] = __expf(tot);
            { float vt[8], bh8[8], kh8[8];
#pragma unroll
              for (int i = 0; i < 8; ++i) { const int t = tg * 8 + i; const float cum = base + cl[i];
                  const float ec = __expf(cum), en = __expf(-cum), eh = __expf(tot - cum);
                  st_lds_bf16(lds + U_AT, t * RS + c * 2, na[i] * __expf(cum - lw[i]));
                  st_lds_bf16(lds + U_BT, t * RS + c * 2, bb[i] * en);
                  st_lds_bf16(lds + U_KT, t * RS + c * 2, kp[i] * en);
                  st_lds_bf16(lds + U_RT, t * RS + c * 2, mr[i] * ec);
                  vt[i] = mv[i]; bh8[i] = bb[i] * eh; kh8[i] = kp[i] * eh; }
              u32x4 w; w.x = cvt_pk_bf16(vt[0], vt[1]); w.y = cvt_pk_bf16(vt[2], vt[3]); w.z = cvt_pk_bf16(vt[4], vt[5]); w.w = cvt_pk_bf16(vt[6], vt[7]);
              *(LAS u32x4*)(lds + U_VT + c * RS + tg * 16) = w;
              w.x = cvt_pk_bf16(bh8[0], bh8[1]); w.y = cvt_pk_bf16(bh8[2], bh8[3]); w.z = cvt_pk_bf16(bh8[4], bh8[5]); w.w = cvt_pk_bf16(bh8[6], bh8[7]);
              *(LAS u32x4*)(lds + U_BH + c * RS + tg * 16) = w;
              w.x = cvt_pk_bf16(kh8[0], kh8[1]); w.y = cvt_pk_bf16(kh8[2], kh8[3]); w.z = cvt_pk_bf16(kh8[4], kh8[5]); w.w = cvt_pk_bf16(kh8[6], kh8[7]);
              *(LAS u32x4*)(lds + U_KH + c * RS + tg * 16) = w; }
            __syncthreads();
#pragma unroll
            for (int n = 0; n < 2; ++n) { const int nt = nt0 + n; const int t = nt * 16 + fr, j0 = mt * 16 + fq * 4; const f32x4 z4 = (f32x4){0.f, 0.f, 0.f, 0.f};
                f32x4 lab = mm2(lds + U_BT, lds + U_AT, mt * 16 + fr, nt * 16 + fr, fq, z4);
                f32x4 lak = mm2(lds + U_KT, lds + U_AT, mt * 16 + fr, nt * 16 + fr, fq, z4);
                f32x4 mrb = mm2(lds + U_BT, lds + U_RT, mt * 16 + fr, nt * 16 + fr, fq, z4);
                f32x4 mrk = mm2(lds + U_KT, lds + U_RT, mt * 16 + fr, nt * 16 + fr, fq, z4);
#pragma unroll
                for (int jj = 0; jj < 4; ++jj) { if (j0 + jj >= t) { lab[jj] = 0.f; lak[jj] = 0.f; } if (j0 + jj > t) { mrb[jj] = 0.f; mrk[jj] = 0.f; } }
                *(LAS f32x4*)(lds + F_LAB + t * FRS + j0 * 4) = lab;
                *(LAS u32x2*)(lds + U_LAK + t * RS + j0 * 2) = pk4c<0>(lak);
                *(LAS u32x2*)(lds + U_MRB + t * RS + j0 * 2) = pk4c<0>(mrb);
                *(LAS u32x2*)(lds + U_MRK + t * RS + j0 * 2) = pk4c<0>(mrk); }
            __syncthreads();
#pragma unroll
            for (int n = 0; n < 2; ++n) { const int nt = nt0 + n; const int t = nt * 16 + fr, v0 = mt * 16 + fq * 4;
                const f32x4 x = mm2(lds + U_VT, lds + U_LAK, mt * 16 + fr, nt * 16 + fr, fq, (f32x4){0.f, 0.f, 0.f, 0.f});
                *(LAS f32x4*)(lds + F_X + t * FRS + v0 * 4) = x; }
            { const int t = tid >> 3, j0 = (tid & 7) * 8;
              const f32x4 l0 = *(const LAS f32x4*)(lds + F_LAB + t * FRS + j0 * 4), l1 = *(const LAS f32x4*)(lds + F_LAB + t * FRS + j0 * 4 + 16);
              u32x4 w; w.x = cvt_pk_bf16(l0[0], l0[1]); w.y = cvt_pk_bf16(l0[2], l0[3]); w.z = cvt_pk_bf16(l1[0], l1[1]); w.w = cvt_pk_bf16(l1[2], l1[3]);
              if ((j0 >> 4) == (t >> 4)) w = (u32x4){0u, 0u, 0u, 0u};
              *(LAS u32x4*)(lds + U_KT + t * RS + j0 * 2) = w;
              for (int i = tid; i < 2 * UNIT / 16; i += NTHREADS) ((LAS u32x4*)(lds + U_PT))[i] = (u32x4){0u, 0u, 0u, 0u}; }
            __syncthreads();
#pragma unroll 1
            for (int bi = 0; bi < 4; ++bi) {
                { const LAS unsigned char* YB = lds + ((wave < 4) ? U_PT : U_QT); const int ntl = wave & 3;
                  f32x4 d = (f32x4){0.f, 0.f, 0.f, 0.f};
                  const int nks = (bi + 1) >> 1;
                  for (int ks = 0; ks < nks; ++ks) { const bf16x8 a = *(const LAS bf16x8*)(lds + U_KT + (bi * 16 + fr) * RS + (ks * 32 + fq * 8) * 2), bq = *(const LAS bf16x8*)(YB + (ntl * 16 + fr) * RS + (ks * 32 + fq * 8) * 2);
                      d = __builtin_amdgcn_mfma_f32_16x16x32_bf16(a, bq, d, 0, 0, 0); }
#pragma unroll
                  for (int jj = 0; jj < 4; ++jj) { const int i = fq * 4 + jj, row = bi * 16 + i;
                      const float rhs = (wave < 4) ? bf2f(*(const LAS bf16_t*)(lds + U_AT + row * RS + (ntl * 16 + fr) * 2)) : *(const LAS float*)(lds + F_X + row * FRS + (ntl * 16 + fr) * 4);
                      *(LAS float*)(lds + U_LAK + i * 528 + (wave * 16 + fr) * 4) = d[jj] + rhs; } }
                __syncthreads();
                if (wave < 2) {
                    LAS unsigned char* dst = lds + (wave == 0 ? U_PT : U_QT) + lane * RS;
                    float acc[16];
#pragma unroll
                    for (int r = 0; r < 16; ++r) acc[r] = *(const LAS float*)(lds + U_LAK + r * 528 + (wave * 64 + lane) * 4);
                    const LAS unsigned char* Ld = lds + F_LAB + (bi * 16) * FRS + bi * 64;
#pragma unroll
                    for (int r = 1; r < 16; ++r) {
#pragma unroll
                        for (int q4 = 0; q4 < (r + 3) / 4; ++q4) { const f32x4 l = *(const LAS f32x4*)(Ld + r * FRS + q4 * 16);
#pragma unroll
                            for (int q = 0; q < 4; ++q) if (q4 * 4 + q < r) acc[r] += l[q] * acc[q4 * 4 + q]; }
                    }
                    u32x4 w; w.x = cvt_pk_bf16(acc[0], acc[1]); w.y = cvt_pk_bf16(acc[2], acc[3]); w.z = cvt_pk_bf16(acc[4], acc[5]); w.w = cvt_pk_bf16(acc[6], acc[7]);
                    *(LAS u32x4*)(dst + bi * 32) = w;
                    w.x = cvt_pk_bf16(acc[8], acc[9]); w.y = cvt_pk_bf16(acc[10], acc[11]); w.z = cvt_pk_bf16(acc[12], acc[13]); w.w = cvt_pk_bf16(acc[14], acc[15]);
                    *(LAS u32x4*)(dst + bi * 32 + 16) = w;
                }
                __syncthreads();
            }
#pragma unroll
            for (int i = 0; i < 8; ++i) { const int t = tg * 8 + i;
                proj[(unsigned)(rowbase + t) * (unsigned)NPROJ + (unsigned)APROJ + hcc] = (bf16_t)qbr[i];
                *(bf16_t*)(r2 + 16384 + t * 128 + c * 2) = (bf16_t)(cvt_pk_bf16(bvs[i], 0.f) & 0xffffu); }
#pragma unroll
            for (int n = 0; n < 2; ++n) { const int nt = nt0 + n;
                *(u32x2*)(proj + (unsigned)(rowbase + nt * 16 + fr) * (unsigned)NPROJ + (unsigned)(APROJ + 512 + hc + mt * 16 + fq * 4)) = hrs[n];
                *(u32x2*)(r3 + (nt * 16 + fr) * 128 + (mt * 16 + fq * 4) * 2) = prs[n];
#pragma unroll
                for (int jj = 0; jj < 4; ++jj) *(bf16_t*)(r2 + 8192 + (mt * 16 + fq * 4 + jj) * 128 + (nt * 16 + fr) * 2) = (bf16_t)(cvt_pk_bf16(dgs[n][jj], 0.f) & 0xffffu); }
#pragma unroll
            for (int n = 0; n < 2; ++n) { const int nt = nt0 + n; const f32x4 z4 = (f32x4){0.f, 0.f, 0.f, 0.f};
                { f32x4 g4 = mm2(lds + U_PT, lds + U_MRB, mt * 16 + fr, nt * 16 + fr, fq, z4);
                  const int t = nt * 16 + fr, k0 = mt * 16 + fq * 4; const u32x2 rr = *(const LAS u32x2*)(lds + U_RT + t * RS + k0 * 2);
                  g4[0] += __uint_as_float(rr.x << 16); g4[1] += __uint_as_float(rr.x & 0xffff0000u); g4[2] += __uint_as_float(rr.y << 16); g4[3] += __uint_as_float(rr.y & 0xffff0000u);
                  *(u32x2*)(proj + (unsigned)(rowbase + t) * (unsigned)NPROJ + (unsigned)(APROJ + 1024 + hc + k0)) = pk4c<2>(g4); }
                { f32x4 h4 = mm2(lds + U_QT, lds + U_MRB, mt * 16 + fr, nt * 16 + fr, fq, z4);
                  h4 = mm2(lds + U_VT, lds + U_MRK, mt * 16 + fr, nt * 16 + fr, fq, h4);
                  const int t = nt * 16 + fr, v0 = mt * 16 + fq * 4;
                  *(u32x2*)(r2 + t * 128 + v0 * 2) = pk4c<2>(h4); }
                { f32x4 f4 = mm2(lds + U_PT, lds + U_BH, mt * 16 + fr, nt * 16 + fr, fq, z4);
                  const int k2 = nt * 16 + fr, k10 = mt * 16 + fq * 4;
#pragma unroll
                  for (int jj = 0; jj < 4; ++jj) if (k10 + jj == k2) f4[jj] += wend[k2];
                  *(u32x2*)(r1 + k2 * 128 + k10 * 2) = pk4c<3>(f4); }
                { f32x4 s4 = mm2(lds + U_BH, lds + U_QT, mt * 16 + fr, nt * 16 + fr, fq, z4);
                  s4 = mm2(lds + U_KH, lds + U_VT, mt * 16 + fr, nt * 16 + fr, fq, s4);
                  const int v = nt * 16 + fr, k0 = mt * 16 + fq * 4;
                  *(u32x2*)(r1 + 8192 + v * 128 + k0 * 2) = pk4c<3>(s4); } }
            if (h == 0 && ch == 31) { float* dst = p.out + O_PSHIFT + (size_t)b * APROJ; const bf16_t* pr = proj + (size_t)(rowbase + 63) * NPROJ;
                for (int j = tid; j < APROJ; j += NTHREADS) dst[j] = bf2f(pr[j]); }
            __syncthreads();
        }
    }
}

constexpr int ORS = 32;
constexpr int CH_SCR = 0, CH_OBUF = 4 * 16 * RS, CH_RING = CH_OBUF + 4 * 2 * 64 * ORS, CH_SLOT = 24576, CH_R = 5, CH_A = 4;
static_assert(CH_RING + CH_R * CH_SLOT <= 155648 && (CH_RING & 15) == 0, "chain LDS map");
__device__ __forceinline__ void phase_chain(const Params& p, LAS unsigned char* lds, const int tid, const int bid, const int G) {
    const int lane = tid & 63, wave = __builtin_amdgcn_readfirstlane(tid >> 6), fr = lane & 15, fq = lane >> 4;
    bf16_t* proj = (bf16_t*)(p.ws + WS_BIG);
#define CH_BAR() do { asm volatile("s_waitcnt lgkmcnt(0)" ::: "memory"); __builtin_amdgcn_s_barrier(); asm volatile("" ::: "memory"); } while (0)
    for (int chain = bid; chain < 128; chain += G) {
        const int kind = chain & 1, bh = chain >> 1, b = bh >> 3, h = bh & 7, hc = h * 64;
        const unsigned slot = APROJ + (kind ? 0 : 1024) + hc;
        if (wave < 4) {
            const int vt = wave;
            LAS unsigned char* scr = lds + CH_SCR + vt * (16 * RS);
            LAS unsigned char* obuf = lds + CH_OBUF + vt * (2 * 64 * ORS);
            const float gC = kind ? exp2f(64.0f * log2f(1.0f - exp2f(-5.0f - (float)h))) : 0.f;
            f32x4 S[4]; bf16x8 Sb[2];
#pragma unroll
            for (int m = 0; m < 4; ++m) S[m] = (f32x4){0.f, 0.f, 0.f, 0.f};
#pragma unroll
            for (int ks = 0; ks < 2; ++ks) Sb[ks] = (bf16x8){0, 0, 0, 0, 0, 0, 0, 0};
            for (int ch = 0; ch < 32; ++ch) {
                CH_BAR();
                const LAS unsigned char* sl = lds + CH_RING + (ch % CH_R) * CH_SLOT;
                LAS unsigned char* ob = obuf + (ch & 1) * (64 * ORS);
#pragma unroll
                for (int m = 0; m < 4; ++m) {
                    const u32x2 pw = *(const LAS u32x2*)(sl + 8192 + (vt * 16 + fr) * 128 + (m * 16 + fq * 4) * 2);
                    const f32x4 d = (f32x4){__uint_as_float(pw.x << 16), __uint_as_float(pw.x & 0xffff0000u), __uint_as_float(pw.y << 16), __uint_as_float(pw.y & 0xffff0000u)};
                    f32x4 dm = d, o = (f32x4){0.f, 0.f, 0.f, 0.f};
#pragma unroll
                    for (int ks = 0; ks < 2; ++ks) {
                        dm = __builtin_amdgcn_mfma_f32_16x16x32_bf16(*(const LAS bf16x8*)(sl + (m * 16 + fr) * 128 + (ks * 32 + fq * 8) * 2), Sb[ks], dm, 0, 0, 0);
                        o = __builtin_amdgcn_mfma_f32_16x16x32_bf16(*(const LAS bf16x8*)(sl + 16384 + (m * 16 + fr) * 128 + (ks * 32 + fq * 8) * 2), Sb[ks], o, 0, 0, 0); }
                    const f32x4 dr = S[m] * gC + d;
#pragma unroll
                    for (int q = 0; q < 4; ++q) S[m][q] = kind ? dr[q] : dm[q];
#pragma unroll
                    for (int jj = 0; jj < 4; ++jj) *(LAS bf16_t*)(ob + (m * 16 + fq * 4 + jj) * ORS + fr * 2) = (bf16_t)(cvt_pk_bf16(o[jj], 0.f) & 0xffffu);
                }
#pragma unroll
                for (int m = 0; m < 4; ++m) *(LAS u32x2*)(scr + fr * RS + (m * 16 + fq * 4) * 2) = pk4c<4>(S[m]);
                asm volatile("s_waitcnt lgkmcnt(0)" ::: "memory");
#pragma unroll
                for (int ks = 0; ks < 2; ++ks) Sb[ks] = *(const LAS bf16x8*)(scr + fr * RS + (ks * 32 + fq * 8) * 2);
            }
            CH_BAR();
            if (!kind) { float* dst = p.out + O_PWKV + ((size_t)bh * 64 + vt * 16 + fr) * 64;
#pragma unroll
                for (int m = 0; m < 4; ++m) *(f32x4*)(dst + m * 16 + fq * 4) = S[m]; }
            else { float* dst = p.out + O_PRET + (size_t)bh * 4096 + vt * 16 + fr;
#pragma unroll
                for (int m = 0; m < 4; ++m)
#pragma unroll
                    for (int jj = 0; jj < 4; ++jj) dst[(m * 16 + fq * 4 + jj) * 64] = S[m][jj]; }
        } else if (wave < 6) {
            const int lw = wave - 4;
#define CH_ISSUE(chx) do { const int item_ = bh * 32 + (chx); const unsigned char* r1_ = p.ws + WS_ACT + (size_t)item_ * 16384; \
                const unsigned char* psi_ = kind ? (p.ws + WS_R3 + (size_t)item_ * 8192) : (r1_ + 8192); \
                const unsigned char* gb_ = (const unsigned char*)(proj + (size_t)(b * TP + (chx) * 64) * NPROJ + slot); \
                LAS unsigned char* sl_ = lds + CH_RING + ((chx) % CH_R) * CH_SLOT; \
                _Pragma("unroll") for (int q = 0; q < 12; ++q) { const int pi = lw + 2 * q, seg = pi >> 3; const int off = (pi & 7) * 1024 + lane * 16; \
                    const unsigned char* src_ = seg == 0 ? (r1_ + off) : (seg == 1 ? (psi_ + off) : (gb_ + (size_t)(off >> 7) * (NPROJ * 2) + (off & 127))); \
                    __builtin_amdgcn_global_load_lds((const unsigned*)src_, (LAS unsigned*)(sl_ + pi * 1024), 16, 0, 0); } } while (0)
#pragma unroll
            for (int c0 = 0; c0 < CH_A; ++c0) CH_ISSUE(c0);
            for (int ch = 0; ch < 32; ++ch) {
                const int rem = 31 - ch;
                if (rem >= 3) asm volatile("s_waitcnt vmcnt(36)" ::: "memory"); else if (rem == 2) asm volatile("s_waitcnt vmcnt(24)" ::: "memory");
                else if (rem == 1) asm volatile("s_waitcnt vmcnt(12)" ::: "memory"); else asm volatile("s_waitcnt vmcnt(0)" ::: "memory");
                CH_BAR();
                if (ch + CH_A < 32) CH_ISSUE(ch + CH_A);
            }
#undef CH_ISSUE
            CH_BAR();
        } else {
            const int sw = wave - 6;
            for (int ch = 0; ch <= 32; ++ch) {
                CH_BAR();
                if (ch >= 1) {
#pragma unroll
                    for (int q = 0; q < 2; ++q) { const int vt = sw * 2 + q;
                        const LAS unsigned char* ob = lds + CH_OBUF + vt * (2 * 64 * ORS) + ((ch - 1) & 1) * (64 * ORS) + lane * ORS;
                        const u32x4 w0 = *(const LAS u32x4*)ob, w1 = *(const LAS u32x4*)(ob + 16);
                        bf16_t* dst = proj + (size_t)(b * TP + (ch - 1) * 64 + lane) * NPROJ + slot + vt * 16;
                        *(u32x4*)dst = w0; *(u32x4*)(dst + 8) = w1; } }
            }
        }
        asm volatile("s_waitcnt vmcnt(0)" ::: "memory");
        __syncthreads();
    }
#undef CH_BAR
}

__device__ __forceinline__ void phase_mix_post(const Params& p, const int tid, const int bid, const int G) {
    const int lane = tid & 63, wave = tid >> 6, c = lane;
    const bf16_t* proj = (const bf16_t*)(p.ws + WS_BIG);
    bf16_t* ycat = (bf16_t*)(p.ws + WS_ACT);
    for (int row0 = bid * 8 + wave; row0 < MP / 2; row0 += G * 8) {
        float ow[2][8], g[2][8], bv[2][8], orr[2][8], gt[2][8];
#pragma unroll
        for (int r = 0; r < 2; ++r) { const int row = row0 + r * (MP / 2);
            const int b = row >> 11, tt = row & 2047, ch = tt >> 6, t = tt & 63; const unsigned ro = (unsigned)row * (unsigned)NPROJ;
#pragma unroll
            for (int h = 0; h < 8; ++h) { const unsigned hcc = (unsigned)(h * 64 + c); const int item = (b * 8 + h) * 32 + ch;
                const unsigned char* r2 = (const unsigned char*)(p.out + O_Y) + (size_t)item * 24576;
                ow[r][h] = bf2f(*(const bf16_t*)(r2 + t * 128 + c * 2)) + bf2f(proj[ro + (unsigned)(APROJ + 1024) + hcc]);
                g[r][h] = bf2f(*(const bf16_t*)(r2 + 8192 + t * 128 + c * 2)); bv[r][h] = bf2f(*(const bf16_t*)(r2 + 16384 + t * 128 + c * 2));
                orr[r][h] = bf2f(proj[ro + (unsigned)(APROJ + 512) + hcc]) + bf2f(proj[ro + (unsigned)APROJ + hcc]);
                gt[r][h] = bf2f(proj[ro + (unsigned)(APROJ + 1536) + hcc]); } }
#pragma unroll
        for (int r = 0; r < 2; ++r) { const int row = row0 + r * (MP / 2);
            float sw[8], qw[8], sr[8], qr[8];
#pragma unroll
            for (int h = 0; h < 8; ++h) { sw[h] = ow[r][h]; qw[h] = ow[r][h] * ow[r][h]; sr[h] = orr[r][h]; qr[h] = orr[r][h] * orr[r][h]; }
#pragma unroll
            for (int o = 32; o >= 1; o >>= 1) {
#pragma unroll
                for (int h = 0; h < 8; ++h) { sw[h] += __shfl_xor(sw[h], o); qw[h] += __shfl_xor(qw[h], o); sr[h] += __shfl_xor(sr[h], o); qr[h] += __shfl_xor(qr[h], o); } }
#pragma unroll
            for (int h = 0; h < 8; ++h) { const unsigned hcc = (unsigned)(h * 64 + c);
                const float mw = sw[h] * (1.f / 64.f), vw = fmaxf(qw[h] * (1.f / 64.f) - mw * mw, 0.f);
                const float ya = ((ow[r][h] - mw) * rsqrtf(vw + 64e-5f) * p.in[16][hcc] + p.in[17][hcc] + bv[r][h]) * g[r][h];
                const float mr_ = sr[h] * (1.f / 64.f), vr = fmaxf(qr[h] * (1.f / 64.f) - mr_ * mr_, 0.f);
                const float yb = gt[r][h] / (1.0f + __expf(-gt[r][h])) * ((orr[r][h] - mr_) * rsqrtf(vr + 1e-5f) * p.in[18][hcc] + p.in[19][hcc]);
                const float ya2 = __shfl_down(ya, 1), yb2 = __shfl_down(yb, 1);
                if (!(c & 1)) { *(unsigned*)(ycat + ((unsigned)row * (unsigned)DM + hcc)) = cvt_pk_bf16(ya, ya2); *(unsigned*)(ycat + ((unsigned)row * (unsigned)DM + 512u + hcc)) = cvt_pk_bf16(yb, yb2); } } }
    }
}

__device__ __forceinline__ void phase_ln(float* X, const float* g, const float* bta, bf16_t* xb, const int tid, const int bid, const int G) {
    const int lane = tid & 63, wave = tid >> 6;
    f32x4 gg[4], bb[4];
#pragma unroll
    for (int i = 0; i < 4; ++i) { gg[i] = *(const f32x4*)(g + i * 256 + lane * 4); bb[i] = *(const f32x4*)(bta + i * 256 + lane * 4); }
    for (int row = bid * 8 + wave; row < MT; row += G * 8) {
        float* xr = X + (size_t)row * DM; f32x4 v[4]; float s = 0.f;
#pragma unroll
        for (int i = 0; i < 4; ++i) { v[i] = *(const f32x4*)(xr + i * 256 + lane * 4); s += (v[i][0] + v[i][1]) + (v[i][2] + v[i][3]); }
        const float mean = wave_sum(s) * (1.f / 1024.f); float q = 0.f;
#pragma unroll
        for (int i = 0; i < 4; ++i) { v[i] -= mean; q += (v[i][0] * v[i][0] + v[i][1] * v[i][1]) + (v[i][2] * v[i][2] + v[i][3] * v[i][3]); }
        const float rstd = rsqrtf(wave_sum(q) * (1.f / 1024.f) + 1e-5f);
#pragma unroll
        for (int i = 0; i < 4; ++i) { const f32x4 y = v[i] * rstd * gg[i] + bb[i]; *(f32x4*)(xr + i * 256 + lane * 4) = y;
            u32x2 w; w.x = cvt_pk_bf16(y[0], y[1]); w.y = cvt_pk_bf16(y[2], y[3]); *(u32x2*)(xb + (size_t)row * DM + i * 256 + lane * 4) = w; }
    }
}

__device__ __forceinline__ void phase_conv(const Params& p, const int tid, const int bid, const int G) {
    const bf16_t* cp = (const bf16_t*)(p.ws + WS_BIG);
    bf16_t* vb = (bf16_t*)(p.ws + WS_ACT);
    const float* cw = p.in[22];
    const size_t total = (size_t)MT * 128;
    for (size_t idx0 = (size_t)bid * NTHREADS + tid; idx0 < total / 2; idx0 += (size_t)G * NTHREADS)
#pragma unroll
    for (int rr = 0; rr < 2; ++rr) { const size_t idx = idx0 + (size_t)rr * (total / 2);
        const int row = (int)(idx >> 7), c0 = (int)(idx & 127) * 8;
        const bool smp = row >= MP; const int T = smp ? TS : TP; const int b = smp ? (row - MP) / TS : row / TP; const int t = smp ? (row - MP) % TS : row % TP;
        float u[3][8];
#pragma unroll
        for (int d = 0; d < 3; ++d) { const int tt = t - 2 + d;
            if (tt >= 0) { const bf16_t* r = cp + (size_t)(row - 2 + d) * NCONV; const u32x4 cgv = *(const u32x4*)(r + 1024 + c0), hv = *(const u32x4*)(r + 2048 + c0);
#pragma unroll
                for (int q = 0; q < 4; ++q) { u[d][2 * q] = __uint_as_float(cgv[q] << 16) * __uint_as_float(hv[q] << 16); u[d][2 * q + 1] = __uint_as_float(cgv[q] & 0xffff0000u) * __uint_as_float(hv[q] & 0xffff0000u); } }
            else { if (smp) { const float* sr = p.in[5] + ((size_t)b * 2 + (tt + 2)) * DM + c0;
#pragma unroll
                    for (int q = 0; q < 8; ++q) u[d][q] = sr[q]; }
                else {
#pragma unroll
                    for (int q = 0; q < 8; ++q) u[d][q] = 0.f; } } }
        const u32x4 bgv = *(const u32x4*)(cp + (size_t)row * NCONV + c0); float o[8];
#pragma unroll
        for (int q = 0; q < 8; ++q) { const float bg = (q & 1) ? __uint_as_float(bgv[q >> 1] & 0xffff0000u) : __uint_as_float(bgv[q >> 1] << 16);
            o[q] = bg * (u[0][q] * cw[c0 + q] + u[1][q] * cw[DM + c0 + q] + u[2][q] * cw[2 * DM + c0 + q]); }
        u32x4 w; w.x = cvt_pk_bf16(o[0], o[1]); w.y = cvt_pk_bf16(o[2], o[3]); w.z = cvt_pk_bf16(o[4], o[5]); w.w = cvt_pk_bf16(o[6], o[7]);
        *(u32x4*)(vb + (size_t)row * DM + c0) = w;
        if (t >= T - 2) { float* dst = p.out + (smp ? O_SCONV : O_PCONV) + ((size_t)b * 2 + (t - (T - 2))) * DM + c0;
#pragma unroll
            for (int q = 0; q < 8; ++q) dst[q] = u[2][q]; }
    }
}


#define XB_TMO      128
#define XB_XCNT(j)  (256  + 64 * (j))
#define XB_XSUB(j)  (1280 + 64 * (j))
#define XB_XGEN(j)  (2304 + 64 * (j))
#define XB_TOP      3328
#define XB_TOPGEN   3392
#define XCD_BAR_WORDS 3456
#define XB_SPIN_CAP (1u << 18)
__device__ __forceinline__ unsigned xb_ld(unsigned* p)              { return __hip_atomic_load(p, __ATOMIC_RELAXED, __HIP_MEMORY_SCOPE_AGENT); }
__device__ __forceinline__ unsigned xb_add(unsigned* p, unsigned v) { return __hip_atomic_fetch_add(p, v, __ATOMIC_RELAXED, __HIP_MEMORY_SCOPE_AGENT); }
__device__ __forceinline__ unsigned xb_xcc_id() { return (unsigned)__builtin_amdgcn_s_getreg((3 << 11) | 20) & 0xFu; }
#define XB_SPIN(cond, bar) do { unsigned _sp = 0; while (cond) { __builtin_amdgcn_s_sleep(1); \
    if ((++_sp & 255u) == 0u) { if (xb_ld(&(bar)[XB_TMO])) break; if (_sp > XB_SPIN_CAP) { atomicAdd(&(bar)[XB_TMO], 1u); break; } } } } while (0)
struct XcdBarrier { unsigned* bar; unsigned x; volatile LAS unsigned* st; };
__device__ __forceinline__ XcdBarrier xcd_barrier_post(unsigned* bar, volatile LAS unsigned* st) {
    XcdBarrier b; b.bar = bar; b.x = xb_xcc_id(); b.st = st;
    if (threadIdx.x == 0) (void)xb_add(&bar[XB_XCNT(b.x)], 1u);
    return b;
}
__device__ __forceinline__ void xcd_barrier_complete(unsigned* bar, unsigned x, unsigned& nloc, unsigned& nx) {
    const unsigned G = gridDim.x * gridDim.y * gridDim.z;
    unsigned sum, cnt, mine, sp = 0u;
    for (;;) {
        sum = 0u; cnt = 0u; mine = 0u;
#pragma unroll
        for (unsigned j = 0; j < 16; ++j) { const unsigned c = xb_ld(&bar[XB_XCNT(j)]); sum += c; cnt += (c > 0u) ? 1u : 0u; mine = (j == x) ? c : mine; }
        if (sum == G) break;
        __builtin_amdgcn_s_sleep(1);
        if ((++sp & 255u) == 0u) { if (xb_ld(&bar[XB_TMO])) break; if (sp > XB_SPIN_CAP) { atomicAdd(&bar[XB_TMO], 1u); break; } }
    }
    nloc = mine > 0u ? mine : 1u; nx = cnt > 0u ? cnt : 1u;
}
__device__ __forceinline__ void xcd_barrier(const XcdBarrier& b) {
    asm volatile("s_waitcnt vmcnt(0)" ::: "memory");
    __syncthreads();
    if (threadIdx.x == 0) {
        unsigned* bar = b.bar;
        __builtin_amdgcn_s_waitcnt(0);
        unsigned nloc = b.st[0], nx = b.st[1];
        if (nloc == 0u) { xcd_barrier_complete(bar, b.x, nloc, nx); b.st[0] = nloc; b.st[1] = nx; }
        const unsigned old = xb_add(&bar[XB_XSUB(b.x)], 1u);
        const unsigned gen = old / nloc;
        if (old + 1u == (gen + 1u) * nloc) {
            __builtin_amdgcn_fence(__ATOMIC_RELEASE, "agent");
            asm volatile("s_waitcnt vmcnt(0)" ::: "memory");
            const unsigned og = xb_add(&bar[XB_TOP], 1u);
            const unsigned tg = og / nx;
            if (og + 1u == (tg + 1u) * nx) xb_add(&bar[XB_TOPGEN], 1u);
            else XB_SPIN(xb_ld(&bar[XB_TOPGEN]) == tg, bar);
            __builtin_amdgcn_fence(__ATOMIC_ACQUIRE, "agent");
            xb_add(&bar[XB_XGEN(b.x)], 1u);
            asm volatile("s_waitcnt vmcnt(0)" ::: "memory");
        } else {
            XB_SPIN(xb_ld(&bar[XB_XGEN(b.x)]) == gen, bar);
            __builtin_amdgcn_fence(__ATOMIC_ACQUIRE, "agent");
            asm volatile("s_waitcnt vmcnt(0)" ::: "memory");
        }
    }
    __syncthreads();
}

__global__ void __launch_bounds__(NTHREADS, 2) mega(Params p_arg) {
    extern __shared__ __attribute__((aligned(16))) unsigned char lds[];
    cg::grid_group grid = cg::this_grid();
    LAS unsigned char* ldsl = (LAS unsigned char*)lds;
    float* L = (float*)lds;
    const int lo = p_arg.ph_lo, hi = p_arg.ph_hi & 0xff; const int dbg = p_arg.ph_hi >> 8;
    volatile LAS unsigned* xb_st = (volatile LAS unsigned*)(ldsl + 155648);
    if (threadIdx.x == 0) { xb_st[0] = 0u; xb_st[1] = 0u; }
    __syncthreads();
    const XcdBarrier xbar = xcd_barrier_post((unsigned*)(p_arg.ws + WS_BAR), xb_st);
    const int wid_s = __builtin_amdgcn_readfirstlane((int)threadIdx.x >> 6);
    for (int ph = lo; ph < hi; ++ph) {
        unsigned zero_v = 0u; asm volatile("" : "+v"(zero_v));
        int tid = wid_s * 64 + (int)__builtin_amdgcn_mbcnt_hi(~0u, __builtin_amdgcn_mbcnt_lo(~0u, zero_v)), bid = blockIdx.x, G = gridDim.x;
        asm volatile("" : "+v"(tid), "+s"(bid), "+s"(G));
        const __attribute__((address_space(4))) Params* pk = (const __attribute__((address_space(4))) Params*)__builtin_amdgcn_kernarg_segment_ptr();
        asm volatile("" : "+s"(pk));
        const Params& p = *(const Params*)pk;
        bf16_t* act = (bf16_t*)(p.ws + WS_ACT); bf16_t* big = (bf16_t*)(p.ws + WS_BIG);
        float* Y = p.out + O_Y;
#if PROBE_MASK
        if (bid == 0 && tid == 0) ((unsigned long long*)(p.ws + WS_STAMP))[ph] = __builtin_amdgcn_s_memrealtime();
#endif
        if (ph == 0) phase_convert(p, L, tid, bid, G, 0, 960, true);
        else if (ph == 2) { phase_mix_local(p, ldsl, tid, (dbg & 1) ? 4096 : bid, G); __syncthreads(); phase_sample(p, ldsl, tid, bid, G); }
        else if (ph == 3) { phase_chain(p, ldsl, tid, (dbg & 2) ? 4096 : bid, G);
            if (G > 128) { if (bid >= 128) phase_convert(p, L, tid, bid - 128, G - 128, 960, 6336, false); } else { __syncthreads(); phase_convert(p, L, tid, bid, G, 960, 6336, false); } }
        else if (ph == 4) phase_mix_post(p, tid, (dbg & 4) ? (1 << 20) : bid, G);
        else if (ph == 11) phase_conv(p, tid, bid, G);
        else if (ph == 6 || ph == 9 || ph == 13 || ph == 16) {
            const int l = ph >= 13 ? 1 : 0; const bool second = (ph == 9 || ph == 16);
            phase_ln(Y, (second ? p.in[26] : p.in[24]) + l * DM, (second ? p.in[27] : p.in[25]) + l * DM, act, tid, bid, G);
        } else {
            pg8::Gemm g; pg8::Epi E; E.O = big; E.xlo = Y; E.xhi = Y; E.Z = Y; g.M = MT; g.A = act; g.K = DM;
            size_t wo;
            switch (ph) {
                case 1: wo = WS_WIN; g.N = NPROJ; E.mode = 0; break;
                case 5: wo = WS_WOUT; g.N = DM; E.mode = 2; E.xlo = p.in[0]; E.xhi = p.in[1] - (size_t)MP * DM; break;
                case 7: wo = WS_WUP0; g.N = DFF; E.mode = 1; break;
                case 8: wo = WS_WDN0; g.N = DM; g.K = DFF; g.A = big; E.mode = 2; break;
                case 10: wo = WS_WCIN; g.N = NCONV; E.mode = 0; break;
                case 12: wo = WS_WCOUT; g.N = DM; E.mode = 2; break;
                case 14: wo = WS_WUP1; g.N = DFF; E.mode = 1; break;
                default: wo = WS_WDN1; g.N = DM; g.K = DFF; g.A = big; E.mode = 2; break;
            }
            g.Bt = (const bf16_t*)(p.ws + wo); E.ldc = g.N;
            pg8::StaticOrder S; S.init(MT, g.N, G, bid);
            const bool split_tail = (E.mode == 2 && G == 256 && S.nwg == 272);
            if (split_tail) S.lim = 256;
            pg8::gemm_phase(ldsl, g, S, E, tid);
            if (split_tail) { pg8::Unit u; S.map(256 + (bid >> 4), u); const int s = bid & 15; const int row0 = u.pm * 256 + (s >> 2) * 64, col0 = u.pn * 256 + (s & 3) * 64;
                gemm64_resid(ldsl, g.A, g.Bt, g.K, row0, col0, (row0 < MP) ? E.xlo : E.xhi, E.Z, tid); }
        }
        if (ph + 1 < hi) { if (dbg & 64) grid.sync(); else xcd_barrier(xbar); }
#if PROBE_MASK
        if (ph + 1 == hi && bid == 0 && tid == 0) { unsigned long long* st = (unsigned long long*)(p.ws + WS_STAMP); st[hi] = __builtin_amdgcn_s_memrealtime();
            unsigned long long tot = 0; for (int k = lo; k < hi; ++k) if ((PROBE_MASK >> k) & 1) tot += st[k + 1] - st[k];
            asm volatile("s_waitcnt vmcnt(0)" ::: "memory"); p.out[0] = (float)tot * 0.01f; }
#endif
    }
}
#ifndef PROBE_MASK
#define PROBE_MASK 0
#endif
constexpr int NPHASES = 17;
#ifndef DBG
#define DBG 0
#endif

#ifndef PER_PHASE_LAUNCH
#define PER_PHASE_LAUNCH 0
#endif

extern "C" void kernel_launch(void* const* d_in, const int* in_sizes, int n_in, void* d_out, int out_size, void* d_ws, size_t ws_size, hipStream_t stream) {
    static int grid = 0;
    if (grid == 0) {
        if (n_in != 30 || ws_size < WS_END2) { fprintf(stderr, "kernel_launch: unexpected n_in %d or ws_size %zu (need %zu)\n", n_in, ws_size, (size_t)WS_END2); grid = -1; return; }
        int dev = 0, cus = 0, per_cu = 0;
        hipGetDevice(&dev);
        hipDeviceGetAttribute(&cus, hipDeviceAttributeMultiprocessorCount, dev);
        if (hipFuncSetAttribute((const void*)mega, hipFuncAttributeMaxDynamicSharedMemorySize, LDS_BYTES) != hipSuccess) { fprintf(stderr, "kernel_launch: hipFuncSetAttribute failed\n"); grid = -1; return; }
        if (hipOccupancyMaxActiveBlocksPerMultiprocessor(&per_cu, (const void*)mega, NTHREADS, LDS_BYTES) != hipSuccess || per_cu < 1) { fprintf(stderr, "kernel_launch: occupancy query failed (%d)\n", per_cu); (void)hipGetLastError(); per_cu = 1; }
        if (per_cu > 1) per_cu = 1;
        grid = cus * per_cu;
    }
    if (grid < 0) return;
    if (hipMemsetAsync((char*)d_ws + WS_BAR, 0, 3456 * 4, stream) != hipSuccess) { fprintf(stderr, "kernel_launch: hipMemsetAsync failed\n"); return; }
    Params p{};
    for (int i = 0; i < 30; ++i) p.in[i] = (const float*)d_in[i];
    p.out = (float*)d_out; p.ws = (unsigned char*)d_ws;
    for (int f = 0; f < 32; ++f) p.inv_freq[f] = pow(10000.0, -(double)f / 32.0);
#if PER_PHASE_LAUNCH
    for (int ph = 0; ph < NPHASES; ++ph) { p.ph_lo = ph; p.ph_hi = ph + 1; hipLaunchKernelGGL(mega, dim3(grid), dim3(NTHREADS), LDS_BYTES, stream, p); }
#else
    p.ph_lo = 0; p.ph_hi = NPHASES | (DBG << 8);
    void* args[] = {&p};
    hipError_t e = hipLaunchCooperativeKernel((const void*)mega, dim3(grid), dim3(NTHREADS), args, LDS_BYTES, stream);
    if (e != hipSuccess) fprintf(stderr, "cooperative launch failed: %s (grid %d)\n", hipGetErrorString(e), grid);
#endif
}
```

```cpp
#include <hip/hip_runtime.h>
#include <hip/hip_cooperative_groups.h>
#include <cstdio>
#include <cmath>
namespace cg = cooperative_groups;

#ifndef PROBE_MASK
#define PROBE_MASK 0
#endif
#define LAS __attribute__((address_space(3)))
typedef unsigned short bf16_t;
typedef short bf16x8 __attribute__((ext_vector_type(8)));
typedef float f32x4 __attribute__((ext_vector_type(4)));
typedef unsigned u32x4 __attribute__((ext_vector_type(4)));
typedef unsigned u32x2 __attribute__((ext_vector_type(2)));

constexpr int DM = 1024, MP = 16384, MS = 1024, MT = MP + MS;
constexpr int TP = 2048, TS = 8, NBP = 8, NBS = 128;
constexpr int APROJ = 1792, NPROJ = 3840, DFF = 4096, NCONV = 3072;
constexpr float ALPHA = 1.4142135623730951f;
constexpr int LDS_BYTES = 155648 + 256;
constexpr int NTHREADS = 512;

constexpr size_t WS_WIN = 0;
constexpr size_t WS_WOUT = WS_WIN + (size_t)NPROJ * DM * 2;
constexpr size_t WS_WCIN = WS_WOUT + (size_t)DM * DM * 2;
constexpr size_t WS_WCOUT = WS_WCIN + (size_t)NCONV * DM * 2;
constexpr size_t WS_WUP0 = WS_WCOUT + (size_t)DM * DM * 2;
constexpr size_t WS_WUP1 = WS_WUP0 + (size_t)DFF * DM * 2;
constexpr size_t WS_WDN0 = WS_WUP1 + (size_t)DFF * DM * 2;
constexpr size_t WS_WDN1 = WS_WDN0 + (size_t)DFF * DM * 2;
constexpr size_t WS_ACT = WS_WDN1 + (size_t)DFF * DM * 2;
constexpr size_t WS_BIG = WS_ACT + (size_t)MT * DM * 2;
constexpr size_t WS_ROPE = WS_BIG + (size_t)MT * DFF * 2;
constexpr size_t WS_END = WS_ROPE + (size_t)2056 * 32 * 8;

constexpr size_t WS_R3 = (WS_END + 255) & ~(size_t)255;
constexpr size_t WS_STAMP = WS_R3 + (size_t)2048 * 8192;
constexpr size_t WS_W2T = WS_STAMP + 256;
constexpr size_t WS_A2T = WS_W2T + 512 * 64 * 2;
constexpr size_t WS_G2T = WS_A2T + 512 * 64 * 2;
constexpr size_t WS_BAR = WS_G2T + 512 * 128 * 2;
constexpr size_t WS_END2 = WS_BAR + 3456 * 4;

constexpr size_t O_Y = 0;
constexpr size_t O_PSHIFT = (size_t)MT * DM;
constexpr size_t O_PWKV = O_PSHIFT + (size_t)NBP * APROJ;
constexpr size_t O_PRET = O_PWKV + (size_t)NBP * 8 * 4096;
constexpr size_t O_PCONV = O_PRET + (size_t)NBP * 8 * 4096;
constexpr size_t O_SSHIFT = O_PCONV + (size_t)NBP * 2 * DM;
constexpr size_t O_SWKV = O_SSHIFT + (size_t)NBS * APROJ;
constexpr size_t O_SRET = O_SWKV + (size_t)NBS * 8 * 4096;
constexpr size_t O_SCONV = O_SRET + (size_t)NBS * 8 * 4096;

struct Params { const float* in[30]; float* out; unsigned char* ws; int ph_lo, ph_hi; double inv_freq[32]; };

__device__ __forceinline__ float bf2f(bf16_t b) { return __uint_as_float(((unsigned)b) << 16); }
typedef __bf16 bf16x2_t __attribute__((ext_vector_type(2)));
typedef float f32x2_t __attribute__((ext_vector_type(2)));
__device__ __forceinline__ unsigned cvt_pk_bf16(float lo, float hi) { const f32x2_t v = {lo, hi}; const bf16x2_t b = __builtin_convertvector(v, bf16x2_t); return __builtin_bit_cast(unsigned, b); }
template <int CTRL> __device__ __forceinline__ float dpp_mov(float v) { return __int_as_float(__builtin_amdgcn_update_dpp(0, __float_as_int(v), CTRL, 0xF, 0xF, false)); }
__device__ __forceinline__ float row16_sum(float v) {
    v += dpp_mov<0xB1>(v); v += dpp_mov<0x4E>(v); v += dpp_mov<0x124>(v); v += dpp_mov<0x128>(v); return v;
}
__device__ __forceinline__ float wave_sum(float v) { v = row16_sum(v); v += __shfl_xor(v, 16); v += __shfl_xor(v, 32); return v; }

namespace pg8 {
constexpr int BM = 256, BK = 64, HALF = 128, HTB = HALF * BK * 2, STAGE_BYTES = 8 * HTB, NXCD = 8, WGM = 8;
__device__ __forceinline__ int lds_byte(int r, int c) { const int st = (r >> 4) * 2 + (c >> 5), rr = r & 15, cc = c & 31, ob = rr * 64 + cc * 2; return st * 1024 + (ob ^ (((ob >> 9) & 1) << 5)); }
__device__ __forceinline__ void stage_rc(int b, int& R, int& C) { const int st = b / 1024, sb = b % 1024, swz = sb ^ (((sb >> 9) & 1) << 5); R = (st >> 1) * 16 + swz / 64; C = (st & 1) * 32 + (swz % 64) / 2; }
__device__ __forceinline__ int perm32(int rho) { const int n = rho >> 4, i = rho & 15; return 8 * (i >> 2) + 4 * n + (i & 3); }
struct Unit { int pm, pn; };
struct Gemm { const bf16_t* A; const bf16_t* Bt; int M, N, K; };
struct StaticOrder {
    int nM, nN, nwg, G, c, lim;
    __device__ void init(int M, int N, int G_, int c_) { nM = M / BM; nN = N / BM; nwg = nM * nN; G = G_; c = c_; lim = nwg; }
    __device__ void map(int L, Unit& u) const {
        int wgid = L; { const int q = nwg / NXCD, r = nwg % NXCD, xcd = wgid % NXCD, off = wgid / NXCD; wgid = (xcd < r ? xcd * (q + 1) : r * (q + 1) + (xcd - r) * q) + off; }
        const int nig = WGM * nN, gid = wgid / nig, fm = gid * WGM, gsz = (nM - fm) < WGM ? (nM - fm) : WGM;
        u.pm = fm + ((wgid % nig) % gsz); u.pn = (wgid % nig) / gsz;
    }
    __device__ bool next(int i, Unit& u) const { const long L = (long)i * G + c; if (L >= lim) return false; map((int)L, u); return true; }
};

struct Epi {
    int mode; bf16_t* O; int ldc; const float* xlo; const float* xhi; float* Z;
    __device__ __forceinline__ void operator()(const f32x4 (&acc)[2][2][4][2], const Unit& u, int wr, int wc, int fr, int fq) const {
        if (mode < 2) {
            const int row0 = u.pm * BM + wr * 64 + fr; const int col0 = u.pn * BM + wc * 32 + 8 * fq;
            const float lowclamp = mode == 1 ? 0.f : -3.0e38f;
#pragma unroll
            for (int ai = 0; ai < 2; ++ai)
#pragma unroll
                for (int m = 0; m < 4; ++m) { bf16_t* rowp = O + (size_t)(row0 + ai * HALF + m * 16) * ldc + col0;
#pragma unroll
                    for (int bj = 0; bj < 2; ++bj) { f32x4 v0 = acc[ai][bj][m][0], v1 = acc[ai][bj][m][1];
                        if (mode == 1) {
#pragma unroll
                            for (int j = 0; j < 4; ++j) { const float a = fmaxf(v0[j], lowclamp), b = fmaxf(v1[j], lowclamp); v0[j] = a * a; v1[j] = b * b; } }
                        u32x4 w; w.x = cvt_pk_bf16(v0[0], v0[1]); w.y = cvt_pk_bf16(v0[2], v0[3]); w.z = cvt_pk_bf16(v1[0], v1[1]); w.w = cvt_pk_bf16(v1[2], v1[3]);
                        *(u32x4*)(rowp + bj * HALF) = w; } }
        } else {
            const int row0 = u.pm * BM + wr * 64 + fr, col0 = u.pn * BM + wc * 32 + 4 * fq;
            const float* X = (u.pm * BM < MP) ? xlo : xhi;
#pragma unroll
            for (int ai = 0; ai < 2; ++ai)
#pragma unroll
                for (int mp = 0; mp < 2; ++mp) {
                    f32x4 x[2][2][2];
#pragma unroll
                    for (int mm = 0; mm < 2; ++mm) { const size_t off = (size_t)(row0 + ai * HALF + (mp * 2 + mm) * 16) * DM + col0;
#pragma unroll
                        for (int bj = 0; bj < 2; ++bj)
#pragma unroll
                            for (int n = 0; n < 2; ++n) x[mm][bj][n] = *(const f32x4*)(X + off + bj * HALF + n * 16); }
#pragma unroll
                    for (int mm = 0; mm < 2; ++mm) { const int m = mp * 2 + mm; const size_t off = (size_t)(row0 + ai * HALF + m * 16) * DM + col0;
#pragma unroll
                        for (int bj = 0; bj < 2; ++bj)
#pragma unroll
                            for (int n = 0; n < 2; ++n) *(f32x4*)(Z + off + bj * HALF + n * 16) = x[mm][bj][n] * ALPHA + acc[ai][bj][m][n]; }
                    asm volatile("" ::: "memory"); }
        }
    }
};

template <class Sched>
__device__ __forceinline__ void gemm_phase(LAS unsigned char* lds, const Gemm g, const Sched& S, const Epi& E, const int tid) {
    const bool PERM = E.mode < 2;
    const int wid = __builtin_amdgcn_readfirstlane(tid >> 6), lane = tid & 63, wr = wid >> 2, wc = wid & 3, fr = lane & 15, fq = lane >> 4;
    const int K = g.K, nt = K / BK;
    unsigned voffA[2], voffB[2];
#pragma unroll
    for (int i = 0; i < 2; ++i) { int R, C; stage_rc(tid * 16 + i * 8192, R, C); const int Rb = PERM ? ((R & ~31) + perm32(R & 31)) : R;
        voffA[i] = (unsigned)(R * K + C) * 2u; voffB[i] = (unsigned)(Rb * K + C) * 2u; }
    const size_t kstep = (size_t)(BK * 2);
    const size_t hstep = (size_t)HALF * K * 2;
    const size_t tstep = 2 * hstep;
    const unsigned ldsw = (unsigned)wid * 1024u;
    const int aoff = lds_byte(wr * 64 + fr, fq * 8), boff = lds_byte(wc * 32 + fr, fq * 8);
#define PG8_SA(b, h) (((b) * 2 + (h)) * HTB)
#define PG8_SB(b, h) ((4 + (b) * 2 + (h)) * HTB)
#define PG8_STAGE(bufoff, gbase, voff) do { _Pragma("unroll") for (int _i = 0; _i < 2; ++_i) \
        __builtin_amdgcn_global_load_lds((const unsigned*)((const char*)(gbase) + (voff)[_i]), (LAS unsigned*)(lds + (bufoff) + ldsw + _i * 8192), 16, 0, 0); } while (0)
#define PG8_LDA(dst, b, h) do { _Pragma("unroll") for (int m = 0; m < 4; ++m) _Pragma("unroll") for (int k = 0; k < 2; ++k) dst[m][k] = *(const LAS bf16x8*)(lds + PG8_SA(b, h) + aoff + m * 2048 + k * 1024); } while (0)
#define PG8_LDB(dst, b, h) do { _Pragma("unroll") for (int n = 0; n < 2; ++n) _Pragma("unroll") for (int k = 0; k < 2; ++k) dst[n][k] = *(const LAS bf16x8*)(lds + PG8_SB(b, h) + boff + n * 2048 + k * 1024); } while (0)
#define PG8_MMA(ai, bj, At, Bt) do { __builtin_amdgcn_s_setprio(1); _Pragma("unroll") for (int m = 0; m < 4; ++m) _Pragma("unroll") for (int n = 0; n < 2; ++n) _Pragma("unroll") for (int k = 0; k < 2; ++k) \
        acc[ai][bj][m][n] = __builtin_amdgcn_mfma_f32_16x16x32_bf16(Bt[n][k], At[m][k], acc[ai][bj][m][n], 0, 0, 0); __builtin_amdgcn_s_setprio(0); } while (0)
#define PG8_WAIT_V(n) asm volatile("s_waitcnt vmcnt(" #n ")" ::: "memory")
#define PG8_WAIT_L(n) asm volatile("s_waitcnt lgkmcnt(" #n ")" ::: "memory")
#define PG8_BAR __builtin_amdgcn_s_barrier()
#define PG8_SCHED __builtin_amdgcn_sched_barrier(0)
    Unit cur, nxt; int ui = 0;
    if (!S.next(0, cur)) return;
    f32x4 acc[2][2][4][2];
#pragma unroll
    for (int a = 0; a < 2; ++a)
#pragma unroll
        for (int b = 0; b < 2; ++b)
#pragma unroll
            for (int m = 0; m < 4; ++m)
#pragma unroll
                for (int n = 0; n < 2; ++n) acc[a][b][m][n] = (f32x4){0.f, 0.f, 0.f, 0.f};
    bf16x8 At[4][2], B0[2][2], B1[2][2];
    const char* cA = (const char*)g.A + (size_t)cur.pm * tstep; const char* cB = (const char*)g.Bt + (size_t)cur.pn * tstep;
    PG8_STAGE(PG8_SB(0, 0), cB, voffB); PG8_STAGE(PG8_SA(0, 0), cA, voffA); PG8_STAGE(PG8_SB(0, 1), cB + hstep, voffB); PG8_STAGE(PG8_SA(0, 1), cA + hstep, voffA);
    if (wr == 1) PG8_BAR;
    PG8_WAIT_V(4); PG8_BAR;
    PG8_STAGE(PG8_SB(1, 0), cB + kstep, voffB); PG8_STAGE(PG8_SA(1, 0), cA + kstep, voffA); PG8_STAGE(PG8_SB(1, 1), cB + hstep + kstep, voffB);
    PG8_WAIT_V(6); PG8_BAR;
    for (;;) {
        const bool has_next = S.next(ui + 1, nxt);
        const char* nA = has_next ? (const char*)g.A + (size_t)nxt.pm * tstep : cA; const char* nB = has_next ? (const char*)g.Bt + (size_t)nxt.pn * tstep : cB;
        for (int t = 0; t < nt; t += 2) {
            const bool last = (t == nt - 2);
            const char* a1 = cA + (size_t)(t + 1) * kstep;
            const char* a2 = last ? nA : cA + (size_t)(t + 2) * kstep; const char* b2 = last ? nB : cB + (size_t)(t + 2) * kstep;
            const char* a3 = a2 + kstep; const char* b3 = b2 + kstep;
            PG8_LDB(B0, 0, 0); PG8_SCHED; PG8_LDA(At, 0, 0); PG8_STAGE(PG8_SA(1, 1), a1 + hstep, voffA);
            PG8_WAIT_L(8); PG8_BAR; PG8_WAIT_L(0); PG8_MMA(0, 0, At, B0); PG8_BAR; PG8_SCHED;
            PG8_LDB(B1, 0, 1); PG8_STAGE(PG8_SB(0, 0), b2, voffB);
            PG8_BAR; PG8_WAIT_L(0); PG8_MMA(0, 1, At, B1); PG8_BAR;
            PG8_LDA(At, 0, 1); PG8_STAGE(PG8_SA(0, 0), a2, voffA);
            PG8_BAR; PG8_WAIT_L(0); PG8_MMA(1, 0, At, B0); PG8_BAR; PG8_SCHED;
            PG8_STAGE(PG8_SB(0, 1), b2 + hstep, voffB);
            PG8_WAIT_V(6); PG8_BAR; PG8_MMA(1, 1, At, B1); PG8_BAR;
            PG8_LDB(B0, 1, 0); PG8_SCHED; PG8_LDA(At, 1, 0); PG8_STAGE(PG8_SA(0, 1), a2 + hstep, voffA);
            PG8_WAIT_L(8); PG8_BAR; PG8_WAIT_L(0); PG8_MMA(0, 0, At, B0); PG8_BAR; PG8_SCHED;
            PG8_LDB(B1, 1, 1); PG8_STAGE(PG8_SB(1, 0), b3, voffB);
            PG8_BAR; PG8_WAIT_L(0); PG8_MMA(0, 1, At, B1); PG8_BAR;
            PG8_LDA(At, 1, 1); PG8_STAGE(PG8_SA(1, 0), a3, voffA);
            PG8_BAR; PG8_WAIT_L(0); PG8_MMA(1, 0, At, B0); PG8_BAR; PG8_SCHED;
            PG8_STAGE(PG8_SB(1, 1), b3 + hstep, voffB);
            PG8_WAIT_V(6); PG8_BAR; PG8_MMA(1, 1, At, B1); PG8_BAR;
        }
        E(acc, cur, wr, wc, fr, fq);
        if (!has_next) break;
#pragma unroll
        for (int a = 0; a < 2; ++a)
#pragma unroll
            for (int b = 0; b < 2; ++b)
#pragma unroll
                for (int m = 0; m < 4; ++m)
#pragma unroll
                    for (int n = 0; n < 2; ++n) acc[a][b][m][n] = (f32x4){0.f, 0.f, 0.f, 0.f};
        cur = nxt; cA = nA; cB = nB; ++ui;
    }
    PG8_WAIT_V(0);
    if (wr == 0) PG8_BAR;
    PG8_BAR;
#undef PG8_SA
#undef PG8_SB
#undef PG8_STAGE
#undef PG8_LDA
#undef PG8_LDB
#undef PG8_MMA
#undef PG8_WAIT_V
#undef PG8_WAIT_L
#undef PG8_BAR
#undef PG8_SCHED
}
}

__device__ __forceinline__ void gemm64_resid(LAS unsigned char* lds, const bf16_t* A, const bf16_t* Bt, const int K, const int row0, const int col0, const float* X, float* Z, const int tid) {
    const int wave = tid >> 6, lane = tid & 63, fr = lane & 15, fq = lane >> 4;
    const int kper = K >> 3;
    f32x4 acc[4][4];
#pragma unroll
    for (int m = 0; m < 4; ++m)
#pragma unroll
        for (int n = 0; n < 4; ++n) acc[m][n] = (f32x4){0.f, 0.f, 0.f, 0.f};
    const bf16_t* Ap = A + (size_t)(row0 + fr) * K + wave * kper + fq * 8;
    const bf16_t* Bp = Bt + (size_t)(col0 + fr) * K + wave * kper + fq * 8;
    const size_t rs16 = (size_t)16 * K;
#pragma unroll 2
    for (int ks = 0; ks < (kper >> 5); ++ks) {
        bf16x8 a[4], b[4];
#pragma unroll
        for (int m = 0; m < 4; ++m) { a[m] = *(const bf16x8*)(Ap + m * rs16 + ks * 32); b[m] = *(const bf16x8*)(Bp + m * rs16 + ks * 32); }
#pragma unroll
        for (int m = 0; m < 4; ++m)
#pragma unroll
            for (int n = 0; n < 4; ++n) acc[m][n] = __builtin_amdgcn_mfma_f32_16x16x32_bf16(a[m], b[n], acc[m][n], 0, 0, 0);
    }
    LAS unsigned char* part = lds + wave * (64 * 272);
#pragma unroll
    for (int m = 0; m < 4; ++m)
#pragma unroll
        for (int n = 0; n < 4; ++n)
#pragma unroll
            for (int jj = 0; jj < 4; ++jj) *(LAS float*)(part + (m * 16 + fq * 4 + jj) * 272 + (n * 16 + fr) * 4) = acc[m][n][jj];
    __syncthreads();
    { const int r = tid >> 3, c8 = (tid & 7) * 8; f32x4 s0 = (f32x4){0.f, 0.f, 0.f, 0.f}, s1 = s0;
#pragma unroll
      for (int w = 0; w < 8; ++w) { s0 += *(const LAS f32x4*)(lds + w * (64 * 272) + r * 272 + c8 * 4); s1 += *(const LAS f32x4*)(lds + w * (64 * 272) + r * 272 + c8 * 4 + 16); }
      const size_t off = (size_t)(row0 + r) * DM + col0 + c8;
      const f32x4 x0 = *(const f32x4*)(X + off), x1 = *(const f32x4*)(X + off + 4);
      *(f32x4*)(Z + off) = x0 * ALPHA + s0; *(f32x4*)(Z + off + 4) = x1 * ALPHA + s1; }
    __syncthreads();
}

__device__ __forceinline__ void phase_convert(const Params& p, float* L, const int tid, const int bid, const int G, const int tile_lo, const int tile_hi, const bool misc) {
    for (int tB = tile_lo + bid * 4; tB < tile_hi; tB += G * 4) {
        float4 v[4][2]; bf16_t* wt[4]; int kk[4], kb[4], nb[4];
#pragma unroll
        for (int q = 0; q < 4; ++q) { const int tI = tB + q; wt[q] = nullptr; kk[q] = 0; kb[q] = 0; nb[q] = 0;
            if (tI < tile_hi) {
                int j = tI; const float* W; bf16_t* Wt; int K, N;
                if (j < 960) { W = p.in[6]; Wt = (bf16_t*)(p.ws + WS_WIN); K = DM; N = NPROJ; }
                else if ((j -= 960) < 256) { W = p.in[20]; Wt = (bf16_t*)(p.ws + WS_WOUT); K = DM; N = DM; }
                else if ((j -= 256) < 768) { W = p.in[21]; Wt = (bf16_t*)(p.ws + WS_WCIN); K = DM; N = NCONV; }
                else if ((j -= 768) < 256) { W = p.in[23]; Wt = (bf16_t*)(p.ws + WS_WCOUT); K = DM; N = DM; }
                else if ((j -= 256) < 1024) { W = p.in[28]; Wt = (bf16_t*)(p.ws + WS_WUP0); K = DM; N = DFF; }
                else if ((j -= 1024) < 1024) { W = p.in[28] + (size_t)DM * DFF; Wt = (bf16_t*)(p.ws + WS_WUP1); K = DM; N = DFF; }
                else if ((j -= 1024) < 1024) { W = p.in[29]; Wt = (bf16_t*)(p.ws + WS_WDN0); K = DFF; N = DM; }
                else { j -= 1024; W = p.in[29] + (size_t)DM * DFF; Wt = (bf16_t*)(p.ws + WS_WDN1); K = DFF; N = DM; }
                const int tn = N / 64, k0 = (j / tn) * 64, n0 = (j % tn) * 64;
                wt[q] = Wt; kk[q] = K; kb[q] = k0; nb[q] = n0;
#pragma unroll
                for (int i = 0; i < 2; ++i) { const int e = tid + i * 512, r = e >> 4, c4 = e & 15; v[q][i] = *(const float4*)(W + (size_t)(k0 + r) * N + n0 + c4 * 4); } } }
#pragma unroll
        for (int q = 0; q < 4; ++q) if (wt[q]) {
#pragma unroll
            for (int i = 0; i < 2; ++i) { const int e = tid + i * 512, r = e >> 4, c4 = e & 15; float* d = L + q * 4160 + r * 65 + c4 * 4; d[0] = v[q][i].x; d[1] = v[q][i].y; d[2] = v[q][i].z; d[3] = v[q][i].w; } }
        __syncthreads();
#pragma unroll
        for (int q = 0; q < 4; ++q) if (wt[q]) { const int n = tid >> 3, k8 = tid & 7; float f[8];
#pragma unroll
            for (int z = 0; z < 8; ++z) f[z] = L[q * 4160 + (k8 * 8 + z) * 65 + n];
            u32x4 w; w.x = cvt_pk_bf16(f[0], f[1]); w.y = cvt_pk_bf16(f[2], f[3]); w.z = cvt_pk_bf16(f[4], f[5]); w.w = cvt_pk_bf16(f[6], f[7]);
            *(u32x4*)(wt[q] + (size_t)(nb[q] + n) * kk[q] + kb[q] + k8 * 8) = w; }
        __syncthreads();
    }
    if (!misc) return;
    { bf16_t* xb = (bf16_t*)(p.ws + WS_ACT);
      const size_t n8 = (size_t)MT * DM / 8, np8 = (size_t)MP * DM / 8;
      for (size_t i = (size_t)bid * NTHREADS + tid; i < n8; i += (size_t)G * NTHREADS) {
          const float* src = (i < np8) ? p.in[0] + i * 8 : p.in[1] + (i - np8) * 8;
          const float4 a = *(const float4*)src, b = *(const float4*)(src + 4);
          u32x4 w; w.x = cvt_pk_bf16(a.x, a.y); w.y = cvt_pk_bf16(a.z, a.w); w.z = cvt_pk_bf16(b.x, b.y); w.w = cvt_pk_bf16(b.z, b.w);
          *(u32x4*)(xb + i * 8) = w; } }
    { bf16_t* w2t = (bf16_t*)(p.ws + WS_W2T); bf16_t* a2t = (bf16_t*)(p.ws + WS_A2T); bf16_t* g2t = (bf16_t*)(p.ws + WS_G2T);
      for (int i = bid * NTHREADS + tid; i < 512 * 256; i += G * NTHREADS) { const int c = i >> 8, j = i & 255;
          if (j < 64) w2t[c * 64 + j] = (bf16_t)(cvt_pk_bf16(p.in[9][j * 512 + c], 0.f) & 0xffffu);
          else if (j < 128) a2t[c * 64 + (j - 64)] = (bf16_t)(cvt_pk_bf16(p.in[11][(j - 64) * 512 + c], 0.f) & 0xffffu);
          else g2t[c * 128 + (j - 128)] = (bf16_t)(cvt_pk_bf16(p.in[12][(j - 128) * 512 + c], 0.f) & 0xffffu); } }
    { float2* rope = (float2*)(p.ws + WS_ROPE);
      for (int i = bid * NTHREADS + tid; i < 2056 * 32; i += G * NTHREADS) {
          const int pidx = i >> 5, f = i & 31; const double pos = (double)(pidx < 2048 ? pidx : 16384 + (pidx - 2048));
          double rev = pos * p.inv_freq[f] * 0.15915494309189535; rev -= rint(rev);
          const float fr = (float)rev;
          rope[i] = make_float2(__builtin_amdgcn_cosf(fr), __builtin_amdgcn_sinf(fr)); } }
}

__device__ __forceinline__ void st_lds_bf16(LAS unsigned char* base, int byteoff, float v) { *(LAS bf16_t*)(base + byteoff) = (bf16_t)(cvt_pk_bf16(v, 0.f) & 0xffffu); }
constexpr int LRS = 528;
constexpr int S_LIN = 30720, S_AW = S_LIN + 16 * 528, S_AA = S_AW + 2048, S_AG = S_AA + 2048;
__device__ __forceinline__ void phase_sample(const Params& p, LAS unsigned char* lds, const int tid_in, const int bid, const int G) {
    const bf16_t* proj = (const bf16_t*)(p.ws + WS_BIG);
    bf16_t* ycat = (bf16_t*)(p.ws + WS_ACT);
    const float2* rope = (const float2*)(p.ws + WS_ROPE);
    const float* mu = p.in[7];
    LAS float* lora = (LAS float*)lds;
    LAS float* sc_r = lora + 2048; LAS float* sc_w = sc_r + 512; LAS float* sc_k = sc_w + 512; LAS float* sc_v = sc_k + 512; LAS float* sc_a = sc_v + 512; LAS float* sc_b = sc_a + 512;
    LAS float* rt_q = sc_b + 512; LAS float* rt_k = rt_q + 512; LAS float* rt_v = rt_k + 512; LAS float* o_w = rt_v + 512; LAS float* o_r = o_w + 512;
    for (int it = bid; it < NBS * 8; it += G) {
        int tid = tid_in; asm volatile("" : "+v"(tid));
        const int lane = tid & 63, wave = tid >> 6, c = lane, t = wave;
        const int b = it >> 3, h = it & 7, hc = h * 64; const unsigned hcc = (unsigned)(hc + c);
        const int rowbase = MP + b * TS;
        const float* shift0 = p.in[2] + (size_t)b * APROJ;
#pragma unroll
        for (int q = 0; q < 4; ++q) { const int idx = tid + q * NTHREADS; const int tt = idx >> 8, j = idx & 255; const unsigned col = 1536u + (unsigned)j; const unsigned ro = (unsigned)(rowbase + tt) * (unsigned)NPROJ;
            const float pc = bf2f(proj[ro + col]); const float pp = (tt == 0) ? shift0[col] : bf2f(proj[ro - (unsigned)NPROJ + col]);
            const float m = pc + (pp - pc) * mu[col];
            st_lds_bf16(lds + S_LIN, tt * LRS + j * 2, j < 64 ? (1.0f - 2.0f / (__expf(2.0f * m) + 1.0f)) : (j < 128 ? m : 1.0f / (1.0f + __expf(-m)))); }
        float mr, mk, mv, qg;
        { const unsigned ro = (unsigned)(rowbase + t) * (unsigned)NPROJ; const unsigned rp = ro - (unsigned)NPROJ; const bool first = (t == 0);
          { const float pc = bf2f(proj[ro + hcc]); const float pp = first ? shift0[hcc] : bf2f(proj[rp + hcc]); mr = pc + (pp - pc) * mu[hcc]; }
          { const float pc = bf2f(proj[ro + 512u + hcc]); const float pp = first ? shift0[512u + hcc] : bf2f(proj[rp + 512u + hcc]); mk = pc + (pp - pc) * mu[512u + hcc]; }
          { const float pc = bf2f(proj[ro + 1024u + hcc]); const float pp = first ? shift0[1024u + hcc] : bf2f(proj[rp + 1024u + hcc]); mv = pc + (pp - pc) * mu[1024u + hcc]; }
          const float2 cs = rope[(unsigned)(2048 + t) * 32u + (unsigned)(c & 31)]; const float sgn = (c < 32) ? -1.f : 1.f; const unsigned hco = (unsigned)(hc + (c ^ 32));
          const float qs = bf2f(proj[ro + (unsigned)APROJ + hcc]), qo = bf2f(proj[ro + (unsigned)APROJ + hco]);
          const float ks = bf2f(proj[ro + (unsigned)(APROJ + 512) + hcc]), ko = bf2f(proj[ro + (unsigned)(APROJ + 512) + hco]);
          rt_q[t * 64 + c] = qs * cs.x + sgn * qo * cs.y; rt_k[t * 64 + c] = (ks * cs.x + sgn * ko * cs.y) * 0.125f;
          rt_v[t * 64 + c] = bf2f(proj[ro + (unsigned)(APROJ + 1024) + hcc]); qg = bf2f(proj[ro + (unsigned)(APROJ + 1536) + hcc]); }
        __syncthreads();
        float gv, bonus;
        { const int fr = lane & 15, fq = lane >> 4, nt = wave & 3; const unsigned cr = (unsigned)(hc + nt * 16 + fr);
          const bf16_t* w2t = (const bf16_t*)(p.ws + WS_W2T); const bf16_t* a2t = (const bf16_t*)(p.ws + WS_A2T); const bf16_t* g2t = (const bf16_t*)(p.ws + WS_G2T);
          if (wave < 4) { f32x4 dw = (f32x4){0.f, 0.f, 0.f, 0.f}, da = dw;
#pragma unroll
              for (int ks = 0; ks < 2; ++ks) { const bf16x8 x0 = *(const LAS bf16x8*)(lds + S_LIN + fr * LRS + (ks * 32 + fq * 8) * 2), x1 = *(const LAS bf16x8*)(lds + S_LIN + fr * LRS + (64 + ks * 32 + fq * 8) * 2);
                  dw = __builtin_amdgcn_mfma_f32_16x16x32_bf16(x0, *(const bf16x8*)(w2t + cr * 64u + (unsigned)(ks * 32 + fq * 8)), dw, 0, 0, 0);
                  da = __builtin_amdgcn_mfma_f32_16x16x32_bf16(x1, *(const bf16x8*)(a2t + cr * 64u + (unsigned)(ks * 32 + fq * 8)), da, 0, 0, 0); }
              if (fq < 2) {
#pragma unroll
                  for (int jj = 0; jj < 4; ++jj) { *(LAS float*)(lds + S_AW + (fq * 4 + jj) * 256 + (nt * 16 + fr) * 4) = dw[jj]; *(LAS float*)(lds + S_AA + (fq * 4 + jj) * 256 + (nt * 16 + fr) * 4) = da[jj]; } } }
          else { f32x4 dg = (f32x4){0.f, 0.f, 0.f, 0.f};
#pragma unroll
              for (int ks = 0; ks < 4; ++ks) { const bf16x8 x2 = *(const LAS bf16x8*)(lds + S_LIN + fr * LRS + (128 + ks * 32 + fq * 8) * 2);
                  dg = __builtin_amdgcn_mfma_f32_16x16x32_bf16(x2, *(const bf16x8*)(g2t + cr * 128u + (unsigned)(ks * 32 + fq * 8)), dg, 0, 0, 0); }
              if (fq < 2) {
#pragma unroll
                  for (int jj = 0; jj < 4; ++jj) *(LAS float*)(lds + S_AG + (fq * 4 + jj) * 256 + (nt * 16 + fr) * 4) = dg[jj]; } } }
        __syncthreads();
        { const float aw = p.in[8][hcc] + *(const LAS float*)(lds + S_AW + t * 256 + c * 4), aa = p.in[10][hcc] + *(const LAS float*)(lds + S_AA + t * 256 + c * 4), ag = *(const LAS float*)(lds + S_AG + t * 256 + c * 4);
          const float z = -aw; const float sp = fmaxf(z, 0.f) + log1pf(__expf(-fabsf(z)));
          const float decay = __expf(-__expf(-sp - 0.5f));
          const float al = 1.0f / (1.0f + __expf(-aa));
          const float kkr = mk * p.in[13][hcc]; const float ss = wave_sum(kkr * kkr); const float kk = kkr * rsqrtf(fmaxf(ss, 1e-24f));
          const float kp = mk * (1.0f + (al - 1.0f) * p.in[14][hcc]);
          bonus = wave_sum(mr * kp * p.in[15][hcc]); gv = ag;
          sc_r[t * 64 + c] = mr; sc_w[t * 64 + c] = decay; sc_k[t * 64 + c] = kp; sc_v[t * 64 + c] = mv; sc_a[t * 64 + c] = -kk; sc_b[t * 64 + c] = kk * al; }
        __syncthreads();
        { const int wv = wave & 3, rloc = lane >> 2, kc = lane & 3, row = wv * 16 + rloc;
          float St[16];
          if (wave < 4) {
              const float* src = p.in[3] + (size_t)(b * 8 + h) * 4096 + (unsigned)(row * 64 + kc * 16);
#pragma unroll
              for (int i4 = 0; i4 < 4; ++i4) { const f32x4 v4 = *(const f32x4*)(src + i4 * 4); St[i4 * 4] = v4[0]; St[i4 * 4 + 1] = v4[1]; St[i4 * 4 + 2] = v4[2]; St[i4 * 4 + 3] = v4[3]; }
              for (int s = 0; s < TS; ++s) {
                  const LAS f32x4* A4 = (const LAS f32x4*)(sc_a + s * 64 + kc * 16); const LAS f32x4* W4 = (const LAS f32x4*)(sc_w + s * 64 + kc * 16); const LAS f32x4* B4 = (const LAS f32x4*)(sc_b + s * 64 + kc * 16);
                  const LAS f32x4* K4 = (const LAS f32x4*)(sc_k + s * 64 + kc * 16); const LAS f32x4* R4 = (const LAS f32x4*)(sc_r + s * 64 + kc * 16);
                  float sa = 0.f;
#pragma unroll
                  for (int i4 = 0; i4 < 4; ++i4) { const f32x4 a = A4[i4]; sa += (St[i4 * 4] * a[0] + St[i4 * 4 + 1] * a[1]) + (St[i4 * 4 + 2] * a[2] + St[i4 * 4 + 3] * a[3]); }
                  sa += dpp_mov<0xB1>(sa); sa += dpp_mov<0x4E>(sa);
                  const float vv = sc_v[s * 64 + row]; float o = 0.f;
#pragma unroll
                  for (int i4 = 0; i4 < 4; ++i4) { const f32x4 w = W4[i4], bb = B4[i4], kq = K4[i4], r = R4[i4];
#pragma unroll
                      for (int q = 0; q < 4; ++q) { St[i4 * 4 + q] = St[i4 * 4 + q] * w[q] + sa * bb[q] + vv * kq[q]; o += St[i4 * 4 + q] * r[q]; } }
                  o += dpp_mov<0xB1>(o); o += dpp_mov<0x4E>(o);
                  if (kc == 0) o_w[s * 64 + row] = o;
              }
              float* dst = p.out + O_SWKV + (size_t)(b * 8 + h) * 4096 + (unsigned)(row * 64 + kc * 16);
#pragma unroll
              for (int i4 = 0; i4 < 4; ++i4) *(f32x4*)(dst + i4 * 4) = (f32x4){St[i4 * 4], St[i4 * 4 + 1], St[i4 * 4 + 2], St[i4 * 4 + 3]};
          } else {
              const float gamma = 1.0f - exp2f(-5.0f - (float)h);
              const float* src = p.in[4] + (size_t)(b * 8 + h) * 4096 + (unsigned)(kc * 16 * 64 + row);
#pragma unroll
              for (int i = 0; i < 16; ++i) St[i] = src[i * 64];
              for (int s = 0; s < TS; ++s) {
                  const LAS f32x4* K4 = (const LAS f32x4*)(rt_k + s * 64 + kc * 16); const LAS f32x4* Q4 = (const LAS f32x4*)(rt_q + s * 64 + kc * 16);
                  const float vv = rt_v[s * 64 + row]; float o = 0.f;
#pragma unroll
                  for (int i4 = 0; i4 < 4; ++i4) { const f32x4 kq = K4[i4], q4 = Q4[i4];
#pragma unroll
                      for (int q = 0; q < 4; ++q) { St[i4 * 4 + q] = St[i4 * 4 + q] * gamma + kq[q] * vv; o += St[i4 * 4 + q] * q4[q]; } }
                  o += dpp_mov<0xB1>(o); o += dpp_mov<0x4E>(o);
                  if (kc == 0) o_r[s * 64 + row] = o;
              }
              float* dst = p.out + O_SRET + (size_t)(b * 8 + h) * 4096 + (unsigned)(kc * 16 * 64 + row);
#pragma unroll
              for (int i = 0; i < 16; ++i) dst[i * 64] = St[i];
          } }
        __syncthreads();
        { const unsigned row = (unsigned)(rowbase + t);
          { const float o = o_w[t * 64 + c]; const float mean = wave_sum(o) * (1.f / 64.f); const float d = o - mean; const float var = wave_sum(d * d) * (1.f / 64.f);
            const float ya = (d * rsqrtf(var + 64e-5f) * p.in[16][hcc] + p.in[17][hcc] + bonus * mv) * gv;
            const float ya2 = dpp_mov<0xF5>(ya); if (!(c & 1)) *(unsigned*)(ycat + (row * (unsigned)DM + hcc)) = cvt_pk_bf16(ya, ya2); }
          { const float o = o_r[t * 64 + c]; const float mean = wave_sum(o) * (1.f / 64.f); const float d = o - mean; const float var = wave_sum(d * d) * (1.f / 64.f);
            const float yb = qg / (1.0f + __expf(-qg)) * (d * rsqrtf(var + 1e-5f) * p.in[18][hcc] + p.in[19][hcc]);
            const float yb2 = dpp_mov<0xF5>(yb); if (!(c & 1)) *(unsigned*)(ycat + (row * (unsigned)DM + 512u + hcc)) = cvt_pk_bf16(yb, yb2); } }
        if (h == 0) { float* dst = p.out + O_SSHIFT + (size_t)b * APROJ; const bf16_t* pr = proj + (size_t)(rowbase + TS - 1) * NPROJ;
            for (int j = tid; j < APROJ; j += NTHREADS) dst[j] = bf2f(pr[j]); }
        __syncthreads();
    }
}

constexpr int RS = 144;
constexpr int UNIT = 64 * RS;
constexpr int FRS = 272;
constexpr int U_AT = 0, U_BT = UNIT, U_KT = 2 * UNIT, U_RT = 3 * UNIT, U_VT = 4 * UNIT, U_BH = 5 * UNIT, U_KH = 6 * UNIT;
constexpr int U_LAK = 7 * UNIT, U_MRB = 8 * UNIT, U_MRK = 9 * UNIT, U_PT = 10 * UNIT, U_QT = 11 * UNIT;
constexpr int F_LAB = 12 * UNIT, F_X = F_LAB + 64 * FRS, F_MISC = F_X + 64 * FRS;
constexpr int L_LIN = 7 * UNIT, F_AW = L_LIN + 64 * LRS, F_AA = F_AW + 64 * FRS;
static_assert(F_MISC + 2304 <= LDS_BYTES && F_AA + 64 * FRS <= F_MISC, "LDS map");

__device__ __forceinline__ f32x4 mm2(const LAS unsigned char* A, const LAS unsigned char* B, int arow, int brow, int fq, f32x4 acc) {
#pragma unroll
    for (int ks = 0; ks < 2; ++ks) {
        const bf16x8 a = *(const LAS bf16x8*)(A + arow * RS + (ks * 32 + fq * 8) * 2);
        const bf16x8 b = *(const LAS bf16x8*)(B + brow * RS + (ks * 32 + fq * 8) * 2);
        acc = __builtin_amdgcn_mfma_f32_16x16x32_bf16(a, b, acc, 0, 0, 0);
    }
    return acc;
}
#ifndef SAN
#define SAN 0
#endif
template <int CAT> __device__ __forceinline__ u32x2 pk4c(f32x4 v) { u32x2 w;
    if (SAN & (1 << CAT)) {
#pragma unroll
        for (int q = 0; q < 4; ++q) v[q] = (fabsf(v[q]) <= 3.0e38f) ? v[q] : 0.f; }
    w.x = cvt_pk_bf16(v[0], v[1]); w.y = cvt_pk_bf16(v[2], v[3]); return w; }

__device__ __forceinline__ void phase_mix_local(const Params& p, LAS unsigned char* lds, const int tid_in, const int bid, const int G) {
    bf16_t* proj = (bf16_t*)(p.ws + WS_BIG);
    const float2* rope = (const float2*)(p.ws + WS_ROPE);
    const float* mu = p.in[7];
    for (int item = bid; item < 2048; item += G) {
        int tid = tid_in; asm volatile("" : "+v"(tid));
        const int lane = tid & 63, wave = tid >> 6, fr = lane & 15, fq = lane >> 4;
        const int c = lane, tg = wave;
        const int mt = wave & 3, nt0 = (wave >> 2) * 2;
        const int bh = item >> 5, ch = item & 31, b = bh >> 3, h = bh & 7, hc = h * 64;
        const unsigned hcc = (unsigned)(hc + c);
        const int rowbase = b * TP + ch * 64;
        unsigned char* r1 = p.ws + WS_ACT + (size_t)item * 16384;
        unsigned char* r2 = (unsigned char*)(p.out + O_Y) + (size_t)item * 24576;
        unsigned char* r3 = p.ws + WS_R3 + (size_t)item * 8192;
        {
            const float l2g = log2f(1.0f - exp2f(-5.0f - (float)h));
            float qv[8], kv[8], vv[8];
#pragma unroll
            for (int i = 0; i < 8; ++i) { const int t = tg * 8 + i; const unsigned ro = (unsigned)(rowbase + t) * (unsigned)NPROJ;
                const float2 cs = rope[(unsigned)(ch * 64 + t) * 32u + (unsigned)(c & 31)];
                const float sgn = (c < 32) ? -1.f : 1.f; const unsigned hco = (unsigned)(hc + (c ^ 32));
                const float qs = bf2f(proj[ro + (unsigned)APROJ + hcc]), qo = bf2f(proj[ro + (unsigned)APROJ + hco]);
                const float ks = bf2f(proj[ro + (unsigned)(APROJ + 512) + hcc]), ko = bf2f(proj[ro + (unsigned)(APROJ + 512) + hco]);
                qv[i] = qs * cs.x + sgn * qo * cs.y; kv[i] = (ks * cs.x + sgn * ko * cs.y) * 0.125f; vv[i] = bf2f(proj[ro + (unsigned)(APROJ + 1024) + hcc]); }
            asm volatile("s_waitcnt vmcnt(0)" ::: "memory");
            __syncthreads();
            { float vt[8], kh[8];
#pragma unroll
              for (int i = 0; i < 8; ++i) { const int t = tg * 8 + i; const unsigned ro = (unsigned)(rowbase + t) * (unsigned)NPROJ;
                  const float qd = qv[i] * exp2f(l2g * (float)(t + 1));
                  const unsigned qb = cvt_pk_bf16(qd, 0.f) & 0xffffu;
                  proj[ro + (unsigned)APROJ + hcc] = (bf16_t)qb;
                  *(LAS bf16_t*)(lds + U_RT + t * RS + c * 2) = (bf16_t)qb;
                  st_lds_bf16(lds + U_KT, t * RS + c * 2, kv[i] * exp2f(-l2g * (float)(t + 1)));
                  vt[i] = vv[i]; kh[i] = kv[i] * exp2f(l2g * (float)(63 - t)); }
              u32x4 w; w.x = cvt_pk_bf16(vt[0], vt[1]); w.y = cvt_pk_bf16(vt[2], vt[3]); w.z = cvt_pk_bf16(vt[4], vt[5]); w.w = cvt_pk_bf16(vt[6], vt[7]);
              *(LAS u32x4*)(lds + U_VT + c * RS + tg * 16) = w;
              w.x = cvt_pk_bf16(kh[0], kh[1]); w.y = cvt_pk_bf16(kh[2], kh[3]); w.z = cvt_pk_bf16(kh[4], kh[5]); w.w = cvt_pk_bf16(kh[6], kh[7]);
              *(LAS u32x4*)(lds + U_KH + c * RS + tg * 16) = w; }
            __syncthreads();
#pragma unroll
            for (int n = 0; n < 2; ++n) { const int nt = nt0 + n; f32x4 acc = (f32x4){0.f, 0.f, 0.f, 0.f};
                acc = mm2(lds + U_KT, lds + U_RT, mt * 16 + fr, nt * 16 + fr, fq, acc);
                const int t = nt * 16 + fr, j0 = mt * 16 + fq * 4;
#pragma unroll
                for (int jj = 0; jj < 4; ++jj) if (j0 + jj > t) acc[jj] = 0.f;
                *(LAS u32x2*)(lds + U_MRK + t * RS + j0 * 2) = pk4c<1>(acc); }
            __syncthreads();
#pragma unroll
            for (int n = 0; n < 2; ++n) { const int nt = nt0 + n;
                { f32x4 acc = (f32x4){0.f, 0.f, 0.f, 0.f};
                  acc = mm2(lds + U_VT, lds + U_MRK, mt * 16 + fr, nt * 16 + fr, fq, acc);
                  const int t = nt * 16 + fr, v0 = mt * 16 + fq * 4;
                  *(u32x2*)(proj + (unsigned)(rowbase + t) * (unsigned)NPROJ + (unsigned)(APROJ + 512 + hc + v0)) = pk4c<1>(acc); }
                { f32x4 acc = (f32x4){0.f, 0.f, 0.f, 0.f};
                  acc = mm2(lds + U_KH, lds + U_VT, mt * 16 + fr, nt * 16 + fr, fq, acc);
                  const int v = nt * 16 + fr, k0 = mt * 16 + fq * 4;
                  *(u32x2*)(r3 + v * 128 + k0 * 2) = pk4c<1>(acc); } }
            __syncthreads();
        }
        {
            { const int j = tid & 255, t0 = (tid >> 8) * 32; const unsigned col = 1536u + (unsigned)j; const float muc = mu[col];
              const unsigned ro0 = (unsigned)(rowbase + t0) * (unsigned)NPROJ + col;
              float pv[33];
              pv[0] = (ch == 0 && t0 == 0) ? 0.f : bf2f(proj[ro0 - (unsigned)NPROJ]);
#pragma unroll
              for (int i = 0; i < 32; ++i) pv[i + 1] = bf2f(proj[ro0 + (unsigned)i * (unsigned)NPROJ]);
#pragma unroll
              for (int i = 0; i < 32; ++i) { const float m = pv[i + 1] + (pv[i] - pv[i + 1]) * muc;
                  st_lds_bf16(lds + L_LIN, (t0 + i) * LRS + j * 2, j < 64 ? (1.0f - 2.0f / (__expf(2.0f * m) + 1.0f)) : (j < 128 ? m : 1.0f / (1.0f + __expf(-m)))); } }
            float mr[8], mk[8], mv[8];
            { const float mu_r = mu[hcc], mu_k = mu[512u + hcc], mu_v = mu[1024u + hcc];
#pragma unroll
              for (int i = 0; i < 8; ++i) { const int t = tg * 8 + i; const unsigned ro = (unsigned)(rowbase + t) * (unsigned)NPROJ; const unsigned rp = ro - (unsigned)NPROJ; const bool first = (ch == 0 && t == 0);
                  { const float pc = bf2f(proj[ro + hcc]); const float pp = first ? 0.f : bf2f(proj[rp + hcc]); mr[i] = pc + (pp - pc) * mu_r; }
                  { const float pc = bf2f(proj[ro + 512u + hcc]); const float pp = first ? 0.f : bf2f(proj[rp + 512u + hcc]); mk[i] = pc + (pp - pc) * mu_k; }
                  { const float pc = bf2f(proj[ro + 1024u + hcc]); const float pp = first ? 0.f : bf2f(proj[rp + 1024u + hcc]); mv[i] = pc + (pp - pc) * mu_v; } } }
            __syncthreads();
            { const bf16_t* w2t = (const bf16_t*)(p.ws + WS_W2T); const bf16_t* a2t = (const bf16_t*)(p.ws + WS_A2T); const bf16_t* g2t = (const bf16_t*)(p.ws + WS_G2T);
#pragma unroll
              for (int n = 0; n < 2; ++n) { const int nt = nt0 + n; const unsigned cr = (unsigned)(hc + nt * 16 + fr);
                  f32x4 dw = (f32x4){0.f, 0.f, 0.f, 0.f}, da = dw, dg = dw;
#pragma unroll
                  for (int ks = 0; ks < 2; ++ks) {
                      const bf16x8 x0 = *(const LAS bf16x8*)(lds + L_LIN + (mt * 16 + fr) * LRS + (ks * 32 + fq * 8) * 2), x1 = *(const LAS bf16x8*)(lds + L_LIN + (mt * 16 + fr) * LRS + (64 + ks * 32 + fq * 8) * 2);
                      dw = __builtin_amdgcn_mfma_f32_16x16x32_bf16(x0, *(const bf16x8*)(w2t + cr * 64u + (unsigned)(ks * 32 + fq * 8)), dw, 0, 0, 0);
                      da = __builtin_amdgcn_mfma_f32_16x16x32_bf16(x1, *(const bf16x8*)(a2t + cr * 64u + (unsigned)(ks * 32 + fq * 8)), da, 0, 0, 0); }
#pragma unroll
                  for (int ks = 0; ks < 4; ++ks) { const bf16x8 x2 = *(const LAS bf16x8*)(lds + L_LIN + (mt * 16 + fr) * LRS + (128 + ks * 32 + fq * 8) * 2);
                      dg = __builtin_amdgcn_mfma_f32_16x16x32_bf16(x2, *(const bf16x8*)(g2t + cr * 128u + (unsigned)(ks * 32 + fq * 8)), dg, 0, 0, 0); }
#pragma unroll
                  for (int jj = 0; jj < 4; ++jj) { const int t = mt * 16 + fq * 4 + jj, cc = nt * 16 + fr;
                      *(LAS float*)(lds + F_AW + t * FRS + cc * 4) = dw[jj]; *(LAS float*)(lds + F_AA + t * FRS + cc * 4) = da[jj];
                      *(bf16_t*)(r2 + 8192 + t * 128 + cc * 2) = (bf16_t)(cvt_pk_bf16(dg[jj], 0.f) & 0xffffu); } } }
            __syncthreads();
            float lw[8], kp[8], na[8], bb[8];
            { float aw[8], aa[8];
              const float kkc = p.in[13][hcc], kac = p.in[14][hcc], rkc = p.in[15][hcc], w0c = p.in[8][hcc], a0c = p.in[10][hcc];
#pragma unroll
              for (int i = 0; i < 8; ++i) { const int t = tg * 8 + i; aw[i] = w0c + *(const LAS float*)(lds + F_AW + t * FRS + c * 4); aa[i] = a0c + *(const LAS float*)(lds + F_AA + t * FRS + c * 4); }
              float al8[8], ss8[8], bo8[8], kkr8[8];
#pragma unroll
              for (int i = 0; i < 8; ++i) {
                  const float z = -aw[i]; const float sp = fmaxf(z, 0.f) + log1pf(__expf(-fabsf(z)));
                  lw[i] = -__expf(-sp - 0.5f);
                  al8[i] = 1.0f / (1.0f + __expf(-aa[i]));
                  kkr8[i] = mk[i] * kkc; ss8[i] = kkr8[i] * kkr8[i];
                  kp[i] = mk[i] * (1.0f + (al8[i] - 1.0f) * kac); bo8[i] = mr[i] * kp[i] * rkc; }
#pragma unroll
              for (int i = 0; i < 8; ++i) { ss8[i] = row16_sum(ss8[i]); bo8[i] = row16_sum(bo8[i]); }
#pragma unroll
              for (int o = 16; o <= 32; o <<= 1) {
#pragma unroll
                  for (int i = 0; i < 8; ++i) { ss8[i] += __shfl_xor(ss8[i], o); bo8[i] += __shfl_xor(bo8[i], o); } }
#pragma unroll
              for (int i = 0; i < 8; ++i) { const int t = tg * 8 + i;
                  const float kk = kkr8[i] * rsqrtf(fmaxf(ss8[i], 1e-24f));
                  na[i] = -kk; bb[i] = kk * al8[i];
                  *(bf16_t*)(r2 + 16384 + t * 128 + c * 2) = (bf16_t)(cvt_pk_bf16(bo8[i] * mv[i], 0.f) & 0xffffu); } }
            LAS float* wend = (LAS float*)(lds + F_MISC); LAS float* part = wend + 64;
            float cl[8];
            { float s = 0.f;
#pragma unroll
              for (int i = 0; i < 8; ++i) { s += lw[i]; cl[i] = s; }
              part[tg * 64 + c] = s; }
            __syncthreads();
            float base = 0.f, tot = 0.f;
#pragma unroll
            for (int g8 = 0; g8 < 8; ++g8) { const float pv = part[g8 * 64 + c]; tot += pv; if (g8 < tg) base += pv; }
            if (tg == 0) wend[c] = __expf(tot);
            { float vt[8], bh8[8], kh8[8];
#pragma unroll
              for (int i = 0; i < 8; ++i) { const int t = tg * 8 + i; const float cum = base + cl[i];
                  const float ec = __expf(cum), en = __expf(-cum), eh = __expf(tot - cum);
                  st_lds_bf16(lds + U_AT, t * RS + c * 2, na[i] * __expf(cum - lw[i]));
                  st_lds_bf16(lds + U_BT, t * RS + c * 2, bb[i] * en);
                  st_lds_bf16(lds + U_KT, t * RS + c * 2, kp[i] * en);
                  st_lds_bf16(lds + U_RT, t * RS + c * 2, mr[i] * ec);
                  vt[i] = mv[i]; bh8[i] = bb[i] * eh; kh8[i] = kp[i] * eh; }
              u32x4 w; w.x = cvt_pk_bf16(vt[0], vt[1]); w.y = cvt_pk_bf16(vt[2], vt[3]); w.z = cvt_pk_bf16(vt[4], vt[5]); w.w = cvt_pk_bf16(vt[6], vt[7]);
              *(LAS u32x4*)(lds + U_VT + c * RS + tg * 16) = w;
              w.x = cvt_pk_bf16(bh8[0], bh8[1]); w.y = cvt_pk_bf16(bh8[2], bh8[3]); w.z = cvt_pk_bf16(bh8[4], bh8[5]); w.w = cvt_pk_bf16(bh8[6], bh8[7]);
              *(LAS u32x4*)(lds + U_BH + c * RS + tg * 16) = w;
              w.x = cvt_pk_bf16(kh8[0], kh8[1]); w.y = cvt_pk_bf16(kh8[2], kh8[3]); w.z = cvt_pk_bf16(kh8[4], kh8[5]); w.w = cvt_pk_bf16(kh8[6], kh8[7]);
              *(LAS u32x4*)(lds + U_KH + c * RS + tg * 16) = w; }
            __syncthreads();
#pragma unroll
            for (int n = 0; n < 2; ++n) { const int nt = nt0 + n; const int t = nt * 16 + fr, j0 = mt * 16 + fq * 4; const f32x4 z4 = (f32x4){0.f, 0.f, 0.f, 0.f};
                f32x4 lab = mm2(lds + U_BT, lds + U_AT, mt * 16 + fr, nt * 16 + fr, fq, z4);
                f32x4 lak = mm2(lds + U_KT, lds + U_AT, mt * 16 + fr, nt * 16 + fr, fq, z4);
                f32x4 mrb = mm2(lds + U_BT, lds + U_RT, mt * 16 + fr, nt * 16 + fr, fq, z4);
                f32x4 mrk = mm2(lds + U_KT, lds + U_RT, mt * 16 + fr, nt * 16 + fr, fq, z4);
#pragma unroll
                for (int jj = 0; jj < 4; ++jj) { if (j0 + jj >= t) { lab[jj] = 0.f; lak[jj] = 0.f; } if (j0 + jj > t) { mrb[jj] = 0.f; mrk[jj] = 0.f; } }
                *(LAS f32x4*)(lds + F_LAB + t * FRS + j0 * 4) = lab;
                *(LAS u32x2*)(lds + U_LAK + t * RS + j0 * 2) = pk4c<0>(lak);
                *(LAS u32x2*)(lds + U_MRB + t * RS + j0 * 2) = pk4c<0>(mrb);
                *(LAS u32x2*)(lds + U_MRK + t * RS + j0 * 2) = pk4c<0>(mrk); }
            __syncthreads();
#pragma unroll
            for (int n = 0; n < 2; ++n) { const int nt = nt0 + n; const int t = nt * 16 + fr, v0 = mt * 16 + fq * 4;
                const f32x4 x = mm2(lds + U_VT, lds + U_LAK, mt * 16 + fr, nt * 16 + fr, fq, (f32x4){0.f, 0.f, 0.f, 0.f});
                *(LAS f32x4*)(lds + F_X + t * FRS + v0 * 4) = x; }
            { const int t = tid >> 3, j0 = (tid & 7) * 8;
              const f32x4 l0 = *(const LAS f32x4*)(lds + F_LAB + t * FRS + j0 * 4), l1 = *(const LAS f32x4*)(lds + F_LAB + t * FRS + j0 * 4 + 16);
              u32x4 w; w.x = cvt_pk_bf16(l0[0], l0[1]); w.y = cvt_pk_bf16(l0[2], l0[3]); w.z = cvt_pk_bf16(l1[0], l1[1]); w.w = cvt_pk_bf16(l1[2], l1[3]);
              if ((j0 >> 4) == (t >> 4)) w = (u32x4){0u, 0u, 0u, 0u};
              *(LAS u32x4*)(lds + U_KT + t * RS + j0 * 2) = w;
              for (int i = tid; i < 2 * UNIT / 16; i += NTHREADS) ((LAS u32x4*)(lds + U_PT))[i] = (u32x4){0u, 0u, 0u, 0u}; }
            __syncthreads();
#pragma unroll 1
            for (int bi = 0; bi < 4; ++bi) {
                { const LAS unsigned char* YB = lds + ((wave < 4) ? U_PT : U_QT); const int ntl = wave & 3;
                  f32x4 d = (f32x4){0.f, 0.f, 0.f, 0.f};
                  const int nks = (bi + 1) >> 1;
                  for (int ks = 0; ks < nks; ++ks) { const bf16x8 a = *(const LAS bf16x8*)(lds + U_KT + (bi * 16 + fr) * RS + (ks * 32 + fq * 8) * 2), bq = *(const LAS bf16x8*)(YB + (ntl * 16 + fr) * RS + (ks * 32 + fq * 8) * 2);
                      d = __builtin_amdgcn_mfma_f32_16x16x32_bf16(a, bq, d, 0, 0, 0); }
#pragma unroll
                  for (int jj = 0; jj < 4; ++jj) { const int i = fq * 4 + jj, row = bi * 16 + i;
                      const float rhs = (wave < 4) ? bf2f(*(const LAS bf16_t*)(lds + U_AT + row * RS + (ntl * 16 + fr) * 2)) : *(const LAS float*)(lds + F_X + row * FRS + (ntl * 16 + fr) * 4);
                      *(LAS float*)(lds + U_LAK + i * 528 + (wave * 16 + fr) * 4) = d[jj] + rhs; } }
                __syncthreads();
                if (wave < 2) {
                    LAS unsigned char* dst = lds + (wave == 0 ? U_PT : U_QT) + lane * RS;
                    float acc[16];
#pragma unroll
                    for (int r = 0; r < 16; ++r) acc[r] = *(const LAS float*)(lds + U_LAK + r * 528 + (wave * 64 + lane) * 4);
                    const LAS unsigned char* Ld = lds + F_LAB + (bi * 16) * FRS + bi * 64;
#pragma unroll
                    for (int r = 1; r < 16; ++r) {
#pragma unroll
                        for (int q4 = 0; q4 < (r + 3) / 4; ++q4) { const f32x4 l = *(const LAS f32x4*)(Ld + r * FRS + q4 * 16);
#pragma unroll
                            for (int q = 0; q < 4; ++q) if (q4 * 4 + q < r) acc[r] += l[q] * acc[q4 * 4 + q]; }
                    }
                    u32x4 w; w.x = cvt_pk_bf16(acc[0], acc[1]); w.y = cvt_pk_bf16(acc[2], acc[3]); w.z = cvt_pk_bf16(acc[4], acc[5]); w.w = cvt_pk_bf16(acc[6], acc[7]);
                    *(LAS u32x4*)(dst + bi * 32) = w;
                    w.x = cvt_pk_bf16(acc[8], acc[9]); w.y = cvt_pk_bf16(acc[10], acc[11]); w.z = cvt_pk_bf16(acc[12], acc[13]); w.w = cvt_pk_bf16(acc[14], acc[15]);
                    *(LAS u32x4*)(dst + bi * 32 + 16) = w;
                }
                __syncthreads();
            }
#pragma unroll
            for (int n = 0; n < 2; ++n) { const int nt = nt0 + n; const f32x4 z4 = (f32x4){0.f, 0.f, 0.f, 0.f};
                { f32x4 g4 = mm2(lds + U_PT, lds + U_MRB, mt * 16 + fr, nt * 16 + fr, fq, z4);
                  const int t = nt * 16 + fr, k0 = mt * 16 + fq * 4; const u32x2 rr = *(const LAS u32x2*)(lds + U_RT + t * RS + k0 * 2);
                  g4[0] += __uint_as_float(rr.x << 16); g4[1] += __uint_as_float(rr.x & 0xffff0000u); g4[2] += __uint_as_float(rr.y << 16); g4[3] += __uint_as_float(rr.y & 0xffff0000u);
                  *(u32x2*)(proj + (unsigned)(rowbase + t) * (unsigned)NPROJ + (unsigned)(APROJ + 1024 + hc + k0)) = pk4c<2>(g4); }
                { f32x4 h4 = mm2(lds + U_QT, lds + U_MRB, mt * 16 + fr, nt * 16 + fr, fq, z4);
                  h4 = mm2(lds + U_VT, lds + U_MRK, mt * 16 + fr, nt * 16 + fr, fq, h4);
                  const int t = nt * 16 + fr, v0 = mt * 16 + fq * 4;
                  *(u32x2*)(r2 + t * 128 + v0 * 2) = pk4c<2>(h4); }
                { f32x4 f4 = mm2(lds + U_PT, lds + U_BH, mt * 16 + fr, nt * 16 + fr, fq, z4);
                  const int k2 = nt * 16 + fr, k10 = mt * 16 + fq * 4;
#pragma unroll
                  for (int jj = 0; jj < 4; ++jj) if (k10 + jj == k2) f4[jj] += wend[k2];
                  *(u32x2*)(r1 + k2 * 128 + k10 * 2) = pk4c<3>(f4); }
                { f32x4 s4 = mm2(lds + U_BH, lds + U_QT, mt * 16 + fr, nt * 16 + fr, fq, z4);
                  s4 = mm2(lds + U_KH, lds + U_VT, mt * 16 + fr, nt * 16 + fr, fq, s4);
                  const int v = nt * 16 + fr, k0 = mt * 16 + fq * 4;
                  *(u32x2*)(r1 + 8192 + v * 128 + k0 * 2) = pk4c<3>(s4); } }
            if (h == 0 && ch == 31) { float* dst = p.out + O_PSHIFT + (size_t)b * APROJ; const bf16_t* pr = proj + (size_t)(rowbase + 63) * NPROJ;
                for (int j = tid; j < APROJ; j += NTHREADS) dst[j] = bf2f(pr[j]); }
            __syncthreads();
        }
    }
}

constexpr int ORS = 32;
constexpr int CH_SCR = 0, CH_OBUF = 4 * 16 * RS, CH_RING = CH_OBUF + 4 * 2 * 64 * ORS, CH_SLOT = 24576, CH_R = 5, CH_A = 4;
static_assert(CH_RING + CH_R * CH_SLOT <= 155648 && (CH_RING & 15) == 0, "chain LDS map");
__device__ __forceinline__ void phase_chain(const Params& p, LAS unsigned char* lds, const int tid, const int bid, const int G) {
    const int lane = tid & 63, wave = __builtin_amdgcn_readfirstlane(tid >> 6), fr = lane & 15, fq = lane >> 4;
    bf16_t* proj = (bf16_t*)(p.ws + WS_BIG);
#define CH_BAR() do { asm volatile("s_waitcnt lgkmcnt(0)" ::: "memory"); __builtin_amdgcn_s_barrier(); asm volatile("" ::: "memory"); } while (0)
    for (int chain = bid; chain < 128; chain += G) {
        const int kind = chain & 1, bh = chain >> 1, b = bh >> 3, h = bh & 7, hc = h * 64;
        const unsigned slot = APROJ + (kind ? 0 : 1024) + hc;
        if (wave < 4) {
            const int vt = wave;
            LAS unsigned char* scr = lds + CH_SCR + vt * (16 * RS);
            LAS unsigned char* obuf = lds + CH_OBUF + vt * (2 * 64 * ORS);
            const float gC = kind ? exp2f(64.0f * log2f(1.0f - exp2f(-5.0f - (float)h))) : 0.f;
            f32x4 S[4]; bf16x8 Sb[2];
#pragma unroll
            for (int m = 0; m < 4; ++m) S[m] = (f32x4){0.f, 0.f, 0.f, 0.f};
#pragma unroll
            for (int ks = 0; ks < 2; ++ks) Sb[ks] = (bf16x8){0, 0, 0, 0, 0, 0, 0, 0};
            for (int ch = 0; ch < 32; ++ch) {
                CH_BAR();
                const LAS unsigned char* sl = lds + CH_RING + (ch % CH_R) * CH_SLOT;
                LAS unsigned char* ob = obuf + (ch & 1) * (64 * ORS);
#pragma unroll
                for (int m = 0; m < 4; ++m) {
                    const u32x2 pw = *(const LAS u32x2*)(sl + 8192 + (vt * 16 + fr) * 128 + (m * 16 + fq * 4) * 2);
                    const f32x4 d = (f32x4){__uint_as_float(pw.x << 16), __uint_as_float(pw.x & 0xffff0000u), __uint_as_float(pw.y << 16), __uint_as_float(pw.y & 0xffff0000u)};
                    f32x4 dm = d, o = (f32x4){0.f, 0.f, 0.f, 0.f};
#pragma unroll
                    for (int ks = 0; ks < 2; ++ks) {
                        dm = __builtin_amdgcn_mfma_f32_16x16x32_bf16(*(const LAS bf16x8*)(sl + (m * 16 + fr) * 128 + (ks * 32 + fq * 8) * 2), Sb[ks], dm, 0, 0, 0);
                        o = __builtin_amdgcn_mfma_f32_16x16x32_bf16(*(const LAS bf16x8*)(sl + 16384 + (m * 16 + fr) * 128 + (ks * 32 + fq * 8) * 2), Sb[ks], o, 0, 0, 0); }
                    const f32x4 dr = S[m] * gC + d;
#pragma unroll
                    for (int q = 0; q < 4; ++q) S[m][q] = kind ? dr[q] : dm[q];
#pragma unroll
                    for (int jj = 0; jj < 4; ++jj) *(LAS bf16_t*)(ob + (m * 16 + fq * 4 + jj) * ORS + fr * 2) = (bf16_t)(cvt_pk_bf16(o[jj], 0.f) & 0xffffu);
                }
#pragma unroll
                for (int m = 0; m < 4; ++m) *(LAS u32x2*)(scr + fr * RS + (m * 16 + fq * 4) * 2) = pk4c<4>(S[m]);
                asm volatile("s_waitcnt lgkmcnt(0)" ::: "memory");
#pragma unroll
                for (int ks = 0; ks < 2; ++ks) Sb[ks] = *(const LAS bf16x8*)(scr + fr * RS + (ks * 32 + fq * 8) * 2);
            }
            CH_BAR();
            if (!kind) { float* dst = p.out + O_PWKV + ((size_t)bh * 64 + vt * 16 + fr) * 64;
#pragma unroll
                for (int m = 0; m < 4; ++m) *(f32x4*)(dst + m * 16 + fq * 4) = S[m]; }
            else { float* dst = p.out + O_PRET + (size_t)bh * 4096 + vt * 16 + fr;
#pragma unroll
                for (int m = 0; m < 4; ++m)
#pragma unroll
                    for (int jj = 0; jj < 4; ++jj) dst[(m * 16 + fq * 4 + jj) * 64] = S[m][jj]; }
        } else if (wave < 6) {
            const int lw = wave - 4;
#define CH_ISSUE(chx) do { const int item_ = bh * 32 + (chx); const unsigned char* r1_ = p.ws + WS_ACT + (size_t)item_ * 16384; \
                const unsigned char* psi_ = kind ? (p.ws + WS_R3 + (size_t)item_ * 8192) : (r1_ + 8192); \
                const unsigned char* gb_ = (const unsigned char*)(proj + (size_t)(b * TP + (chx) * 64) * NPROJ + slot); \
                LAS unsigned char* sl_ = lds + CH_RING + ((chx) % CH_R) * CH_SLOT; \
                _Pragma("unroll") for (int q = 0; q < 12; ++q) { const int pi = lw + 2 * q, seg = pi >> 3; const int off = (pi & 7) * 1024 + lane * 16; \
                    const unsigned char* src_ = seg == 0 ? (r1_ + off) : (seg == 1 ? (psi_ + off) : (gb_ + (size_t)(off >> 7) * (NPROJ * 2) + (off & 127))); \
                    __builtin_amdgcn_global_load_lds((const unsigned*)src_, (LAS unsigned*)(sl_ + pi * 1024), 16, 0, 0); } } while (0)
#pragma unroll
            for (int c0 = 0; c0 < CH_A; ++c0) CH_ISSUE(c0);
            for (int ch = 0; ch < 32; ++ch) {
                const int rem = 31 - ch;
                if (rem >= 3) asm volatile("s_waitcnt vmcnt(36)" ::: "memory"); else if (rem == 2) asm volatile("s_waitcnt vmcnt(24)" ::: "memory");
                else if (rem == 1) asm volatile("s_waitcnt vmcnt(12)" ::: "memory"); else asm volatile("s_waitcnt vmcnt(0)" ::: "memory");
                CH_BAR();
                if (ch + CH_A < 32) CH_ISSUE(ch + CH_A);
            }
#undef CH_ISSUE
            CH_BAR();
        } else {
            const int sw = wave - 6;
            for (int ch = 0; ch <= 32; ++ch) {
                CH_BAR();
                if (ch >= 1) {
#pragma unroll
                    for (int q = 0; q < 2; ++q) { const int vt = sw * 2 + q;
                        const LAS unsigned char* ob = lds + CH_OBUF + vt * (2 * 64 * ORS) + ((ch - 1) & 1) * (64 * ORS) + lane * ORS;
                        const u32x4 w0 = *(const LAS u32x4*)ob, w1 = *(const LAS u32x4*)(ob + 16);
                        bf16_t* dst = proj + (size_t)(b * TP + (ch - 1) * 64 + lane) * NPROJ + slot + vt * 16;
                        *(u32x4*)dst = w0; *(u32x4*)(dst + 8) = w1; } }
            }
        }
        asm volatile("s_waitcnt vmcnt(0)" ::: "memory");
        __syncthreads();
    }
#undef CH_BAR
}

__device__ __forceinline__ void phase_mix_post(const Params& p, const int tid, const int bid, const int G) {
    const int lane = tid & 63, wave = tid >> 6, c = lane;
    const bf16_t* proj = (const bf16_t*)(p.ws + WS_BIG);
    bf16_t* ycat = (bf16_t*)(p.ws + WS_ACT);
    for (int row0 = bid * 8 + wave; row0 < MP / 2; row0 += G * 8) {
        float ow[2][8], g[2][8], bv[2][8], orr[2][8], gt[2][8];
#pragma unroll
        for (int r = 0; r < 2; ++r) { const int row = row0 + r * (MP / 2);
            const int b = row >> 11, tt = row & 2047, ch = tt >> 6, t = tt & 63; const unsigned ro = (unsigned)row * (unsigned)NPROJ;
#pragma unroll
            for (int h = 0; h < 8; ++h) { const unsigned hcc = (unsigned)(h * 64 + c); const int item = (b * 8 + h) * 32 + ch;
                const unsigned char* r2 = (const unsigned char*)(p.out + O_Y) + (size_t)item * 24576;
                ow[r][h] = bf2f(*(const bf16_t*)(r2 + t * 128 + c * 2)) + bf2f(proj[ro + (unsigned)(APROJ + 1024) + hcc]);
                g[r][h] = bf2f(*(const bf16_t*)(r2 + 8192 + t * 128 + c * 2)); bv[r][h] = bf2f(*(const bf16_t*)(r2 + 16384 + t * 128 + c * 2));
                orr[r][h] = bf2f(proj[ro + (unsigned)(APROJ + 512) + hcc]) + bf2f(proj[ro + (unsigned)APROJ + hcc]);
                gt[r][h] = bf2f(proj[ro + (unsigned)(APROJ + 1536) + hcc]); } }
#pragma unroll
        for (int r = 0; r < 2; ++r) { const int row = row0 + r * (MP / 2);
            float sw[8], qw[8], sr[8], qr[8];
#pragma unroll
            for (int h = 0; h < 8; ++h) { sw[h] = ow[r][h]; qw[h] = ow[r][h] * ow[r][h]; sr[h] = orr[r][h]; qr[h] = orr[r][h] * orr[r][h]; }
#pragma unroll
            for (int h = 0; h < 8; ++h) { sw[h] = row16_sum(sw[h]); qw[h] = row16_sum(qw[h]); sr[h] = row16_sum(sr[h]); qr[h] = row16_sum(qr[h]); }
#pragma unroll
            for (int o = 16; o <= 32; o <<= 1) {
#pragma unroll
                for (int h = 0; h < 8; ++h) { sw[h] += __shfl_xor(sw[h], o); qw[h] += __shfl_xor(qw[h], o); sr[h] += __shfl_xor(sr[h], o); qr[h] += __shfl_xor(qr[h], o); } }
#pragma unroll
            for (int h = 0; h < 8; ++h) { const unsigned hcc = (unsigned)(h * 64 + c);
                const float mw = sw[h] * (1.f / 64.f), vw = fmaxf(qw[h] * (1.f / 64.f) - mw * mw, 0.f);
                const float ya = ((ow[r][h] - mw) * rsqrtf(vw + 64e-5f) * p.in[16][hcc] + p.in[17][hcc] + bv[r][h]) * g[r][h];
                const float mr_ = sr[h] * (1.f / 64.f), vr = fmaxf(qr[h] * (1.f / 64.f) - mr_ * mr_, 0.f);
                const float yb = gt[r][h] / (1.0f + __expf(-gt[r][h])) * ((orr[r][h] - mr_) * rsqrtf(vr + 1e-5f) * p.in[18][hcc] + p.in[19][hcc]);
                const float ya2 = dpp_mov<0xF5>(ya), yb2 = dpp_mov<0xF5>(yb);
                if (!(c & 1)) { *(unsigned*)(ycat + ((unsigned)row * (unsigned)DM + hcc)) = cvt_pk_bf16(ya, ya2); *(unsigned*)(ycat + ((unsigned)row * (unsigned)DM + 512u + hcc)) = cvt_pk_bf16(yb, yb2); } } }
    }
}

__device__ __forceinline__ void phase_ln(float* X, const float* g, const float* bta, bf16_t* xb, const int tid, const int bid, const int G) {
    const int lane = tid & 63, wave = tid >> 6;
    f32x4 gg[4], bb[4];
#pragma unroll
    for (int i = 0; i < 4; ++i) { gg[i] = *(const f32x4*)(g + i * 256 + lane * 4); bb[i] = *(const f32x4*)(bta + i * 256 + lane * 4); }
    for (int row = bid * 8 + wave; row < MT; row += G * 8) {
        float* xr = X + (size_t)row * DM; f32x4 v[4]; float s = 0.f;
#pragma unroll
        for (int i = 0; i < 4; ++i) { v[i] = *(const f32x4*)(xr + i * 256 + lane * 4); s += (v[i][0] + v[i][1]) + (v[i][2] + v[i][3]); }
        const float mean = wave_sum(s) * (1.f / 1024.f); float q = 0.f;
#pragma unroll
        for (int i = 0; i < 4; ++i) { v[i] -= mean; q += (v[i][0] * v[i][0] + v[i][1] * v[i][1]) + (v[i][2] * v[i][2] + v[i][3] * v[i][3]); }
        const float rstd = rsqrtf(wave_sum(q) * (1.f / 1024.f) + 1e-5f);
#pragma unroll
        for (int i = 0; i < 4; ++i) { const f32x4 y = v[i] * rstd * gg[i] + bb[i]; *(f32x4*)(xr + i * 256 + lane * 4) = y;
            u32x2 w; w.x = cvt_pk_bf16(y[0], y[1]); w.y = cvt_pk_bf16(y[2], y[3]); *(u32x2*)(xb + (size_t)row * DM + i * 256 + lane * 4) = w; }
    }
}

__device__ __forceinline__ void phase_conv(const Params& p, const int tid, const int bid, const int G) {
    const bf16_t* cp = (const bf16_t*)(p.ws + WS_BIG);
    bf16_t* vb = (bf16_t*)(p.ws + WS_ACT);
    const float* cw = p.in[22];
    const size_t total = (size_t)MT * 128;
    for (size_t idx0 = (size_t)bid * NTHREADS + tid; idx0 < total / 2; idx0 += (size_t)G * NTHREADS)
#pragma unroll
    for (int rr = 0; rr < 2; ++rr) { const size_t idx = idx0 + (size_t)rr * (total / 2);
        const int row = (int)(idx >> 7), c0 = (int)(idx & 127) * 8;
        const bool smp = row >= MP; const int T = smp ? TS : TP; const int b = smp ? (row - MP) / TS : row / TP; const int t = smp ? (row - MP) % TS : row % TP;
        float u[3][8];
#pragma unroll
        for (int d = 0; d < 3; ++d) { const int tt = t - 2 + d;
            if (tt >= 0) { const bf16_t* r = cp + (size_t)(row - 2 + d) * NCONV; const u32x4 cgv = *(const u32x4*)(r + 1024 + c0), hv = *(const u32x4*)(r + 2048 + c0);
#pragma unroll
                for (int q = 0; q < 4; ++q) { u[d][2 * q] = __uint_as_float(cgv[q] << 16) * __uint_as_float(hv[q] << 16); u[d][2 * q + 1] = __uint_as_float(cgv[q] & 0xffff0000u) * __uint_as_float(hv[q] & 0xffff0000u); } }
            else { if (smp) { const float* sr = p.in[5] + ((size_t)b * 2 + (tt + 2)) * DM + c0;
#pragma unroll
                    for (int q = 0; q < 8; ++q) u[d][q] = sr[q]; }
                else {
#pragma unroll
                    for (int q = 0; q < 8; ++q) u[d][q] = 0.f; } } }
        const u32x4 bgv = *(const u32x4*)(cp + (size_t)row * NCONV + c0); float o[8];
#pragma unroll
        for (int q = 0; q < 8; ++q) { const float bg = (q & 1) ? __uint_as_float(bgv[q >> 1] & 0xffff0000u) : __uint_as_float(bgv[q >> 1] << 16);
            o[q] = bg * (u[0][q] * cw[c0 + q] + u[1][q] * cw[DM + c0 + q] + u[2][q] * cw[2 * DM + c0 + q]); }
        u32x4 w; w.x = cvt_pk_bf16(o[0], o[1]); w.y = cvt_pk_bf16(o[2], o[3]); w.z = cvt_pk_bf16(o[4], o[5]); w.w = cvt_pk_bf16(o[6], o[7]);
        *(u32x4*)(vb + (size_t)row * DM + c0) = w;
        if (t >= T - 2) { float* dst = p.out + (smp ? O_SCONV : O_PCONV) + ((size_t)b * 2 + (t - (T - 2))) * DM + c0;
#pragma unroll
            for (int q = 0; q < 8; ++q) dst[q] = u[2][q]; }
    }
}


#define XB_TMO      128
#define XB_XCNT(j)  (256  + 64 * (j))
#define XB_XSUB(j)  (1280 + 64 * (j))
#define XB_XGEN(j)  (2304 + 64 * (j))
#define XB_TOP      3328
#define XB_TOPGEN   3392
#define XCD_BAR_WORDS 3456
#define XB_SPIN_CAP (1u << 18)
__device__ __forceinline__ unsigned xb_ld(unsigned* p)              { return __hip_atomic_load(p, __ATOMIC_RELAXED, __HIP_MEMORY_SCOPE_AGENT); }
__device__ __forceinline__ unsigned xb_add(unsigned* p, unsigned v) { return __hip_atomic_fetch_add(p, v, __ATOMIC_RELAXED, __HIP_MEMORY_SCOPE_AGENT); }
__device__ __forceinline__ unsigned xb_xcc_id() { return (unsigned)__builtin_amdgcn_s_getreg((3 << 11) | 20) & 0xFu; }
#define XB_SPIN(cond, bar) do { unsigned _sp = 0; while (cond) { __builtin_amdgcn_s_sleep(1); \
    if ((++_sp & 255u) == 0u) { if (xb_ld(&(bar)[XB_TMO])) break; if (_sp > XB_SPIN_CAP) { atomicAdd(&(bar)[XB_TMO], 1u); break; } } } } while (0)
struct XcdBarrier { unsigned* bar; unsigned x; volatile LAS unsigned* st; };
__device__ __forceinline__ XcdBarrier xcd_barrier_post(unsigned* bar, volatile LAS unsigned* st) {
    XcdBarrier b; b.bar = bar; b.x = xb_xcc_id(); b.st = st;
    if (threadIdx.x == 0) (void)xb_add(&bar[XB_XCNT(b.x)], 1u);
    return b;
}
__device__ __forceinline__ void xcd_barrier_complete(unsigned* bar, unsigned x, unsigned& nloc, unsigned& nx) {
    const unsigned G = gridDim.x * gridDim.y * gridDim.z;
    unsigned sum, cnt, mine, sp = 0u;
    for (;;) {
        sum = 0u; cnt = 0u; mine = 0u;
#pragma unroll
        for (unsigned j = 0; j < 16; ++j) { const unsigned c = xb_ld(&bar[XB_XCNT(j)]); sum += c; cnt += (c > 0u) ? 1u : 0u; mine = (j == x) ? c : mine; }
        if (sum == G) break;
        __builtin_amdgcn_s_sleep(1);
        if ((++sp & 255u) == 0u) { if (xb_ld(&bar[XB_TMO])) break; if (sp > XB_SPIN_CAP) { atomicAdd(&bar[XB_TMO], 1u); break; } }
    }
    nloc = mine > 0u ? mine : 1u; nx = cnt > 0u ? cnt : 1u;
}
__device__ __forceinline__ void xcd_barrier(const XcdBarrier& b) {
    asm volatile("s_waitcnt vmcnt(0)" ::: "memory");
    __syncthreads();
    if (threadIdx.x == 0) {
        unsigned* bar = b.bar;
        __builtin_amdgcn_s_waitcnt(0);
        unsigned nloc = b.st[0], nx = b.st[1];
        if (nloc == 0u) { xcd_barrier_complete(bar, b.x, nloc, nx); b.st[0] = nloc; b.st[1] = nx; }
        const unsigned old = xb_add(&bar[XB_XSUB(b.x)], 1u);
        const unsigned gen = old / nloc;
        if (old + 1u == (gen + 1u) * nloc) {
            __builtin_amdgcn_fence(__ATOMIC_RELEASE, "agent");
            asm volatile("s_waitcnt vmcnt(0)" ::: "memory");
            const unsigned og = xb_add(&bar[XB_TOP], 1u);
            const unsigned tg = og / nx;
            if (og + 1u == (tg + 1u) * nx) xb_add(&bar[XB_TOPGEN], 1u);
            else XB_SPIN(xb_ld(&bar[XB_TOPGEN]) == tg, bar);
            __builtin_amdgcn_fence(__ATOMIC_ACQUIRE, "agent");
            xb_add(&bar[XB_XGEN(b.x)], 1u);
            asm volatile("s_waitcnt vmcnt(0)" ::: "memory");
        } else {
            XB_SPIN(xb_ld(&bar[XB_XGEN(b.x)]) == gen, bar);
            __builtin_amdgcn_fence(__ATOMIC_ACQUIRE, "agent");
            asm volatile("s_waitcnt vmcnt(0)" ::: "memory");
        }
    }
    __syncthreads();
}

__global__ void __launch_bounds__(NTHREADS, 2) mega(Params p_arg) {
    extern __shared__ __attribute__((aligned(16))) unsigned char lds[];
    cg::grid_group grid = cg::this_grid();
    LAS unsigned char* ldsl = (LAS unsigned char*)lds;
    float* L = (float*)lds;
    const int lo = p_arg.ph_lo, hi = p_arg.ph_hi & 0xff; const int dbg = p_arg.ph_hi >> 8;
    volatile LAS unsigned* xb_st = (volatile LAS unsigned*)(ldsl + 155648);
    if (threadIdx.x == 0) { xb_st[0] = 0u; xb_st[1] = 0u; }
    __syncthreads();
    const XcdBarrier xbar = xcd_barrier_post((unsigned*)(p_arg.ws + WS_BAR), xb_st);
    const int wid_s = __builtin_amdgcn_readfirstlane((int)threadIdx.x >> 6);
    for (int ph = lo; ph < hi; ++ph) {
        unsigned zero_v = 0u; asm volatile("" : "+v"(zero_v));
        int tid = wid_s * 64 + (int)__builtin_amdgcn_mbcnt_hi(~0u, __builtin_amdgcn_mbcnt_lo(~0u, zero_v)), bid = blockIdx.x, G = gridDim.x;
        asm volatile("" : "+v"(tid), "+s"(bid), "+s"(G));
        const __attribute__((address_space(4))) Params* pk = (const __attribute__((address_space(4))) Params*)__builtin_amdgcn_kernarg_segment_ptr();
        asm volatile("" : "+s"(pk));
        const Params& p = *(const Params*)pk;
        bf16_t* act = (bf16_t*)(p.ws + WS_ACT); bf16_t* big = (bf16_t*)(p.ws + WS_BIG);
        float* Y = p.out + O_Y;
#if PROBE_MASK
        if (bid == 0 && tid == 0) ((unsigned long long*)(p.ws + WS_STAMP))[ph] = __builtin_amdgcn_s_memrealtime();
#endif
        if (ph == 0) phase_convert(p, L, tid, bid, G, 0, 960, true);
        else if (ph == 2) { phase_mix_local(p, ldsl, tid, (dbg & 1) ? 4096 : bid, G); __syncthreads(); phase_sample(p, ldsl, tid, bid, G); }
        else if (ph == 3) { phase_chain(p, ldsl, tid, (dbg & 2) ? 4096 : bid, G);
            if (G > 128) { if (bid >= 128) phase_convert(p, L, tid, bid - 128, G - 128, 960, 6336, false); } else { __syncthreads(); phase_convert(p, L, tid, bid, G, 960, 6336, false); } }
        else if (ph == 4) phase_mix_post(p, tid, (dbg & 4) ? (1 << 20) : bid, G);
        else if (ph == 11) phase_conv(p, tid, bid, G);
        else if (ph == 6 || ph == 9 || ph == 13 || ph == 16) {
            const int l = ph >= 13 ? 1 : 0; const bool second = (ph == 9 || ph == 16);
            phase_ln(Y, (second ? p.in[26] : p.in[24]) + l * DM, (second ? p.in[27] : p.in[25]) + l * DM, act, tid, bid, G);
        } else {
            pg8::Gemm g; pg8::Epi E; E.O = big; E.xlo = Y; E.xhi = Y; E.Z = Y; g.M = MT; g.A = act; g.K = DM;
            size_t wo;
            switch (ph) {
                case 1: wo = WS_WIN; g.N = NPROJ; E.mode = 0; break;
                case 5: wo = WS_WOUT; g.N = DM; E.mode = 2; E.xlo = p.in[0]; E.xhi = p.in[1] - (size_t)MP * DM; break;
                case 7: wo = WS_WUP0; g.N = DFF; E.mode = 1; break;
                case 8: wo = WS_WDN0; g.N = DM; g.K = DFF; g.A = big; E.mode = 2; break;
                case 10: wo = WS_WCIN; g.N = NCONV; E.mode = 0; break;
                case 12: wo = WS_WCOUT; g.N = DM; E.mode = 2; break;
                case 14: wo = WS_WUP1; g.N = DFF; E.mode = 1; break;
                default: wo = WS_WDN1; g.N = DM; g.K = DFF; g.A = big; E.mode = 2; break;
            }
            g.Bt = (const bf16_t*)(p.ws + wo); E.ldc = g.N;
            pg8::StaticOrder S; S.init(MT, g.N, G, bid);
            const bool split_tail = (E.mode == 2 && G == 256 && S.nwg == 272);
            if (split_tail) S.lim = 256;
            pg8::gemm_phase(ldsl, g, S, E, tid);
            if (split_tail) { pg8::Unit u; S.map(256 + (bid >> 4), u); const int s = bid & 15; const int row0 = u.pm * 256 + (s >> 2) * 64, col0 = u.pn * 256 + (s & 3) * 64;
                gemm64_resid(ldsl, g.A, g.Bt, g.K, row0, col0, (row0 < MP) ? E.xlo : E.xhi, E.Z, tid); }
        }
        if (ph + 1 < hi) { if (dbg & 64) grid.sync(); else xcd_barrier(xbar); }
#if PROBE_MASK
        if (ph + 1 == hi && bid == 0 && tid == 0) { unsigned long long* st = (unsigned long long*)(p.ws + WS_STAMP); st[hi] = __builtin_amdgcn_s_memrealtime();
            unsigned long long tot = 0; for (int k = lo; k < hi; ++k) if ((PROBE_MASK >> k) & 1) tot += st[k + 1] - st[k];
            asm volatile("s_waitcnt vmcnt(0)" ::: "memory"); p.out[0] = (float)tot * 0.01f; }
#endif
    }
}
#ifndef PROBE_MASK
#define PROBE_MASK 0
#endif
constexpr int NPHASES = 17;
#ifndef DBG
#define DBG 0
#endif

#ifndef PER_PHASE_LAUNCH
#define PER_PHASE_LAUNCH 0
#endif

extern "C" void kernel_launch(void* const* d_in, const int* in_sizes, int n_in, void* d_out, int out_size, void* d_ws, size_t ws_size, hipStream_t stream) {
    static int grid = 0;
    if (grid == 0) {
        if (n_in != 30 || ws_size < WS_END2) { fprintf(stderr, "kernel_launch: unexpected n_in %d or ws_size %zu (need %zu)\n", n_in, ws_size, (size_t)WS_END2); grid = -1; return; }
        int dev = 0, cus = 0, per_cu = 0;
        hipGetDevice(&dev);
        hipDeviceGetAttribute(&cus, hipDeviceAttributeMultiprocessorCount, dev);
        if (hipFuncSetAttribute((const void*)mega, hipFuncAttributeMaxDynamicSharedMemorySize, LDS_BYTES) != hipSuccess) { fprintf(stderr, "kernel_launch: hipFuncSetAttribute failed\n"); grid = -1; return; }
        if (hipOccupancyMaxActiveBlocksPerMultiprocessor(&per_cu, (const void*)mega, NTHREADS, LDS_BYTES) != hipSuccess || per_cu < 1) { fprintf(stderr, "kernel_launch: occupancy query failed (%d)\n", per_cu); (void)hipGetLastError(); per_cu = 1; }
        if (per_cu > 1) per_cu = 1;
        grid = cus * per_cu;
    }
    if (grid < 0) return;
    if (hipMemsetAsync((char*)d_ws + WS_BAR, 0, 3456 * 4, stream) != hipSuccess) { fprintf(stderr, "kernel_launch: hipMemsetAsync failed\n"); return; }
    Params p{};
    for (int i = 0; i < 30; ++i) p.in[i] = (const float*)d_in[i];
    p.out = (float*)d_out; p.ws = (unsigned char*)d_ws;
    for (int f = 0; f < 32; ++f) p.inv_freq[f] = pow(10000.0, -(double)f / 32.0);
#if PER_PHASE_LAUNCH
    for (int ph = 0; ph < NPHASES; ++ph) { p.ph_lo = ph; p.ph_hi = ph + 1; hipLaunchKernelGGL(mega, dim3(grid), dim3(NTHREADS), LDS_BYTES, stream, p); }
#else
    p.ph_lo = 0; p.ph_hi = NPHASES | (DBG << 8);
    void* args[] = {&p};
    hipError_t e = hipLaunchCooperativeKernel((const void*)mega, dim3(grid), dim3(NTHREADS), args, LDS_BYTES, stream);
    if (e != hipSuccess) fprintf(stderr, "cooperative launch failed: %s (grid %d)\n", hipGetErrorString(e), grid);
#endif
}
```

```cpp
#include <hip/hip_runtime.h>
#include <hip/hip_cooperative_groups.h>
#include <cstdio>
#include <cmath>
namespace cg = cooperative_groups;

#ifndef PROBE_MASK
#define PROBE_MASK 0
#endif
#define LAS __attribute__((address_space(3)))
typedef unsigned short bf16_t;
typedef short bf16x8 __attribute__((ext_vector_type(8)));
typedef float f32x4 __attribute__((ext_vector_type(4)));
typedef unsigned u32x4 __attribute__((ext_vector_type(4)));
typedef unsigned u32x2 __attribute__((ext_vector_type(2)));

constexpr int DM = 1024, MP = 16384, MS = 1024, MT = MP + MS;
constexpr int TP = 2048, TS = 8, NBP = 8, NBS = 128;
constexpr int APROJ = 1792, NPROJ = 3840, DFF = 4096, NCONV = 3072;
constexpr float ALPHA = 1.4142135623730951f;
constexpr int LDS_BYTES = 155648 + 256;
constexpr int NTHREADS = 512;

constexpr size_t WS_WIN = 0;
constexpr size_t WS_WOUT = WS_WIN + (size_t)NPROJ * DM * 2;
constexpr size_t WS_WCIN = WS_WOUT + (size_t)DM * DM * 2;
constexpr size_t WS_WCOUT = WS_WCIN + (size_t)NCONV * DM * 2;
constexpr size_t WS_WUP0 = WS_WCOUT + (size_t)DM * DM * 2;
constexpr size_t WS_WUP1 = WS_WUP0 + (size_t)DFF * DM * 2;
constexpr size_t WS_WDN0 = WS_WUP1 + (size_t)DFF * DM * 2;
constexpr size_t WS_WDN1 = WS_WDN0 + (size_t)DFF * DM * 2;
constexpr size_t WS_ACT = WS_WDN1 + (size_t)DFF * DM * 2;
constexpr size_t WS_BIG = WS_ACT + (size_t)MT * DM * 2;
constexpr size_t WS_ROPE = WS_BIG + (size_t)MT * DFF * 2;
constexpr size_t WS_END = WS_ROPE + (size_t)2056 * 32 * 8;

constexpr size_t WS_R3 = (WS_END + 255) & ~(size_t)255;
constexpr size_t WS_STAMP = WS_R3 + (size_t)2048 * 8192;
constexpr size_t WS_W2T = WS_STAMP + 256;
constexpr size_t WS_A2T = WS_W2T + 512 * 64 * 2;
constexpr size_t WS_G2T = WS_A2T + 512 * 64 * 2;
constexpr size_t WS_BAR = WS_G2T + 512 * 128 * 2;
constexpr size_t WS_END2 = WS_BAR + 3456 * 4;

constexpr size_t O_Y = 0;
constexpr size_t O_PSHIFT = (size_t)MT * DM;
constexpr size_t O_PWKV = O_PSHIFT + (size_t)NBP * APROJ;
constexpr size_t O_PRET = O_PWKV + (size_t)NBP * 8 * 4096;
constexpr size_t O_PCONV = O_PRET + (size_t)NBP * 8 * 4096;
constexpr size_t O_SSHIFT = O_PCONV + (size_t)NBP * 2 * DM;
constexpr size_t O_SWKV = O_SSHIFT + (size_t)NBS * APROJ;
constexpr size_t O_SRET = O_SWKV + (size_t)NBS * 8 * 4096;
constexpr size_t O_SCONV = O_SRET + (size_t)NBS * 8 * 4096;

struct Params { const float* in[30]; float* out; unsigned char* ws; int ph_lo, ph_hi; double inv_freq[32]; };

__device__ __forceinline__ float bf2f(bf16_t b) { return __uint_as_float(((unsigned)b) << 16); }
typedef __bf16 bf16x2_t __attribute__((ext_vector_type(2)));
typedef float f32x2_t __attribute__((ext_vector_type(2)));
__device__ __forceinline__ unsigned cvt_pk_bf16(float lo, float hi) { const f32x2_t v = {lo, hi}; const bf16x2_t b = __builtin_convertvector(v, bf16x2_t); return __builtin_bit_cast(unsigned, b); }
template <int CTRL> __device__ __forceinline__ float dpp_mov(float v) { return __int_as_float(__builtin_amdgcn_update_dpp(0, __float_as_int(v), CTRL, 0xF, 0xF, false)); }
__device__ __forceinline__ float row16_sum(float v) {
    v += dpp_mov<0xB1>(v); v += dpp_mov<0x4E>(v); v += dpp_mov<0x124>(v); v += dpp_mov<0x128>(v); return v;
}
__device__ __forceinline__ float rows_sum(float v) {
    { const auto r = __builtin_amdgcn_permlane16_swap(__float_as_uint(v), __float_as_uint(v), false, false); v = __uint_as_float(r[0]) + __uint_as_float(r[1]); }
    { const auto r = __builtin_amdgcn_permlane32_swap(__float_as_uint(v), __float_as_uint(v), false, false); v = __uint_as_float(r[0]) + __uint_as_float(r[1]); }
    return v;
}
__device__ __forceinline__ float wave_sum(float v) { return rows_sum(row16_sum(v)); }

namespace pg8 {
constexpr int BM = 256, BK = 64, HALF = 128, HTB = HALF * BK * 2, STAGE_BYTES = 8 * HTB, NXCD = 8, WGM = 8;
__device__ __forceinline__ int lds_byte(int r, int c) { const int st = (r >> 4) * 2 + (c >> 5), rr = r & 15, cc = c & 31, ob = rr * 64 + cc * 2; return st * 1024 + (ob ^ (((ob >> 9) & 1) << 5)); }
__device__ __forceinline__ void stage_rc(int b, int& R, int& C) { const int st = b / 1024, sb = b % 1024, swz = sb ^ (((sb >> 9) & 1) << 5); R = (st >> 1) * 16 + swz / 64; C = (st & 1) * 32 + (swz % 64) / 2; }
__device__ __forceinline__ int perm32(int rho) { const int n = rho >> 4, i = rho & 15; return 8 * (i >> 2) + 4 * n + (i & 3); }
struct Unit { int pm, pn; };
struct Gemm { const bf16_t* A; const bf16_t* Bt; int M, N, K; };
struct StaticOrder {
    int nM, nN, nwg, G, c, lim;
    __device__ void init(int M, int N, int G_, int c_) { nM = M / BM; nN = N / BM; nwg = nM * nN; G = G_; c = c_; lim = nwg; }
    __device__ void map(int L, Unit& u) const {
        int wgid = L; { const int q = nwg / NXCD, r = nwg % NXCD, xcd = wgid % NXCD, off = wgid / NXCD; wgid = (xcd < r ? xcd * (q + 1) : r * (q + 1) + (xcd - r) * q) + off; }
        const int nig = WGM * nN, gid = wgid / nig, fm = gid * WGM, gsz = (nM - fm) < WGM ? (nM - fm) : WGM;
        u.pm = fm + ((wgid % nig) % gsz); u.pn = (wgid % nig) / gsz;
    }
    __device__ bool next(int i, Unit& u) const { const long L = (long)i * G + c; if (L >= lim) return false; map((int)L, u); return true; }
};

struct Epi {
    int mode; bf16_t* O; int ldc; const float* xlo; const float* xhi; float* Z;
    __device__ __forceinline__ void operator()(const f32x4 (&acc)[2][2][4][2], const Unit& u, int wr, int wc, int fr, int fq) const {
        if (mode < 2) {
            const int row0 = u.pm * BM + wr * 64 + fr; const int col0 = u.pn * BM + wc * 32 + 8 * fq;
            const float lowclamp = mode == 1 ? 0.f : -3.0e38f;
#pragma unroll
            for (int ai = 0; ai < 2; ++ai)
#pragma unroll
                for (int m = 0; m < 4; ++m) { bf16_t* rowp = O + (size_t)(row0 + ai * HALF + m * 16) * ldc + col0;
#pragma unroll
                    for (int bj = 0; bj < 2; ++bj) { f32x4 v0 = acc[ai][bj][m][0], v1 = acc[ai][bj][m][1];
                        if (mode == 1) {
#pragma unroll
                            for (int j = 0; j < 4; ++j) { const float a = fmaxf(v0[j], lowclamp), b = fmaxf(v1[j], lowclamp); v0[j] = a * a; v1[j] = b * b; } }
                        u32x4 w; w.x = cvt_pk_bf16(v0[0], v0[1]); w.y = cvt_pk_bf16(v0[2], v0[3]); w.z = cvt_pk_bf16(v1[0], v1[1]); w.w = cvt_pk_bf16(v1[2], v1[3]);
                        *(u32x4*)(rowp + bj * HALF) = w; } }
        } else {
            const int row0 = u.pm * BM + wr * 64 + fr, col0 = u.pn * BM + wc * 32 + 4 * fq;
            const float* X = (u.pm * BM < MP) ? xlo : xhi;
#pragma unroll
            for (int ai = 0; ai < 2; ++ai)
#pragma unroll
                for (int mp = 0; mp < 2; ++mp) {
                    f32x4 x[2][2][2];
#pragma unroll
                    for (int mm = 0; mm < 2; ++mm) { const size_t off = (size_t)(row0 + ai * HALF + (mp * 2 + mm) * 16) * DM + col0;
#pragma unroll
                        for (int bj = 0; bj < 2; ++bj)
#pragma unroll
                            for (int n = 0; n < 2; ++n) x[mm][bj][n] = *(const f32x4*)(X + off + bj * HALF + n * 16); }
#pragma unroll
                    for (int mm = 0; mm < 2; ++mm) { const int m = mp * 2 + mm; const size_t off = (size_t)(row0 + ai * HALF + m * 16) * DM + col0;
#pragma unroll
                        for (int bj = 0; bj < 2; ++bj)
#pragma unroll
                            for (int n = 0; n < 2; ++n) *(f32x4*)(Z + off + bj * HALF + n * 16) = x[mm][bj][n] * ALPHA + acc[ai][bj][m][n]; }
                    asm volatile("" ::: "memory"); }
        }
    }
};

template <class Sched>
__device__ __forceinline__ void gemm_phase(LAS unsigned char* lds, const Gemm g, const Sched& S, const Epi& E, const int tid) {
    const bool PERM = E.mode < 2;
    const int wid = __builtin_amdgcn_readfirstlane(tid >> 6), lane = tid & 63, wr = wid >> 2, wc = wid & 3, fr = lane & 15, fq = lane >> 4;
    const int K = g.K, nt = K / BK;
    unsigned voffA[2], voffB[2];
#pragma unroll
    for (int i = 0; i < 2; ++i) { int R, C; stage_rc(tid * 16 + i * 8192, R, C); const int Rb = PERM ? ((R & ~31) + perm32(R & 31)) : R;
        voffA[i] = (unsigned)(R * K + C) * 2u; voffB[i] = (unsigned)(Rb * K + C) * 2u; }
    const size_t kstep = (size_t)(BK * 2);
    const size_t hstep = (size_t)HALF * K * 2;
    const size_t tstep = 2 * hstep;
    const unsigned ldsw = (unsigned)wid * 1024u;
    const int aoff = lds_byte(wr * 64 + fr, fq * 8), boff = lds_byte(wc * 32 + fr, fq * 8);
#define PG8_SA(b, h) (((b) * 2 + (h)) * HTB)
#define PG8_SB(b, h) ((4 + (b) * 2 + (h)) * HTB)
#define PG8_STAGE(bufoff, gbase, voff) do { _Pragma("unroll") for (int _i = 0; _i < 2; ++_i) \
        __builtin_amdgcn_global_load_lds((const unsigned*)((const char*)(gbase) + (voff)[_i]), (LAS unsigned*)(lds + (bufoff) + ldsw + _i * 8192), 16, 0, 0); } while (0)
#define PG8_LDA(dst, b, h) do { _Pragma("unroll") for (int m = 0; m < 4; ++m) _Pragma("unroll") for (int k = 0; k < 2; ++k) dst[m][k] = *(const LAS bf16x8*)(lds + PG8_SA(b, h) + aoff + m * 2048 + k * 1024); } while (0)
#define PG8_LDB(dst, b, h) do { _Pragma("unroll") for (int n = 0; n < 2; ++n) _Pragma("unroll") for (int k = 0; k < 2; ++k) dst[n][k] = *(const LAS bf16x8*)(lds + PG8_SB(b, h) + boff + n * 2048 + k * 1024); } while (0)
#define PG8_MMA(ai, bj, At, Bt) do { __builtin_amdgcn_s_setprio(1); _Pragma("unroll") for (int m = 0; m < 4; ++m) _Pragma("unroll") for (int n = 0; n < 2; ++n) _Pragma("unroll") for (int k = 0; k < 2; ++k) \
        acc[ai][bj][m][n] = __builtin_amdgcn_mfma_f32_16x16x32_bf16(Bt[n][k], At[m][k], acc[ai][bj][m][n], 0, 0, 0); __builtin_amdgcn_s_setprio(0); } while (0)
#define PG8_WAIT_V(n) asm volatile("s_waitcnt vmcnt(" #n ")" ::: "memory")
#define PG8_WAIT_L(n) asm volatile("s_waitcnt lgkmcnt(" #n ")" ::: "memory")
#define PG8_BAR __builtin_amdgcn_s_barrier()
#define PG8_SCHED __builtin_amdgcn_sched_barrier(0)
    Unit cur, nxt; int ui = 0;
    if (!S.next(0, cur)) return;
    f32x4 acc[2][2][4][2];
#pragma unroll
    for (int a = 0; a < 2; ++a)
#pragma unroll
        for (int b = 0; b < 2; ++b)
#pragma unroll
            for (int m = 0; m < 4; ++m)
#pragma unroll
                for (int n = 0; n < 2; ++n) acc[a][b][m][n] = (f32x4){0.f, 0.f, 0.f, 0.f};
    bf16x8 At[4][2], B0[2][2], B1[2][2];
    const char* cA = (const char*)g.A + (size_t)cur.pm * tstep; const char* cB = (const char*)g.Bt + (size_t)cur.pn * tstep;
    PG8_STAGE(PG8_SB(0, 0), cB, voffB); PG8_STAGE(PG8_SA(0, 0), cA, voffA); PG8_STAGE(PG8_SB(0, 1), cB + hstep, voffB); PG8_STAGE(PG8_SA(0, 1), cA + hstep, voffA);
    if (wr == 1) PG8_BAR;
    PG8_WAIT_V(4); PG8_BAR;
    PG8_STAGE(PG8_SB(1, 0), cB + kstep, voffB); PG8_STAGE(PG8_SA(1, 0), cA + kstep, voffA); PG8_STAGE(PG8_SB(1, 1), cB + hstep + kstep, voffB);
    PG8_WAIT_V(6); PG8_BAR;
    for (;;) {
        const bool has_next = S.next(ui + 1, nxt);
        const char* nA = has_next ? (const char*)g.A + (size_t)nxt.pm * tstep : cA; const char* nB = has_next ? (const char*)g.Bt + (size_t)nxt.pn * tstep : cB;
        for (int t = 0; t < nt; t += 2) {
            const bool last = (t == nt - 2);
            const char* a1 = cA + (size_t)(t + 1) * kstep;
            const char* a2 = last ? nA : cA + (size_t)(t + 2) * kstep; const char* b2 = last ? nB : cB + (size_t)(t + 2) * kstep;
            const char* a3 = a2 + kstep; const char* b3 = b2 + kstep;
            PG8_LDB(B0, 0, 0); PG8_SCHED; PG8_LDA(At, 0, 0); PG8_STAGE(PG8_SA(1, 1), a1 + hstep, voffA);
            PG8_WAIT_L(8); PG8_BAR; PG8_WAIT_L(0); PG8_MMA(0, 0, At, B0); PG8_BAR; PG8_SCHED;
            PG8_LDB(B1, 0, 1); PG8_STAGE(PG8_SB(0, 0), b2, voffB);
            PG8_BAR; PG8_WAIT_L(0); PG8_MMA(0, 1, At, B1); PG8_BAR;
            PG8_LDA(At, 0, 1); PG8_STAGE(PG8_SA(0, 0), a2, voffA);
            PG8_BAR; PG8_WAIT_L(0); PG8_MMA(1, 0, At, B0); PG8_BAR; PG8_SCHED;
            PG8_STAGE(PG8_SB(0, 1), b2 + hstep, voffB);
            PG8_WAIT_V(6); PG8_BAR; PG8_MMA(1, 1, At, B1); PG8_BAR;
            PG8_LDB(B0, 1, 0); PG8_SCHED; PG8_LDA(At, 1, 0); PG8_STAGE(PG8_SA(0, 1), a2 + hstep, voffA);
            PG8_WAIT_L(8); PG8_BAR; PG8_WAIT_L(0); PG8_MMA(0, 0, At, B0); PG8_BAR; PG8_SCHED;
            PG8_LDB(B1, 1, 1); PG8_STAGE(PG8_SB(1, 0), b3, voffB);
            PG8_BAR; PG8_WAIT_L(0); PG8_MMA(0, 1, At, B1); PG8_BAR;
            PG8_LDA(At, 1, 1); PG8_STAGE(PG8_SA(1, 0), a3, voffA);
            PG8_BAR; PG8_WAIT_L(0); PG8_MMA(1, 0, At, B0); PG8_BAR; PG8_SCHED;
            PG8_STAGE(PG8_SB(1, 1), b3 + hstep, voffB);
            PG8_WAIT_V(6); PG8_BAR; PG8_MMA(1, 1, At, B1); PG8_BAR;
        }
        E(acc, cur, wr, wc, fr, fq);
        if (!has_next) break;
#pragma unroll
        for (int a = 0; a < 2; ++a)
#pragma unroll
            for (int b = 0; b < 2; ++b)
#pragma unroll
                for (int m = 0; m < 4; ++m)
#pragma unroll
                    for (int n = 0; n < 2; ++n) acc[a][b][m][n] = (f32x4){0.f, 0.f, 0.f, 0.f};
        cur = nxt; cA = nA; cB = nB; ++ui;
    }
    PG8_WAIT_V(0);
    if (wr == 0) PG8_BAR;
    PG8_BAR;
#undef PG8_SA
#undef PG8_SB
#undef PG8_STAGE
#undef PG8_LDA
#undef PG8_LDB
#undef PG8_MMA
#undef PG8_WAIT_V
#undef PG8_WAIT_L
#undef PG8_BAR
#undef PG8_SCHED
}
}

__device__ __forceinline__ void gemm64_resid(LAS unsigned char* lds, const bf16_t* A, const bf16_t* Bt, const int K, const int row0, const int col0, const float* X, float* Z, const int tid) {
    const int wave = tid >> 6, lane = tid & 63, fr = lane & 15, fq = lane >> 4;
    const int kper = K >> 3;
    f32x4 acc[4][4];
#pragma unroll
    for (int m = 0; m < 4; ++m)
#pragma unroll
        for (int n = 0; n < 4; ++n) acc[m][n] = (f32x4){0.f, 0.f, 0.f, 0.f};
    const bf16_t* Ap = A + (size_t)(row0 + fr) * K + wave * kper + fq * 8;
    const bf16_t* Bp = Bt + (size_t)(col0 + fr) * K + wave * kper + fq * 8;
    const size_t rs16 = (size_t)16 * K;
#pragma unroll 2
    for (int ks = 0; ks < (kper >> 5); ++ks) {
        bf16x8 a[4], b[4];
#pragma unroll
        for (int m = 0; m < 4; ++m) { a[m] = *(const bf16x8*)(Ap + m * rs16 + ks * 32); b[m] = *(const bf16x8*)(Bp + m * rs16 + ks * 32); }
#pragma unroll
        for (int m = 0; m < 4; ++m)
#pragma unroll
            for (int n = 0; n < 4; ++n) acc[m][n] = __builtin_amdgcn_mfma_f32_16x16x32_bf16(a[m], b[n], acc[m][n], 0, 0, 0);
    }
    LAS unsigned char* part = lds + wave * (64 * 272);
#pragma unroll
    for (int m = 0; m < 4; ++m)
#pragma unroll
        for (int n = 0; n < 4; ++n)
#pragma unroll
            for (int jj = 0; jj < 4; ++jj) *(LAS float*)(part + (m * 16 + fq * 4 + jj) * 272 + (n * 16 + fr) * 4) = acc[m][n][jj];
    __syncthreads();
    { const int r = tid >> 3, c8 = (tid & 7) * 8; f32x4 s0 = (f32x4){0.f, 0.f, 0.f, 0.f}, s1 = s0;
#pragma unroll
      for (int w = 0; w < 8; ++w) { s0 += *(const LAS f32x4*)(lds + w * (64 * 272) + r * 272 + c8 * 4); s1 += *(const LAS f32x4*)(lds + w * (64 * 272) + r * 272 + c8 * 4 + 16); }
      const size_t off = (size_t)(row0 + r) * DM + col0 + c8;
      const f32x4 x0 = *(const f32x4*)(X + off), x1 = *(const f32x4*)(X + off + 4);
      *(f32x4*)(Z + off) = x0 * ALPHA + s0; *(f32x4*)(Z + off + 4) = x1 * ALPHA + s1; }
    __syncthreads();
}

__device__ __forceinline__ void phase_convert(const Params& p, float* L, const int tid, const int bid, const int G, const int tile_lo, const int tile_hi, const bool misc) {
    for (int tB = tile_lo + bid * 4; tB < tile_hi; tB += G * 4) {
        float4 v[4][2]; bf16_t* wt[4]; int kk[4], kb[4], nb[4];
#pragma unroll
        for (int q = 0; q < 4; ++q) { const int tI = tB + q; wt[q] = nullptr; kk[q] = 0; kb[q] = 0; nb[q] = 0;
            if (tI < tile_hi) {
                int j = tI; const float* W; bf16_t* Wt; int K, N;
                if (j < 960) { W = p.in[6]; Wt = (bf16_t*)(p.ws + WS_WIN); K = DM; N = NPROJ; }
                else if ((j -= 960) < 256) { W = p.in[20]; Wt = (bf16_t*)(p.ws + WS_WOUT); K = DM; N = DM; }
                else if ((j -= 256) < 768) { W = p.in[21]; Wt = (bf16_t*)(p.ws + WS_WCIN); K = DM; N = NCONV; }
                else if ((j -= 768) < 256) { W = p.in[23]; Wt = (bf16_t*)(p.ws + WS_WCOUT); K = DM; N = DM; }
                else if ((j -= 256) < 1024) { W = p.in[28]; Wt = (bf16_t*)(p.ws + WS_WUP0); K = DM; N = DFF; }
                else if ((j -= 1024) < 1024) { W = p.in[28] + (size_t)DM * DFF; Wt = (bf16_t*)(p.ws + WS_WUP1); K = DM; N = DFF; }
                else if ((j -= 1024) < 1024) { W = p.in[29]; Wt = (bf16_t*)(p.ws + WS_WDN0); K = DFF; N = DM; }
                else { j -= 1024; W = p.in[29] + (size_t)DM * DFF; Wt = (bf16_t*)(p.ws + WS_WDN1); K = DFF; N = DM; }
                const int tn = N / 64, k0 = (j / tn) * 64, n0 = (j % tn) * 64;
                wt[q] = Wt; kk[q] = K; kb[q] = k0; nb[q] = n0;
#pragma unroll
                for (int i = 0; i < 2; ++i) { const int e = tid + i * 512, r = e >> 4, c4 = e & 15; v[q][i] = *(const float4*)(W + (size_t)(k0 + r) * N + n0 + c4 * 4); } } }
#pragma unroll
        for (int q = 0; q < 4; ++q) if (wt[q]) {
#pragma unroll
            for (int i = 0; i < 2; ++i) { const int e = tid + i * 512, r = e >> 4, c4 = e & 15; float* d = L + q * 4160 + r * 65 + c4 * 4; d[0] = v[q][i].x; d[1] = v[q][i].y; d[2] = v[q][i].z; d[3] = v[q][i].w; } }
        __syncthreads();
#pragma unroll
        for (int q = 0; q < 4; ++q) if (wt[q]) { const int n = tid >> 3, k8 = tid & 7; float f[8];
#pragma unroll
            for (int z = 0; z < 8; ++z) f[z] = L[q * 4160 + (k8 * 8 + z) * 65 + n];
            u32x4 w; w.x = cvt_pk_bf16(f[0], f[1]); w.y = cvt_pk_bf16(f[2], f[3]); w.z = cvt_pk_bf16(f[4], f[5]); w.w = cvt_pk_bf16(f[6], f[7]);
            *(u32x4*)(wt[q] + (size_t)(nb[q] + n) * kk[q] + kb[q] + k8 * 8) = w; }
        __syncthreads();
    }
    if (!misc) return;
    { bf16_t* xb = (bf16_t*)(p.ws + WS_ACT);
      const size_t n8 = (size_t)MT * DM / 8, np8 = (size_t)MP * DM / 8;
      for (size_t i = (size_t)bid * NTHREADS + tid; i < n8; i += (size_t)G * NTHREADS) {
          const float* src = (i < np8) ? p.in[0] + i * 8 : p.in[1] + (i - np8) * 8;
          const float4 a = *(const float4*)src, b = *(const float4*)(src + 4);
          u32x4 w; w.x = cvt_pk_bf16(a.x, a.y); w.y = cvt_pk_bf16(a.z, a.w); w.z = cvt_pk_bf16(b.x, b.y); w.w = cvt_pk_bf16(b.z, b.w);
          *(u32x4*)(xb + i * 8) = w; } }
    { bf16_t* w2t = (bf16_t*)(p.ws + WS_W2T); bf16_t* a2t = (bf16_t*)(p.ws + WS_A2T); bf16_t* g2t = (bf16_t*)(p.ws + WS_G2T);
      for (int i = bid * NTHREADS + tid; i < 512 * 256; i += G * NTHREADS) { const int c = i >> 8, j = i & 255;
          if (j < 64) w2t[c * 64 + j] = (bf16_t)(cvt_pk_bf16(p.in[9][j * 512 + c], 0.f) & 0xffffu);
          else if (j < 128) a2t[c * 64 + (j - 64)] = (bf16_t)(cvt_pk_bf16(p.in[11][(j - 64) * 512 + c], 0.f) & 0xffffu);
          else g2t[c * 128 + (j - 128)] = (bf16_t)(cvt_pk_bf16(p.in[12][(j - 128) * 512 + c], 0.f) & 0xffffu); } }
    { float2* rope = (float2*)(p.ws + WS_ROPE);
      for (int i = bid * NTHREADS + tid; i < 2056 * 32; i += G * NTHREADS) {
          const int pidx = i >> 5, f = i & 31; const double pos = (double)(pidx < 2048 ? pidx : 16384 + (pidx - 2048));
          double rev = pos * p.inv_freq[f] * 0.15915494309189535; rev -= rint(rev);
          const float fr = (float)rev;
          rope[i] = make_float2(__builtin_amdgcn_cosf(fr), __builtin_amdgcn_sinf(fr)); } }
}

__device__ __forceinline__ void st_lds_bf16(LAS unsigned char* base, int byteoff, float v) { *(LAS bf16_t*)(base + byteoff) = (bf16_t)(cvt_pk_bf16(v, 0.f) & 0xffffu); }
constexpr int LRS = 528;
constexpr int S_LIN = 30720, S_AW = S_LIN + 16 * 528, S_AA = S_AW + 2048, S_AG = S_AA + 2048;
__device__ __forceinline__ void phase_sample(const Params& p, LAS unsigned char* lds, const int tid_in, const int bid, const int G) {
    const bf16_t* proj = (const bf16_t*)(p.ws + WS_BIG);
    bf16_t* ycat = (bf16_t*)(p.ws + WS_ACT);
    const float2* rope = (const float2*)(p.ws + WS_ROPE);
    const float* mu = p.in[7];
    LAS float* lora = (LAS float*)lds;
    LAS float* sc_r = lora + 2048; LAS float* sc_w = sc_r + 512; LAS float* sc_k = sc_w + 512; LAS float* sc_v = sc_k + 512; LAS float* sc_a = sc_v + 512; LAS float* sc_b = sc_a + 512;
    LAS float* rt_q = sc_b + 512; LAS float* rt_k = rt_q + 512; LAS float* rt_v = rt_k + 512; LAS float* o_w = rt_v + 512; LAS float* o_r = o_w + 512;
    for (int it = bid; it < NBS * 8; it += G) {
        int tid = tid_in; asm volatile("" : "+v"(tid));
        const int lane = tid & 63, wave = tid >> 6, c = lane, t = wave;
        const int b = it >> 3, h = it & 7, hc = h * 64; const unsigned hcc = (unsigned)(hc + c);
        const int rowbase = MP + b * TS;
        const float* shift0 = p.in[2] + (size_t)b * APROJ;
#pragma unroll
        for (int q = 0; q < 4; ++q) { const int idx = tid + q * NTHREADS; const int tt = idx >> 8, j = idx & 255; const unsigned col = 1536u + (unsigned)j; const unsigned ro = (unsigned)(rowbase + tt) * (unsigned)NPROJ;
            const float pc = bf2f(proj[ro + col]); const float pp = (tt == 0) ? shift0[col] : bf2f(proj[ro - (unsigned)NPROJ + col]);
            const float m = pc + (pp - pc) * mu[col];
            st_lds_bf16(lds + S_LIN, tt * LRS + j * 2, j < 64 ? (1.0f - 2.0f / (__expf(2.0f * m) + 1.0f)) : (j < 128 ? m : 1.0f / (1.0f + __expf(-m)))); }
        float mr, mk, mv, qg;
        { const unsigned ro = (unsigned)(rowbase + t) * (unsigned)NPROJ; const unsigned rp = ro - (unsigned)NPROJ; const bool first = (t == 0);
          { const float pc = bf2f(proj[ro + hcc]); const float pp = first ? shift0[hcc] : bf2f(proj[rp + hcc]); mr = pc + (pp - pc) * mu[hcc]; }
          { const float pc = bf2f(proj[ro + 512u + hcc]); const float pp = first ? shift0[512u + hcc] : bf2f(proj[rp + 512u + hcc]); mk = pc + (pp - pc) * mu[512u + hcc]; }
          { const float pc = bf2f(proj[ro + 1024u + hcc]); const float pp = first ? shift0[1024u + hcc] : bf2f(proj[rp + 1024u + hcc]); mv = pc + (pp - pc) * mu[1024u + hcc]; }
          const float2 cs = rope[(unsigned)(2048 + t) * 32u + (unsigned)(c & 31)]; const float sgn = (c < 32) ? -1.f : 1.f; const unsigned hco = (unsigned)(hc + (c ^ 32));
          const float qs = bf2f(proj[ro + (unsigned)APROJ + hcc]), qo = bf2f(proj[ro + (unsigned)APROJ + hco]);
          const float ks = bf2f(proj[ro + (unsigned)(APROJ + 512) + hcc]), ko = bf2f(proj[ro + (unsigned)(APROJ + 512) + hco]);
          rt_q[t * 64 + c] = qs * cs.x + sgn * qo * cs.y; rt_k[t * 64 + c] = (ks * cs.x + sgn * ko * cs.y) * 0.125f;
          rt_v[t * 64 + c] = bf2f(proj[ro + (unsigned)(APROJ + 1024) + hcc]); qg = bf2f(proj[ro + (unsigned)(APROJ + 1536) + hcc]); }
        __syncthreads();
        float gv, bonus;
        { const int fr = lane & 15, fq = lane >> 4, nt = wave & 3; const unsigned cr = (unsigned)(hc + nt * 16 + fr);
          const bf16_t* w2t = (const bf16_t*)(p.ws + WS_W2T); const bf16_t* a2t = (const bf16_t*)(p.ws + WS_A2T); const bf16_t* g2t = (const bf16_t*)(p.ws + WS_G2T);
          if (wave < 4) { f32x4 dw = (f32x4){0.f, 0.f, 0.f, 0.f}, da = dw;
#pragma unroll
              for (int ks = 0; ks < 2; ++ks) { const bf16x8 x0 = *(const LAS bf16x8*)(lds + S_LIN + fr * LRS + (ks * 32 + fq * 8) * 2), x1 = *(const LAS bf16x8*)(lds + S_LIN + fr * LRS + (64 + ks * 32 + fq * 8) * 2);
                  dw = __builtin_amdgcn_mfma_f32_16x16x32_bf16(x0, *(const bf16x8*)(w2t + cr * 64u + (unsigned)(ks * 32 + fq * 8)), dw, 0, 0, 0);
                  da = __builtin_amdgcn_mfma_f32_16x16x32_bf16(x1, *(const bf16x8*)(a2t + cr * 64u + (unsigned)(ks * 32 + fq * 8)), da, 0, 0, 0); }
              if (fq < 2) {
#pragma unroll
                  for (int jj = 0; jj < 4; ++jj) { *(LAS float*)(lds + S_AW + (fq * 4 + jj) * 256 + (nt * 16 + fr) * 4) = dw[jj]; *(LAS float*)(lds + S_AA + (fq * 4 + jj) * 256 + (nt * 16 + fr) * 4) = da[jj]; } } }
          else { f32x4 dg = (f32x4){0.f, 0.f, 0.f, 0.f};
#pragma unroll
              for (int ks = 0; ks < 4; ++ks) { const bf16x8 x2 = *(const LAS bf16x8*)(lds + S_LIN + fr * LRS + (128 + ks * 32 + fq * 8) * 2);
                  dg = __builtin_amdgcn_mfma_f32_16x16x32_bf16(x2, *(const bf16x8*)(g2t + cr * 128u + (unsigned)(ks * 32 + fq * 8)), dg, 0, 0, 0); }
              if (fq < 2) {
#pragma unroll
                  for (int jj = 0; jj < 4; ++jj) *(LAS float*)(lds + S_AG + (fq * 4 + jj) * 256 + (nt * 16 + fr) * 4) = dg[jj]; } } }
        __syncthreads();
        { const float aw = p.in[8][hcc] + *(const LAS float*)(lds + S_AW + t * 256 + c * 4), aa = p.in[10][hcc] + *(const LAS float*)(lds + S_AA + t * 256 + c * 4), ag = *(const LAS float*)(lds + S_AG + t * 256 + c * 4);
          const float z = -aw; const float sp = fmaxf(z, 0.f) + log1pf(__expf(-fabsf(z)));
          const float decay = __expf(-__expf(-sp - 0.5f));
          const float al = 1.0f / (1.0f + __expf(-aa));
          const float kkr = mk * p.in[13][hcc]; const float ss = wave_sum(kkr * kkr); const float kk = kkr * rsqrtf(fmaxf(ss, 1e-24f));
          const float kp = mk * (1.0f + (al - 1.0f) * p.in[14][hcc]);
          bonus = wave_sum(mr * kp * p.in[15][hcc]); gv = ag;
          sc_r[t * 64 + c] = mr; sc_w[t * 64 + c] = decay; sc_k[t * 64 + c] = kp; sc_v[t * 64 + c] = mv; sc_a[t * 64 + c] = -kk; sc_b[t * 64 + c] = kk * al; }
        __syncthreads();
        { const int wv = wave & 3, rloc = lane >> 2, kc = lane & 3, row = wv * 16 + rloc;
          float St[16];
          if (wave < 4) {
              const float* src = p.in[3] + (size_t)(b * 8 + h) * 4096 + (unsigned)(row * 64 + kc * 16);
#pragma unroll
              for (int i4 = 0; i4 < 4; ++i4) { const f32x4 v4 = *(const f32x4*)(src + i4 * 4); St[i4 * 4] = v4[0]; St[i4 * 4 + 1] = v4[1]; St[i4 * 4 + 2] = v4[2]; St[i4 * 4 + 3] = v4[3]; }
              for (int s = 0; s < TS; ++s) {
                  const LAS f32x4* A4 = (const LAS f32x4*)(sc_a + s * 64 + kc * 16); const LAS f32x4* W4 = (const LAS f32x4*)(sc_w + s * 64 + kc * 16); const LAS f32x4* B4 = (const LAS f32x4*)(sc_b + s * 64 + kc * 16);
                  const LAS f32x4* K4 = (const LAS f32x4*)(sc_k + s * 64 + kc * 16); const LAS f32x4* R4 = (const LAS f32x4*)(sc_r + s * 64 + kc * 16);
                  float sa = 0.f;
#pragma unroll
                  for (int i4 = 0; i4 < 4; ++i4) { const f32x4 a = A4[i4]; sa += (St[i4 * 4] * a[0] + St[i4 * 4 + 1] * a[1]) + (St[i4 * 4 + 2] * a[2] + St[i4 * 4 + 3] * a[3]); }
                  sa += dpp_mov<0xB1>(sa); sa += dpp_mov<0x4E>(sa);
                  const float vv = sc_v[s * 64 + row]; float o = 0.f;
#pragma unroll
                  for (int i4 = 0; i4 < 4; ++i4) { const f32x4 w = W4[i4], bb = B4[i4], kq = K4[i4], r = R4[i4];
#pragma unroll
                      for (int q = 0; q < 4; ++q) { St[i4 * 4 + q] = St[i4 * 4 + q] * w[q] + sa * bb[q] + vv * kq[q]; o += St[i4 * 4 + q] * r[q]; } }
                  o += dpp_mov<0xB1>(o); o += dpp_mov<0x4E>(o);
                  if (kc == 0) o_w[s * 64 + row] = o;
              }
              float* dst = p.out + O_SWKV + (size_t)(b * 8 + h) * 4096 + (unsigned)(row * 64 + kc * 16);
#pragma unroll
              for (int i4 = 0; i4 < 4; ++i4) *(f32x4*)(dst + i4 * 4) = (f32x4){St[i4 * 4], St[i4 * 4 + 1], St[i4 * 4 + 2], St[i4 * 4 + 3]};
          } else {
              const float gamma = 1.0f - exp2f(-5.0f - (float)h);
              const float* src = p.in[4] + (size_t)(b * 8 + h) * 4096 + (unsigned)(kc * 16 * 64 + row);
#pragma unroll
              for (int i = 0; i < 16; ++i) St[i] = src[i * 64];
              for (int s = 0; s < TS; ++s) {
                  const LAS f32x4* K4 = (const LAS f32x4*)(rt_k + s * 64 + kc * 16); const LAS f32x4* Q4 = (const LAS f32x4*)(rt_q + s * 64 + kc * 16);
                  const float vv = rt_v[s * 64 + row]; float o = 0.f;
#pragma unroll
                  for (int i4 = 0; i4 < 4; ++i4) { const f32x4 kq = K4[i4], q4 = Q4[i4];
#pragma unroll
                      for (int q = 0; q < 4; ++q) { St[i4 * 4 + q] = St[i4 * 4 + q] * gamma + kq[q] * vv; o += St[i4 * 4 + q] * q4[q]; } }
                  o += dpp_mov<0xB1>(o); o += dpp_mov<0x4E>(o);
                  if (kc == 0) o_r[s * 64 + row] = o;
              }
              float* dst = p.out + O_SRET + (size_t)(b * 8 + h) * 4096 + (unsigned)(kc * 16 * 64 + row);
#pragma unroll
              for (int i = 0; i < 16; ++i) dst[i * 64] = St[i];
          } }
        __syncthreads();
        { const unsigned row = (unsigned)(rowbase + t);
          { const float o = o_w[t * 64 + c]; const float mean = wave_sum(o) * (1.f / 64.f); const float d = o - mean; const float var = wave_sum(d * d) * (1.f / 64.f);
            const float ya = (d * rsqrtf(var + 64e-5f) * p.in[16][hcc] + p.in[17][hcc] + bonus * mv) * gv;
            const float ya2 = dpp_mov<0xF5>(ya); if (!(c & 1)) *(unsigned*)(ycat + (row * (unsigned)DM + hcc)) = cvt_pk_bf16(ya, ya2); }
          { const float o = o_r[t * 64 + c]; const float mean = wave_sum(o) * (1.f / 64.f); const float d = o - mean; const float var = wave_sum(d * d) * (1.f / 64.f);
            const float yb = qg / (1.0f + __expf(-qg)) * (d * rsqrtf(var + 1e-5f) * p.in[18][hcc] + p.in[19][hcc]);
            const float yb2 = dpp_mov<0xF5>(yb); if (!(c & 1)) *(unsigned*)(ycat + (row * (unsigned)DM + 512u + hcc)) = cvt_pk_bf16(yb, yb2); } }
        if (h == 0) { float* dst = p.out + O_SSHIFT + (size_t)b * APROJ; const bf16_t* pr = proj + (size_t)(rowbase + TS - 1) * NPROJ;
            for (int j = tid; j < APROJ; j += NTHREADS) dst[j] = bf2f(pr[j]); }
        __syncthreads();
    }
}

constexpr int RS = 144;
constexpr int UNIT = 64 * RS;
constexpr int FRS = 272;
constexpr int U_AT = 0, U_BT = UNIT, U_KT = 2 * UNIT, U_RT = 3 * UNIT, U_VT = 4 * UNIT, U_BH = 5 * UNIT, U_KH = 6 * UNIT;
constexpr int U_LAK = 7 * UNIT, U_MRB = 8 * UNIT, U_MRK = 9 * UNIT, U_PT = 10 * UNIT, U_QT = 11 * UNIT;
constexpr int F_LAB = 12 * UNIT, F_X = F_LAB + 64 * FRS, F_MISC = F_X + 64 * FRS;
constexpr int L_LIN = 7 * UNIT, F_AW = L_LIN + 64 * LRS, F_AA = F_AW + 64 * FRS;
static_assert(F_MISC + 2304 <= LDS_BYTES && F_AA + 64 * FRS <= F_MISC, "LDS map");

__device__ __forceinline__ f32x4 mm2(const LAS unsigned char* A, const LAS unsigned char* B, int arow, int brow, int fq, f32x4 acc) {
#pragma unroll
    for (int ks = 0; ks < 2; ++ks) {
        const bf16x8 a = *(const LAS bf16x8*)(A + arow * RS + (ks * 32 + fq * 8) * 2);
        const bf16x8 b = *(const LAS bf16x8*)(B + brow * RS + (ks * 32 + fq * 8) * 2);
        acc = __builtin_amdgcn_mfma_f32_16x16x32_bf16(a, b, acc, 0, 0, 0);
    }
    return acc;
}
#ifndef SAN
#define SAN 0
#endif
template <int CAT> __device__ __forceinline__ u32x2 pk4c(f32x4 v) { u32x2 w;
    if (SAN & (1 << CAT)) {
#pragma unroll
        for (int q = 0; q < 4; ++q) v[q] = (fabsf(v[q]) <= 3.0e38f) ? v[q] : 0.f; }
    w.x = cvt_pk_bf16(v[0], v[1]); w.y = cvt_pk_bf16(v[2], v[3]); return w; }

__device__ __forceinline__ void phase_mix_local(const Params& p, LAS unsigned char* lds, const int tid_in, const int bid, const int G) {
    bf16_t* proj = (bf16_t*)(p.ws + WS_BIG);
    const float2* rope = (const float2*)(p.ws + WS_ROPE);
    const float* mu = p.in[7];
    for (int item = bid; item < 2048; item += G) {
        int tid = tid_in; asm volatile("" : "+v"(tid));
        const int lane = tid & 63, wave = tid >> 6, fr = lane & 15, fq = lane >> 4;
        const int c = lane, tg = wave;
        const int mt = wave & 3, nt0 = (wave >> 2) * 2;
        const int bh = item >> 5, ch = item & 31, b = bh >> 3, h = bh & 7, hc = h * 64;
        const unsigned hcc = (unsigned)(hc + c);
        const int rowbase = b * TP + ch * 64;
        unsigned char* r1 = p.ws + WS_ACT + (size_t)item * 16384;
        unsigned char* r2 = (unsigned char*)(p.out + O_Y) + (size_t)item * 24576;
        unsigned char* r3 = p.ws + WS_R3 + (size_t)item * 8192;
        {
            const float l2g = log2f(1.0f - exp2f(-5.0f - (float)h));
            float qv[8], kv[8], vv[8];
#pragma unroll
            for (int i = 0; i < 8; ++i) { const int t = tg * 8 + i; const unsigned ro = (unsigned)(rowbase + t) * (unsigned)NPROJ;
                const float2 cs = rope[(unsigned)(ch * 64 + t) * 32u + (unsigned)(c & 31)];
                const float sgn = (c < 32) ? -1.f : 1.f; const unsigned hco = (unsigned)(hc + (c ^ 32));
                const float qs = bf2f(proj[ro + (unsigned)APROJ + hcc]), qo = bf2f(proj[ro + (unsigned)APROJ + hco]);
                const float ks = bf2f(proj[ro + (unsigned)(APROJ + 512) + hcc]), ko = bf2f(proj[ro + (unsigned)(APROJ + 512) + hco]);
                qv[i] = qs * cs.x + sgn * qo * cs.y; kv[i] = (ks * cs.x + sgn * ko * cs.y) * 0.125f; vv[i] = bf2f(proj[ro + (unsigned)(APROJ + 1024) + hcc]); }
            asm volatile("s_waitcnt vmcnt(0)" ::: "memory");
            __syncthreads();
            { float vt[8], kh[8];
#pragma unroll
              for (int i = 0; i < 8; ++i) { const int t = tg * 8 + i; const unsigned ro = (unsigned)(rowbase + t) * (unsigned)NPROJ;
                  const float qd = qv[i] * exp2f(l2g * (float)(t + 1));
                  const unsigned qb = cvt_pk_bf16(qd, 0.f) & 0xffffu;
                  proj[ro + (unsigned)APROJ + hcc] = (bf16_t)qb;
                  *(LAS bf16_t*)(lds + U_RT + t * RS + c * 2) = (bf16_t)qb;
                  st_lds_bf16(lds + U_KT, t * RS + c * 2, kv[i] * exp2f(-l2g * (float)(t + 1)));
                  vt[i] = vv[i]; kh[i] = kv[i] * exp2f(l2g * (float)(63 - t)); }
              u32x4 w; w.x = cvt_pk_bf16(vt[0], vt[1]); w.y = cvt_pk_bf16(vt[2], vt[3]); w.z = cvt_pk_bf16(vt[4], vt[5]); w.w = cvt_pk_bf16(vt[6], vt[7]);
              *(LAS u32x4*)(lds + U_VT + c * RS + tg * 16) = w;
              w.x = cvt_pk_bf16(kh[0], kh[1]); w.y = cvt_pk_bf16(kh[2], kh[3]); w.z = cvt_pk_bf16(kh[4], kh[5]); w.w = cvt_pk_bf16(kh[6], kh[7]);
              *(LAS u32x4*)(lds + U_KH + c * RS + tg * 16) = w; }
            __syncthreads();
#pragma unroll
            for (int n = 0; n < 2; ++n) { const int nt = nt0 + n; f32x4 acc = (f32x4){0.f, 0.f, 0.f, 0.f};
                acc = mm2(lds + U_KT, lds + U_RT, mt * 16 + fr, nt * 16 + fr, fq, acc);
                const int t = nt * 16 + fr, j0 = mt * 16 + fq * 4;
#pragma unroll
                for (int jj = 0; jj < 4; ++jj) if (j0 + jj > t) acc[jj] = 0.f;
                *(LAS u32x2*)(lds + U_MRK + t * RS + j0 * 2) = pk4c<1>(acc); }
            __syncthreads();
#pragma unroll
            for (int n = 0; n < 2; ++n) { const int nt = nt0 + n;
                { f32x4 acc = (f32x4){0.f, 0.f, 0.f, 0.f};
                  acc = mm2(lds + U_VT, lds + U_MRK, mt * 16 + fr, nt * 16 + fr, fq, acc);
                  const int t = nt * 16 + fr, v0 = mt * 16 + fq * 4;
                  *(u32x2*)(proj + (unsigned)(rowbase + t) * (unsigned)NPROJ + (unsigned)(APROJ + 512 + hc + v0)) = pk4c<1>(acc); }
                { f32x4 acc = (f32x4){0.f, 0.f, 0.f, 0.f};
                  acc = mm2(lds + U_KH, lds + U_VT, mt * 16 + fr, nt * 16 + fr, fq, acc);
                  const int v = nt * 16 + fr, k0 = mt * 16 + fq * 4;
                  *(u32x2*)(r3 + v * 128 + k0 * 2) = pk4c<1>(acc); } }
            __syncthreads();
        }
        {
            { const int j = tid & 255, t0 = (tid >> 8) * 32; const unsigned col = 1536u + (unsigned)j; const float muc = mu[col];
              const unsigned ro0 = (unsigned)(rowbase + t0) * (unsigned)NPROJ + col;
              float pv[33];
              pv[0] = (ch == 0 && t0 == 0) ? 0.f : bf2f(proj[ro0 - (unsigned)NPROJ]);
#pragma unroll
              for (int i = 0; i < 32; ++i) pv[i + 1] = bf2f(proj[ro0 + (unsigned)i * (unsigned)NPROJ]);
#pragma unroll
              for (int i = 0; i < 32; ++i) { const float m = pv[i + 1] + (pv[i] - pv[i + 1]) * muc;
                  st_lds_bf16(lds + L_LIN, (t0 + i) * LRS + j * 2, j < 64 ? (1.0f - 2.0f / (__expf(2.0f * m) + 1.0f)) : (j < 128 ? m : 1.0f / (1.0f + __expf(-m)))); } }
            float mr[8], mk[8], mv[8];
            { const float mu_r = mu[hcc], mu_k = mu[512u + hcc], mu_v = mu[1024u + hcc];
#pragma unroll
              for (int i = 0; i < 8; ++i) { const int t = tg * 8 + i; const unsigned ro = (unsigned)(rowbase + t) * (unsigned)NPROJ; const unsigned rp = ro - (unsigned)NPROJ; const bool first = (ch == 0 && t == 0);
                  { const float pc = bf2f(proj[ro + hcc]); const float pp = first ? 0.f : bf2f(proj[rp + hcc]); mr[i] = pc + (pp - pc) * mu_r; }
                  { const float pc = bf2f(proj[ro + 512u + hcc]); const float pp = first ? 0.f : bf2f(proj[rp + 512u + hcc]); mk[i] = pc + (pp - pc) * mu_k; }
                  { const float pc = bf2f(proj[ro + 1024u + hcc]); const float pp = first ? 0.f : bf2f(proj[rp + 1024u + hcc]); mv[i] = pc + (pp - pc) * mu_v; } } }
            __syncthreads();
            { const bf16_t* w2t = (const bf16_t*)(p.ws + WS_W2T); const bf16_t* a2t = (const bf16_t*)(p.ws + WS_A2T); const bf16_t* g2t = (const bf16_t*)(p.ws + WS_G2T);
#pragma unroll
              for (int n = 0; n < 2; ++n) { const int nt = nt0 + n; const unsigned cr = (unsigned)(hc + nt * 16 + fr);
                  f32x4 dw = (f32x4){0.f, 0.f, 0.f, 0.f}, da = dw, dg = dw;
#pragma unroll
                  for (int ks = 0; ks < 2; ++ks) {
                      const bf16x8 x0 = *(const LAS bf16x8*)(lds + L_LIN + (mt * 16 + fr) * LRS + (ks * 32 + fq * 8) * 2), x1 = *(const LAS bf16x8*)(lds + L_LIN + (mt * 16 + fr) * LRS + (64 + ks * 32 + fq * 8) * 2);
                      dw = __builtin_amdgcn_mfma_f32_16x16x32_bf16(x0, *(const bf16x8*)(w2t + cr * 64u + (unsigned)(ks * 32 + fq * 8)), dw, 0, 0, 0);
                      da = __builtin_amdgcn_mfma_f32_16x16x32_bf16(x1, *(const bf16x8*)(a2t + cr * 64u + (unsigned)(ks * 32 + fq * 8)), da, 0, 0, 0); }
#pragma unroll
                  for (int ks = 0; ks < 4; ++ks) { const bf16x8 x2 = *(const LAS bf16x8*)(lds + L_LIN + (mt * 16 + fr) * LRS + (128 + ks * 32 + fq * 8) * 2);
                      dg = __builtin_amdgcn_mfma_f32_16x16x32_bf16(x2, *(const bf16x8*)(g2t + cr * 128u + (unsigned)(ks * 32 + fq * 8)), dg, 0, 0, 0); }
#pragma unroll
                  for (int jj = 0; jj < 4; ++jj) { const int t = mt * 16 + fq * 4 + jj, cc = nt * 16 + fr;
                      *(LAS float*)(lds + F_AW + t * FRS + cc * 4) = dw[jj]; *(LAS float*)(lds + F_AA + t * FRS + cc * 4) = da[jj];
                      *(bf16_t*)(r2 + 8192 + t * 128 + cc * 2) = (bf16_t)(cvt_pk_bf16(dg[jj], 0.f) & 0xffffu); } } }
            __syncthreads();
            float lw[8], kp[8], na[8], bb[8];
            { float aw[8], aa[8];
              const float kkc = p.in[13][hcc], kac = p.in[14][hcc], rkc = p.in[15][hcc], w0c = p.in[8][hcc], a0c = p.in[10][hcc];
#pragma unroll
              for (int i = 0; i < 8; ++i) { const int t = tg * 8 + i; aw[i] = w0c + *(const LAS float*)(lds + F_AW + t * FRS + c * 4); aa[i] = a0c + *(const LAS float*)(lds + F_AA + t * FRS + c * 4); }
              float al8[8], ss8[8], bo8[8], kkr8[8];
#pragma unroll
              for (int i = 0; i < 8; ++i) {
                  const float z = -aw[i]; const float sp = fmaxf(z, 0.f) + log1pf(__expf(-fabsf(z)));
                  lw[i] = -__expf(-sp - 0.5f);
                  al8[i] = 1.0f / (1.0f + __expf(-aa[i]));
                  kkr8[i] = mk[i] * kkc; ss8[i] = kkr8[i] * kkr8[i];
                  kp[i] = mk[i] * (1.0f + (al8[i] - 1.0f) * kac); bo8[i] = mr[i] * kp[i] * rkc; }
#pragma unroll
              for (int i = 0; i < 8; ++i) { ss8[i] = wave_sum(ss8[i]); bo8[i] = wave_sum(bo8[i]); }
#pragma unroll
              for (int i = 0; i < 8; ++i) { const int t = tg * 8 + i;
                  const float kk = kkr8[i] * rsqrtf(fmaxf(ss8[i], 1e-24f));
                  na[i] = -kk; bb[i] = kk * al8[i];
                  *(bf16_t*)(r2 + 16384 + t * 128 + c * 2) = (bf16_t)(cvt_pk_bf16(bo8[i] * mv[i], 0.f) & 0xffffu); } }
            LAS float* wend = (LAS float*)(lds + F_MISC); LAS float* part = wend + 64;
            float cl[8];
            { float s = 0.f;
#pragma unroll
              for (int i = 0; i < 8; ++i) { s += lw[i]; cl[i] = s; }
              part[tg * 64 + c] = s; }
            __syncthreads();
            float base = 0.f, tot = 0.f;
#pragma unroll
            for (int g8 = 0; g8 < 8; ++g8) { const float pv = part[g8 * 64 + c]; tot += pv; if (g8 < tg) base += pv; }
            if (tg == 0) wend[c] = __expf(tot);
            { float vt[8], bh8[8], kh8[8];
#pragma unroll
              for (int i = 0; i < 8; ++i) { const int t = tg * 8 + i; const float cum = base + cl[i];
                  const float ec = __expf(cum), en = __expf(-cum), eh = __expf(tot - cum);
                  st_lds_bf16(lds + U_AT, t * RS + c * 2, na[i] * __expf(cum - lw[i]));
                  st_lds_bf16(lds + U_BT, t * RS + c * 2, bb[i] * en);
                  st_lds_bf16(lds + U_KT, t * RS + c * 2, kp[i] * en);
                  st_lds_bf16(lds + U_RT, t * RS + c * 2, mr[i] * ec);
                  vt[i] = mv[i]; bh8[i] = bb[i] * eh; kh8[i] = kp[i] * eh; }
              u32x4 w; w.x = cvt_pk_bf16(vt[0], vt[1]); w.y = cvt_pk_bf16(vt[2], vt[3]); w.z = cvt_pk_bf16(vt[4], vt[5]); w.w = cvt_pk_bf16(vt[6], vt[7]);
              *(LAS u32x4*)(lds + U_VT + c * RS + tg * 16) = w;
              w.x = cvt_pk_bf16(bh8[0], bh8[1]); w.y = cvt_pk_bf16(bh8[2], bh8[3]); w.z = cvt_pk_bf16(bh8[4], bh8[5]); w.w = cvt_pk_bf16(bh8[6], bh8[7]);
              *(LAS u32x4*)(lds + U_BH + c * RS + tg * 16) = w;
              w.x = cvt_pk_bf16(kh8[0], kh8[1]); w.y = cvt_pk_bf16(kh8[2], kh8[3]); w.z = cvt_pk_bf16(kh8[4], kh8[5]); w.w = cvt_pk_bf16(kh8[6], kh8[7]);
              *(LAS u32x4*)(lds + U_KH + c * RS + tg * 16) = w; }
            __syncthreads();
#pragma unroll
            for (int n = 0; n < 2; ++n) { const int nt = nt0 + n; const int t = nt * 16 + fr, j0 = mt * 16 + fq * 4; const f32x4 z4 = (f32x4){0.f, 0.f, 0.f, 0.f};
                f32x4 lab = mm2(lds + U_BT, lds + U_AT, mt * 16 + fr, nt * 16 + fr, fq, z4);
                f32x4 lak = mm2(lds + U_KT, lds + U_AT, mt * 16 + fr, nt * 16 + fr, fq, z4);
                f32x4 mrb = mm2(lds + U_BT, lds + U_RT, mt * 16 + fr, nt * 16 + fr, fq, z4);
                f32x4 mrk = mm2(lds + U_KT, lds + U_RT, mt * 16 + fr, nt * 16 + fr, fq, z4);
#pragma unroll
                for (int jj = 0; jj < 4; ++jj) { if (j0 + jj >= t) { lab[jj] = 0.f; lak[jj] = 0.f; } if (j0 + jj > t) { mrb[jj] = 0.f; mrk[jj] = 0.f; } }
                *(LAS f32x4*)(lds + F_LAB + t * FRS + j0 * 4) = lab;
                *(LAS u32x2*)(lds + U_LAK + t * RS + j0 * 2) = pk4c<0>(lak);
                *(LAS u32x2*)(lds + U_MRB + t * RS + j0 * 2) = pk4c<0>(mrb);
                *(LAS u32x2*)(lds + U_MRK + t * RS + j0 * 2) = pk4c<0>(mrk); }
            __syncthreads();
#pragma unroll
            for (int n = 0; n < 2; ++n) { const int nt = nt0 + n; const int t = nt * 16 + fr, v0 = mt * 16 + fq * 4;
                const f32x4 x = mm2(lds + U_VT, lds + U_LAK, mt * 16 + fr, nt * 16 + fr, fq, (f32x4){0.f, 0.f, 0.f, 0.f});
                *(LAS f32x4*)(lds + F_X + t * FRS + v0 * 4) = x; }
            { const int t = tid >> 3, j0 = (tid & 7) * 8;
              const f32x4 l0 = *(const LAS f32x4*)(lds + F_LAB + t * FRS + j0 * 4), l1 = *(const LAS f32x4*)(lds + F_LAB + t * FRS + j0 * 4 + 16);
              u32x4 w; w.x = cvt_pk_bf16(l0[0], l0[1]); w.y = cvt_pk_bf16(l0[2], l0[3]); w.z = cvt_pk_bf16(l1[0], l1[1]); w.w = cvt_pk_bf16(l1[2], l1[3]);
              if ((j0 >> 4) == (t >> 4)) w = (u32x4){0u, 0u, 0u, 0u};
              *(LAS u32x4*)(lds + U_KT + t * RS + j0 * 2) = w;
              for (int i = tid; i < 2 * UNIT / 16; i += NTHREADS) ((LAS u32x4*)(lds + U_PT))[i] = (u32x4){0u, 0u, 0u, 0u}; }
            __syncthreads();
#pragma unroll 1
            for (int bi = 0; bi < 4; ++bi) {
                { const LAS unsigned char* YB = lds + ((wave < 4) ? U_PT : U_QT); const int ntl = wave & 3;
                  f32x4 d = (f32x4){0.f, 0.f, 0.f, 0.f};
                  const int nks = (bi + 1) >> 1;
                  for (int ks = 0; ks < nks; ++ks) { const bf16x8 a = *(const LAS bf16x8*)(lds + U_KT + (bi * 16 + fr) * RS + (ks * 32 + fq * 8) * 2), bq = *(const LAS bf16x8*)(YB + (ntl * 16 + fr) * RS + (ks * 32 + fq * 8) * 2);
                      d = __builtin_amdgcn_mfma_f32_16x16x32_bf16(a, bq, d, 0, 0, 0); }
#pragma unroll
                  for (int jj = 0; jj < 4; ++jj) { const int i = fq * 4 + jj, row = bi * 16 + i;
                      const float rhs = (wave < 4) ? bf2f(*(const LAS bf16_t*)(lds + U_AT + row * RS + (ntl * 16 + fr) * 2)) : *(const LAS float*)(lds + F_X + row * FRS + (ntl * 16 + fr) * 4);
                      *(LAS float*)(lds + U_LAK + i * 528 + (wave * 16 + fr) * 4) = d[jj] + rhs; } }
                __syncthreads();
                if (wave < 2) {
                    LAS unsigned char* dst = lds + (wave == 0 ? U_PT : U_QT) + lane * RS;
                    float acc[16];
#pragma unroll
                    for (int r = 0; r < 16; ++r) acc[r] = *(const LAS float*)(lds + U_LAK + r * 528 + (wave * 64 + lane) * 4);
                    const LAS unsigned char* Ld = lds + F_LAB + (bi * 16) * FRS + bi * 64;
#pragma unroll
                    for (int r = 1; r < 16; ++r) {
#pragma unroll
                        for (int q4 = 0; q4 < (r + 3) / 4; ++q4) { const f32x4 l = *(const LAS f32x4*)(Ld + r * FRS + q4 * 16);
#pragma unroll
                            for (int q = 0; q < 4; ++q) if (q4 * 4 + q < r) acc[r] += l[q] * acc[q4 * 4 + q]; }
                    }
                    u32x4 w; w.x = cvt_pk_bf16(acc[0], acc[1]); w.y = cvt_pk_bf16(acc[2], acc[3]); w.z = cvt_pk_bf16(acc[4], acc[5]); w.w = cvt_pk_bf16(acc[6], acc[7]);
                    *(LAS u32x4*)(dst + bi * 32) = w;
                    w.x = cvt_pk_bf16(acc[8], acc[9]); w.y = cvt_pk_bf16(acc[10], acc[11]); w.z = cvt_pk_bf16(acc[12], acc[13]); w.w = cvt_pk_bf16(acc[14], acc[15]);
                    *(LAS u32x4*)(dst + bi * 32 + 16) = w;
                }
                __syncthreads();
            }
#pragma unroll
            for (int n = 0; n < 2; ++n) { const int nt = nt0 + n; const f32x4 z4 = (f32x4){0.f, 0.f, 0.f, 0.f};
                { f32x4 g4 = mm2(lds + U_PT, lds + U_MRB, mt * 16 + fr, nt * 16 + fr, fq, z4);
                  const int t = nt * 16 + fr, k0 = mt * 16 + fq * 4; const u32x2 rr = *(const LAS u32x2*)(lds + U_RT + t * RS + k0 * 2);
                  g4[0] += __uint_as_float(rr.x << 16); g4[1] += __uint_as_float(rr.x & 0xffff0000u); g4[2] += __uint_as_float(rr.y << 16); g4[3] += __uint_as_float(rr.y & 0xffff0000u);
                  *(u32x2*)(proj + (unsigned)(rowbase + t) * (unsigned)NPROJ + (unsigned)(APROJ + 1024 + hc + k0)) = pk4c<2>(g4); }
                { f32x4 h4 = mm2(lds + U_QT, lds + U_MRB, mt * 16 + fr, nt * 16 + fr, fq, z4);
                  h4 = mm2(lds + U_VT, lds + U_MRK, mt * 16 + fr, nt * 16 + fr, fq, h4);
                  const int t = nt * 16 + fr, v0 = mt * 16 + fq * 4;
                  *(u32x2*)(r2 + t * 128 + v0 * 2) = pk4c<2>(h4); }
                { f32x4 f4 = mm2(lds + U_PT, lds + U_BH, mt * 16 + fr, nt * 16 + fr, fq, z4);
                  const int k2 = nt * 16 + fr, k10 = mt * 16 + fq * 4;
#pragma unroll
                  for (int jj = 0; jj < 4; ++jj) if (k10 + jj == k2) f4[jj] += wend[k2];
                  *(u32x2*)(r1 + k2 * 128 + k10 * 2) = pk4c<3>(f4); }
                { f32x4 s4 = mm2(lds + U_BH, lds + U_QT, mt * 16 + fr, nt * 16 + fr, fq, z4);
                  s4 = mm2(lds + U_KH, lds + U_VT, mt * 16 + fr, nt * 16 + fr, fq, s4);
                  const int v = nt * 16 + fr, k0 = mt * 16 + fq * 4;
                  *(u32x2*)(r1 + 8192 + v * 128 + k0 * 2) = pk4c<3>(s4); } }
            if (h == 0 && ch == 31) { float* dst = p.out + O_PSHIFT + (size_t)b * APROJ; const bf16_t* pr = proj + (size_t)(rowbase + 63) * NPROJ;
                for (int j = tid; j < APROJ; j += NTHREADS) dst[j] = bf2f(pr[j]); }
            __syncthreads();
        }
    }
}

constexpr int ORS = 32;
constexpr int CH_SCR = 0, CH_OBUF = 4 * 16 * RS, CH_RING = CH_OBUF + 4 * 2 * 64 * ORS, CH_SLOT = 24576, CH_R = 5, CH_A = 4;
static_assert(CH_RING + CH_R * CH_SLOT <= 155648 && (CH_RING & 15) == 0, "chain LDS map");
__device__ __forceinline__ void phase_chain(const Params& p, LAS unsigned char* lds, const int tid, const int bid, const int G) {
    const int lane = tid & 63, wave = __builtin_amdgcn_readfirstlane(tid >> 6), fr = lane & 15, fq = lane >> 4;
    bf16_t* proj = (bf16_t*)(p.ws + WS_BIG);
#define CH_BAR() do { asm volatile("s_waitcnt lgkmcnt(0)" ::: "memory"); __builtin_amdgcn_s_barrier(); asm volatile("" ::: "memory"); } while (0)
    for (int chain = bid; chain < 128; chain += G) {
        const int kind = chain & 1, bh = chain >> 1, b = bh >> 3, h = bh & 7, hc = h * 64;
        const unsigned slot = APROJ + (kind ? 0 : 1024) + hc;
        if (wave < 4) {
            const int vt = wave;
            LAS unsigned char* scr = lds + CH_SCR + vt * (16 * RS);
            LAS unsigned char* obuf = lds + CH_OBUF + vt * (2 * 64 * ORS);
            const float gC = kind ? exp2f(64.0f * log2f(1.0f - exp2f(-5.0f - (float)h))) : 0.f;
            f32x4 S[4]; bf16x8 Sb[2];
#pragma unroll
            for (int m = 0; m < 4; ++m) S[m] = (f32x4){0.f, 0.f, 0.f, 0.f};
#pragma unroll
            for (int ks = 0; ks < 2; ++ks) Sb[ks] = (bf16x8){0, 0, 0, 0, 0, 0, 0, 0};
            for (int ch = 0; ch < 32; ++ch) {
                CH_BAR();
                const LAS unsigned char* sl = lds + CH_RING + (ch % CH_R) * CH_SLOT;
                LAS unsigned char* ob = obuf + (ch & 1) * (64 * ORS);
#pragma unroll
                for (int m = 0; m < 4; ++m) {
                    const u32x2 pw = *(const LAS u32x2*)(sl + 8192 + (vt * 16 + fr) * 128 + (m * 16 + fq * 4) * 2);
                    const f32x4 d = (f32x4){__uint_as_float(pw.x << 16), __uint_as_float(pw.x & 0xffff0000u), __uint_as_float(pw.y << 16), __uint_as_float(pw.y & 0xffff0000u)};
                    f32x4 dm = d, o = (f32x4){0.f, 0.f, 0.f, 0.f};
#pragma unroll
                    for (int ks = 0; ks < 2; ++ks) {
                        dm = __builtin_amdgcn_mfma_f32_16x16x32_bf16(*(const LAS bf16x8*)(sl + (m * 16 + fr) * 128 + (ks * 32 + fq * 8) * 2), Sb[ks], dm, 0, 0, 0);
                        o = __builtin_amdgcn_mfma_f32_16x16x32_bf16(*(const LAS bf16x8*)(sl + 16384 + (m * 16 + fr) * 128 + (ks * 32 + fq * 8) * 2), Sb[ks], o, 0, 0, 0); }
                    const f32x4 dr = S[m] * gC + d;
#pragma unroll
                    for (int q = 0; q < 4; ++q) S[m][q] = kind ? dr[q] : dm[q];
#pragma unroll
                    for (int jj = 0; jj < 4; ++jj) *(LAS bf16_t*)(ob + (m * 16 + fq * 4 + jj) * ORS + fr * 2) = (bf16_t)(cvt_pk_bf16(o[jj], 0.f) & 0xffffu);
                }
#pragma unroll
                for (int m = 0; m < 4; ++m) *(LAS u32x2*)(scr + fr * RS + (m * 16 + fq * 4) * 2) = pk4c<4>(S[m]);
                asm volatile("s_waitcnt lgkmcnt(0)" ::: "memory");
#pragma unroll
                for (int ks = 0; ks < 2; ++ks) Sb[ks] = *(const LAS bf16x8*)(scr + fr * RS + (ks * 32 + fq * 8) * 2);
            }
            CH_BAR();
            if (!kind) { float* dst = p.out + O_PWKV + ((size_t)bh * 64 + vt * 16 + fr) * 64;
#pragma unroll
                for (int m = 0; m < 4; ++m) *(f32x4*)(dst + m * 16 + fq * 4) = S[m]; }
            else { float* dst = p.out + O_PRET + (size_t)bh * 4096 + vt * 16 + fr;
#pragma unroll
                for (int m = 0; m < 4; ++m)
#pragma unroll
                    for (int jj = 0; jj < 4; ++jj) dst[(m * 16 + fq * 4 + jj) * 64] = S[m][jj]; }
        } else if (wave < 6) {
            const int lw = wave - 4;
#define CH_ISSUE(chx) do { const int item_ = bh * 32 + (chx); const unsigned char* r1_ = p.ws + WS_ACT + (size_t)item_ * 16384; \
                const unsigned char* psi_ = kind ? (p.ws + WS_R3 + (size_t)item_ * 8192) : (r1_ + 8192); \
                const unsigned char* gb_ = (const unsigned char*)(proj + (size_t)(b * TP + (chx) * 64) * NPROJ + slot); \
                LAS unsigned char* sl_ = lds + CH_RING + ((chx) % CH_R) * CH_SLOT; \
                _Pragma("unroll") for (int q = 0; q < 12; ++q) { const int pi = lw + 2 * q, seg = pi >> 3; const int off = (pi & 7) * 1024 + lane * 16; \
                    const unsigned char* src_ = seg == 0 ? (r1_ + off) : (seg == 1 ? (psi_ + off) : (gb_ + (size_t)(off >> 7) * (NPROJ * 2) + (off & 127))); \
                    __builtin_amdgcn_global_load_lds((const unsigned*)src_, (LAS unsigned*)(sl_ + pi * 1024), 16, 0, 0); } } while (0)
#pragma unroll
            for (int c0 = 0; c0 < CH_A; ++c0) CH_ISSUE(c0);
            for (int ch = 0; ch < 32; ++ch) {
                const int rem = 31 - ch;
                if (rem >= 3) asm volatile("s_waitcnt vmcnt(36)" ::: "memory"); else if (rem == 2) asm volatile("s_waitcnt vmcnt(24)" ::: "memory");
                else if (rem == 1) asm volatile("s_waitcnt vmcnt(12)" ::: "memory"); else asm volatile("s_waitcnt vmcnt(0)" ::: "memory");
                CH_BAR();
                if (ch + CH_A < 32) CH_ISSUE(ch + CH_A);
            }
#undef CH_ISSUE
            CH_BAR();
        } else {
            const int sw = wave - 6;
            for (int ch = 0; ch <= 32; ++ch) {
                CH_BAR();
                if (ch >= 1) {
#pragma unroll
                    for (int q = 0; q < 2; ++q) { const int vt = sw * 2 + q;
                        const LAS unsigned char* ob = lds + CH_OBUF + vt * (2 * 64 * ORS) + ((ch - 1) & 1) * (64 * ORS) + lane * ORS;
                        const u32x4 w0 = *(const LAS u32x4*)ob, w1 = *(const LAS u32x4*)(ob + 16);
                        bf16_t* dst = proj + (size_t)(b * TP + (ch - 1) * 64 + lane) * NPROJ + slot + vt * 16;
                        *(u32x4*)dst = w0; *(u32x4*)(dst + 8) = w1; } }
            }
        }
        asm volatile("s_waitcnt vmcnt(0)" ::: "memory");
        __syncthreads();
    }
#undef CH_BAR
}

__device__ __forceinline__ void phase_mix_post(const Params& p, const int tid, const int bid, const int G) {
    const int lane = tid & 63, wave = tid >> 6, c = lane;
    const bf16_t* proj = (const bf16_t*)(p.ws + WS_BIG);
    bf16_t* ycat = (bf16_t*)(p.ws + WS_ACT);
    for (int row0 = bid * 8 + wave; row0 < MP / 2; row0 += G * 8) {
        float ow[2][8], g[2][8], bv[2][8], orr[2][8], gt[2][8];
#pragma unroll
        for (int r = 0; r < 2; ++r) { const int row = row0 + r * (MP / 2);
            const int b = row >> 11, tt = row & 2047, ch = tt >> 6, t = tt & 63; const unsigned ro = (unsigned)row * (unsigned)NPROJ;
#pragma unroll
            for (int h = 0; h < 8; ++h) { const unsigned hcc = (unsigned)(h * 64 + c); const int item = (b * 8 + h) * 32 + ch;
                const unsigned char* r2 = (const unsigned char*)(p.out + O_Y) + (size_t)item * 24576;
                ow[r][h] = bf2f(*(const bf16_t*)(r2 + t * 128 + c * 2)) + bf2f(proj[ro + (unsigned)(APROJ + 1024) + hcc]);
                g[r][h] = bf2f(*(const bf16_t*)(r2 + 8192 + t * 128 + c * 2)); bv[r][h] = bf2f(*(const bf16_t*)(r2 + 16384 + t * 128 + c * 2));
                orr[r][h] = bf2f(proj[ro + (unsigned)(APROJ + 512) + hcc]) + bf2f(proj[ro + (unsigned)APROJ + hcc]);
                gt[r][h] = bf2f(proj[ro + (unsigned)(APROJ + 1536) + hcc]); } }
#pragma unroll
        for (int r = 0; r < 2; ++r) { const int row = row0 + r * (MP / 2);
            float sw[8], qw[8], sr[8], qr[8];
#pragma unroll
            for (int h = 0; h < 8; ++h) { sw[h] = ow[r][h]; qw[h] = ow[r][h] * ow[r][h]; sr[h] = orr[r][h]; qr[h] = orr[r][h] * orr[r][h]; }
#pragma unroll
            for (int h = 0; h < 8; ++h) { sw[h] = wave_sum(sw[h]); qw[h] = wave_sum(qw[h]); sr[h] = wave_sum(sr[h]); qr[h] = wave_sum(qr[h]); }
#pragma unroll
            for (int h = 0; h < 8; ++h) { const unsigned hcc = (unsigned)(h * 64 + c);
                const float mw = sw[h] * (1.f / 64.f), vw = fmaxf(qw[h] * (1.f / 64.f) - mw * mw, 0.f);
                const float ya = ((ow[r][h] - mw) * rsqrtf(vw + 64e-5f) * p.in[16][hcc] + p.in[17][hcc] + bv[r][h]) * g[r][h];
                const float mr_ = sr[h] * (1.f / 64.f), vr = fmaxf(qr[h] * (1.f / 64.f) - mr_ * mr_, 0.f);
                const float yb = gt[r][h] / (1.0f + __expf(-gt[r][h])) * ((orr[r][h] - mr_) * rsqrtf(vr + 1e-5f) * p.in[18][hcc] + p.in[19][hcc]);
                const float ya2 = dpp_mov<0xF5>(ya), yb2 = dpp_mov<0xF5>(yb);
                if (!(c & 1)) { *(unsigned*)(ycat + ((unsigned)row * (unsigned)DM + hcc)) = cvt_pk_bf16(ya, ya2); *(unsigned*)(ycat + ((unsigned)row * (unsigned)DM + 512u + hcc)) = cvt_pk_bf16(yb, yb2); } } }
    }
}

__device__ __forceinline__ void phase_ln(float* X, const float* g, const float* bta, bf16_t* xb, const int tid, const int bid, const int G) {
    const int lane = tid & 63, wave = tid >> 6;
    f32x4 gg[4], bb[4];
#pragma unroll
    for (int i = 0; i < 4; ++i) { gg[i] = *(const f32x4*)(g + i * 256 + lane * 4); bb[i] = *(const f32x4*)(bta + i * 256 + lane * 4); }
    for (int row = bid * 8 + wave; row < MT; row += G * 8) {
        float* xr = X + (size_t)row * DM; f32x4 v[4]; float s = 0.f;
#pragma unroll
        for (int i = 0; i < 4; ++i) { v[i] = *(const f32x4*)(xr + i * 256 + lane * 4); s += (v[i][0] + v[i][1]) + (v[i][2] + v[i][3]); }
        const float mean = wave_sum(s) * (1.f / 1024.f); float q = 0.f;
#pragma unroll
        for (int i = 0; i < 4; ++i) { v[i] -= mean; q += (v[i][0] * v[i][0] + v[i][1] * v[i][1]) + (v[i][2] * v[i][2] + v[i][3] * v[i][3]); }
        const float rstd = rsqrtf(wave_sum(q) * (1.f / 1024.f) + 1e-5f);
#pragma unroll
        for (int i = 0; i < 4; ++i) { const f32x4 y = v[i] * rstd * gg[i] + bb[i]; *(f32x4*)(xr + i * 256 + lane * 4) = y;
            u32x2 w; w.x = cvt_pk_bf16(y[0], y[1]); w.y = cvt_pk_bf16(y[2], y[3]); *(u32x2*)(xb + (size_t)row * DM + i * 256 + lane * 4) = w; }
    }
}

__device__ __forceinline__ void phase_conv(const Params& p, const int tid, const int bid, const int G) {
    const bf16_t* cp = (const bf16_t*)(p.ws + WS_BIG);
    bf16_t* vb = (bf16_t*)(p.ws + WS_ACT);
    const float* cw = p.in[22];
    const size_t total = (size_t)MT * 128;
    for (size_t idx0 = (size_t)bid * NTHREADS + tid; idx0 < total / 2; idx0 += (size_t)G * NTHREADS)
#pragma unroll
    for (int rr = 0; rr < 2; ++rr) { const size_t idx = idx0 + (size_t)rr * (total / 2);
        const int row = (int)(idx >> 7), c0 = (int)(idx & 127) * 8;
        const bool smp = row >= MP; const int T = smp ? TS : TP; const int b = smp ? (row - MP) / TS : row / TP; const int t = smp ? (row - MP) % TS : row % TP;
        float u[3][8];
#pragma unroll
        for (int d = 0; d < 3; ++d) { const int tt = t - 2 + d;
            if (tt >= 0) { const bf16_t* r = cp + (size_t)(row - 2 + d) * NCONV; const u32x4 cgv = *(const u32x4*)(r + 1024 + c0), hv = *(const u32x4*)(r + 2048 + c0);
#pragma unroll
                for (int q = 0; q < 4; ++q) { u[d][2 * q] = __uint_as_float(cgv[q] << 16) * __uint_as_float(hv[q] << 16); u[d][2 * q + 1] = __uint_as_float(cgv[q] & 0xffff0000u) * __uint_as_float(hv[q] & 0xffff0000u); } }
            else { if (smp) { const float* sr = p.in[5] + ((size_t)b * 2 + (tt + 2)) * DM + c0;
#pragma unroll
                    for (int q = 0; q < 8; ++q) u[d][q] = sr[q]; }
                else {
#pragma unroll
                    for (int q = 0; q < 8; ++q) u[d][q] = 0.f; } } }
        const u32x4 bgv = *(const u32x4*)(cp + (size_t)row * NCONV + c0); float o[8];
#pragma unroll
        for (int q = 0; q < 8; ++q) { const float bg = (q & 1) ? __uint_as_float(bgv[q >> 1] & 0xffff0000u) : __uint_as_float(bgv[q >> 1] << 16);
            o[q] = bg * (u[0][q] * cw[c0 + q] + u[1][q] * cw[DM + c0 + q] + u[2][q] * cw[2 * DM + c0 + q]); }
        u32x4 w; w.x = cvt_pk_bf16(o[0], o[1]); w.y = cvt_pk_bf16(o[2], o[3]); w.z = cvt_pk_bf16(o[4], o[5]); w.w = cvt_pk_bf16(o[6], o[7]);
        *(u32x4*)(vb + (size_t)row * DM + c0) = w;
        if (t >= T - 2) { float* dst = p.out + (smp ? O_SCONV : O_PCONV) + ((size_t)b * 2 + (t - (T - 2))) * DM + c0;
#pragma unroll
            for (int q = 0; q < 8; ++q) dst[q] = u[2][q]; }
    }
}


#define XB_TMO      128
#define XB_XCNT(j)  (256  + 64 * (j))
#define XB_XSUB(j)  (1280 + 64 * (j))
#define XB_XGEN(j)  (2304 + 64 * (j))
#define XB_TOP      3328
#define XB_TOPGEN   3392
#define XCD_BAR_WORDS 3456
#define XB_SPIN_CAP (1u << 18)
__device__ __forceinline__ unsigned xb_ld(unsigned* p)              { return __hip_atomic_load(p, __ATOMIC_RELAXED, __HIP_MEMORY_SCOPE_AGENT); }
__device__ __forceinline__ unsigned xb_add(unsigned* p, unsigned v) { return __hip_atomic_fetch_add(p, v, __ATOMIC_RELAXED, __HIP_MEMORY_SCOPE_AGENT); }
__device__ __forceinline__ unsigned xb_xcc_id() { return (unsigned)__builtin_amdgcn_s_getreg((3 << 11) | 20) & 0xFu; }
#define XB_SPIN(cond, bar) do { unsigned _sp = 0; while (cond) { __builtin_amdgcn_s_sleep(1); \
    if ((++_sp & 255u) == 0u) { if (xb_ld(&(bar)[XB_TMO])) break; if (_sp > XB_SPIN_CAP) { atomicAdd(&(bar)[XB_TMO], 1u); break; } } } } while (0)
struct XcdBarrier { unsigned* bar; unsigned x; volatile LAS unsigned* st; };
__device__ __forceinline__ XcdBarrier xcd_barrier_post(unsigned* bar, volatile LAS unsigned* st) {
    XcdBarrier b; b.bar = bar; b.x = xb_xcc_id(); b.st = st;
    if (threadIdx.x == 0) (void)xb_add(&bar[XB_XCNT(b.x)], 1u);
    return b;
}
__device__ __forceinline__ void xcd_barrier_complete(unsigned* bar, unsigned x, unsigned& nloc, unsigned& nx) {
    const unsigned G = gridDim.x * gridDim.y * gridDim.z;
    unsigned sum, cnt, mine, sp = 0u;
    for (;;) {
        sum = 0u; cnt = 0u; mine = 0u;
#pragma unroll
        for (unsigned j = 0; j < 16; ++j) { const unsigned c = xb_ld(&bar[XB_XCNT(j)]); sum += c; cnt += (c > 0u) ? 1u : 0u; mine = (j == x) ? c : mine; }
        if (sum == G) break;
        __builtin_amdgcn_s_sleep(1);
        if ((++sp & 255u) == 0u) { if (xb_ld(&bar[XB_TMO])) break; if (sp > XB_SPIN_CAP) { atomicAdd(&bar[XB_TMO], 1u); break; } }
    }
    nloc = mine > 0u ? mine : 1u; nx = cnt > 0u ? cnt : 1u;
}
__device__ __forceinline__ void xcd_barrier(const XcdBarrier& b) {
    asm volatile("s_waitcnt vmcnt(0)" ::: "memory");
    __syncthreads();
    if (threadIdx.x == 0) {
        unsigned* bar = b.bar;
        __builtin_amdgcn_s_waitcnt(0);
        unsigned nloc = b.st[0], nx = b.st[1];
        if (nloc == 0u) { xcd_barrier_complete(bar, b.x, nloc, nx); b.st[0] = nloc; b.st[1] = nx; }
        const unsigned old = xb_add(&bar[XB_XSUB(b.x)], 1u);
        const unsigned gen = old / nloc;
        if (old + 1u == (gen + 1u) * nloc) {
            __builtin_amdgcn_fence(__ATOMIC_RELEASE, "agent");
            asm volatile("s_waitcnt vmcnt(0)" ::: "memory");
            const unsigned og = xb_add(&bar[XB_TOP], 1u);
            const unsigned tg = og / nx;
            if (og + 1u == (tg + 1u) * nx) xb_add(&bar[XB_TOPGEN], 1u);
            else XB_SPIN(xb_ld(&bar[XB_TOPGEN]) == tg, bar);
            __builtin_amdgcn_fence(__ATOMIC_ACQUIRE, "agent");
            xb_add(&bar[XB_XGEN(b.x)], 1u);
            asm volatile("s_waitcnt vmcnt(0)" ::: "memory");
        } else {
            XB_SPIN(xb_ld(&bar[XB_XGEN(b.x)]) == gen, bar);
            __builtin_amdgcn_fence(__ATOMIC_ACQUIRE, "agent");
            asm volatile("s_waitcnt vmcnt(0)" ::: "memory");
        }
    }
    __syncthreads();
}

__global__ void __launch_bounds__(NTHREADS, 2) mega(Params p_arg) {
    extern __shared__ __attribute__((aligned(16))) unsigned char lds[];
    cg::grid_group grid = cg::this_grid();
    LAS unsigned char* ldsl = (LAS unsigned char*)lds;
    float* L = (float*)lds;
    const int lo = p_arg.ph_lo, hi = p_arg.ph_hi & 0xff; const int dbg = p_arg.ph_hi >> 8;
    volatile LAS unsigned* xb_st = (volatile LAS unsigned*)(ldsl + 155648);
    if (threadIdx.x == 0) { xb_st[0] = 0u; xb_st[1] = 0u; }
    __syncthreads();
    const XcdBarrier xbar = xcd_barrier_post((unsigned*)(p_arg.ws + WS_BAR), xb_st);
    const int wid_s = __builtin_amdgcn_readfirstlane((int)threadIdx.x >> 6);
    for (int ph = lo; ph < hi; ++ph) {
        unsigned zero_v = 0u; asm volatile("" : "+v"(zero_v));
        int tid = wid_s * 64 + (int)__builtin_amdgcn_mbcnt_hi(~0u, __builtin_amdgcn_mbcnt_lo(~0u, zero_v)), bid = blockIdx.x, G = gridDim.x;
        asm volatile("" : "+v"(tid), "+s"(bid), "+s"(G));
        const __attribute__((address_space(4))) Params* pk = (const __attribute__((address_space(4))) Params*)__builtin_amdgcn_kernarg_segment_ptr();
        asm volatile("" : "+s"(pk));
        const Params& p = *(const Params*)pk;
        bf16_t* act = (bf16_t*)(p.ws + WS_ACT); bf16_t* big = (bf16_t*)(p.ws + WS_BIG);
        float* Y = p.out + O_Y;
#if PROBE_MASK
        if (bid == 0 && tid == 0) ((unsigned long long*)(p.ws + WS_STAMP))[ph] = __builtin_amdgcn_s_memrealtime();
#endif
        if (ph == 0) phase_convert(p, L, tid, bid, G, 0, 960, true);
        else if (ph == 2) { phase_mix_local(p, ldsl, tid, (dbg & 1) ? 4096 : bid, G); __syncthreads(); phase_sample(p, ldsl, tid, bid, G); }
        else if (ph == 3) { phase_chain(p, ldsl, tid, (dbg & 2) ? 4096 : bid, G);
            if (G > 128) { if (bid >= 128) phase_convert(p, L, tid, bid - 128, G - 128, 960, 6336, false); } else { __syncthreads(); phase_convert(p, L, tid, bid, G, 960, 6336, false); } }
        else if (ph == 4) phase_mix_post(p, tid, (dbg & 4) ? (1 << 20) : bid, G);
        else if (ph == 11) phase_conv(p, tid, bid, G);
        else if (ph == 6 || ph == 9 || ph == 13 || ph == 16) {
            const int l = ph >= 13 ? 1 : 0; const bool second = (ph == 9 || ph == 16);
            phase_ln(Y, (second ? p.in[26] : p.in[24]) + l * DM, (second ? p.in[27] : p.in[25]) + l * DM, act, tid, bid, G);
        } else {
            pg8::Gemm g; pg8::Epi E; E.O = big; E.xlo = Y; E.xhi = Y; E.Z = Y; g.M = MT; g.A = act; g.K = DM;
            size_t wo;
            switch (ph) {
                case 1: wo = WS_WIN; g.N = NPROJ; E.mode = 0; break;
                case 5: wo = WS_WOUT; g.N = DM; E.mode = 2; E.xlo = p.in[0]; E.xhi = p.in[1] - (size_t)MP * DM; break;
                case 7: wo = WS_WUP0; g.N = DFF; E.mode = 1; break;
                case 8: wo = WS_WDN0; g.N = DM; g.K = DFF; g.A = big; E.mode = 2; break;
                case 10: wo = WS_WCIN; g.N = NCONV; E.mode = 0; break;
                case 12: wo = WS_WCOUT; g.N = DM; E.mode = 2; break;
                case 14: wo = WS_WUP1; g.N = DFF; E.mode = 1; break;
                default: wo = WS_WDN1; g.N = DM; g.K = DFF; g.A = big; E.mode = 2; break;
            }
            g.Bt = (const bf16_t*)(p.ws + wo); E.ldc = g.N;
            pg8::StaticOrder S; S.init(MT, g.N, G, bid);
            const bool split_tail = (E.mode == 2 && G == 256 && S.nwg == 272);
            if (split_tail) S.lim = 256;
            pg8::gemm_phase(ldsl, g, S, E, tid);
            if (split_tail) { pg8::Unit u; S.map(256 + (bid >> 4), u); const int s = bid & 15; const int row0 = u.pm * 256 + (s >> 2) * 64, col0 = u.pn * 256 + (s & 3) * 64;
                gemm64_resid(ldsl, g.A, g.Bt, g.K, row0, col0, (row0 < MP) ? E.xlo : E.xhi, E.Z, tid); }
        }
        if (ph + 1 < hi) { if (dbg & 64) grid.sync(); else xcd_barrier(xbar); }
#if PROBE_MASK
        if (ph + 1 == hi && bid == 0 && tid == 0) { unsigned long long* st = (unsigned long long*)(p.ws + WS_STAMP); st[hi] = __builtin_amdgcn_s_memrealtime();
            unsigned long long tot = 0; for (int k = lo; k < hi; ++k) if ((PROBE_MASK >> k) & 1) tot += st[k + 1] - st[k];
            asm volatile("s_waitcnt vmcnt(0)" ::: "memory"); p.out[0] = (float)tot * 0.01f; }
#endif
    }
}
#ifndef PROBE_MASK
#define PROBE_MASK 0
#endif
constexpr int NPHASES = 17;
#ifndef DBG
#define DBG 0
#endif

#ifndef PER_PHASE_LAUNCH
#define PER_PHASE_LAUNCH 0
#endif

extern "C" void kernel_launch(void* const* d_in, const int* in_sizes, int n_in, void* d_out, int out_size, void* d_ws, size_t ws_size, hipStream_t stream) {
    static int grid = 0;
    if (grid == 0) {
        if (n_in != 30 || ws_size < WS_END2) { fprintf(stderr, "kernel_launch: unexpected n_in %d or ws_size %zu (need %zu)\n", n_in, ws_size, (size_t)WS_END2); grid = -1; return; }
        int dev = 0, cus = 0, per_cu = 0;
        hipGetDevice(&dev);
        hipDeviceGetAttribute(&cus, hipDeviceAttributeMultiprocessorCount, dev);
        if (hipFuncSetAttribute((const void*)mega, hipFuncAttributeMaxDynamicSharedMemorySize, LDS_BYTES) != hipSuccess) { fprintf(stderr, "kernel_launch: hipFuncSetAttribute failed\n"); grid = -1; return; }
        if (hipOccupancyMaxActiveBlocksPerMultiprocessor(&per_cu, (const void*)mega, NTHREADS, LDS_BYTES) != hipSuccess || per_cu < 1) { fprintf(stderr, "kernel_launch: occupancy query failed (%d)\n", per_cu); (void)hipGetLastError(); per_cu = 1; }
        if (per_cu > 1) per_cu = 1;
        grid = cus * per_cu;
    }
    if (grid < 0) return;
    if (hipMemsetAsync((char*)d_ws + WS_BAR, 0, 3456 * 4, stream) != hipSuccess) { fprintf(stderr, "kernel_launch: hipMemsetAsync failed\n"); return; }
    Params p{};
    for (int i = 0; i < 30; ++i) p.in[i] = (const float*)d_in[i];
    p.out = (float*)d_out; p.ws = (unsigned char*)d_ws;
    for (int f = 0; f < 32; ++f) p.inv_freq[f] = pow(10000.0, -(double)f / 32.0);
#if PER_PHASE_LAUNCH
    for (int ph = 0; ph < NPHASES; ++ph) { p.ph_lo = ph; p.ph_hi = ph + 1; hipLaunchKernelGGL(mega, dim3(grid), dim3(NTHREADS), LDS_BYTES, stream, p); }
#else
    p.ph_lo = 0; p.ph_hi = NPHASES | (DBG << 8);
    void* args[] = {&p};
    hipError_t e = hipLaunchCooperativeKernel((const void*)mega, dim3(grid), dim3(NTHREADS), args, LDS_BYTES, stream);
    if (e != hipSuccess) fprintf(stderr, "cooperative launch failed: %s (grid %d)\n", hipGetErrorString(e), grid);
#endif
}
```

```cpp
#include <hip/hip_runtime.h>
#include <hip/hip_cooperative_groups.h>
#include <cstdio>
#include <cmath>
namespace cg = cooperative_groups;

#ifndef PROBE_MASK
#define PROBE_MASK 0
#endif
#define LAS __attribute__((address_space(3)))
typedef unsigned short bf16_t;
typedef short bf16x8 __attribute__((ext_vector_type(8)));
typedef float f32x4 __attribute__((ext_vector_type(4)));
typedef unsigned u32x4 __attribute__((ext_vector_type(4)));
typedef unsigned u32x2 __attribute__((ext_vector_type(2)));

constexpr int DM = 1024, MP = 16384, MS = 1024, MT = MP + MS;
constexpr int TP = 2048, TS = 8, NBP = 8, NBS = 128;
constexpr int APROJ = 1792, NPROJ = 3840, DFF = 4096, NCONV = 3072;
constexpr float ALPHA = 1.4142135623730951f;
constexpr int LDS_BYTES = 155648 + 256;
constexpr int NTHREADS = 512;

constexpr size_t WS_WIN = 0;
constexpr size_t WS_WOUT = WS_WIN + (size_t)NPROJ * DM * 2;
constexpr size_t WS_WCIN = WS_WOUT + (size_t)DM * DM * 2;
constexpr size_t WS_WCOUT = WS_WCIN + (size_t)NCONV * DM * 2;
constexpr size_t WS_WUP0 = WS_WCOUT + (size_t)DM * DM * 2;
constexpr size_t WS_WUP1 = WS_WUP0 + (size_t)DFF * DM * 2;
constexpr size_t WS_WDN0 = WS_WUP1 + (size_t)DFF * DM * 2;
constexpr size_t WS_WDN1 = WS_WDN0 + (size_t)DFF * DM * 2;
constexpr size_t WS_ACT = WS_WDN1 + (size_t)DFF * DM * 2;
constexpr size_t WS_BIG = WS_ACT + (size_t)MT * DM * 2;
constexpr size_t WS_ROPE = WS_BIG + (size_t)MT * DFF * 2;
constexpr size_t WS_END = WS_ROPE + (size_t)2056 * 32 * 8;

constexpr size_t WS_R3 = (WS_END + 255) & ~(size_t)255;
constexpr size_t WS_STAMP = WS_R3 + (size_t)2048 * 8192;
constexpr size_t WS_W2T = WS_STAMP + 256;
constexpr size_t WS_A2T = WS_W2T + 512 * 64 * 2;
constexpr size_t WS_G2T = WS_A2T + 512 * 64 * 2;
constexpr size_t WS_BAR = WS_G2T + 512 * 128 * 2;
constexpr size_t WS_END2 = WS_BAR + 3456 * 4;

constexpr size_t O_Y = 0;
constexpr size_t O_PSHIFT = (size_t)MT * DM;
constexpr size_t O_PWKV = O_PSHIFT + (size_t)NBP * APROJ;
constexpr size_t O_PRET = O_PWKV + (size_t)NBP * 8 * 4096;
constexpr size_t O_PCONV = O_PRET + (size_t)NBP * 8 * 4096;
constexpr size_t O_SSHIFT = O_PCONV + (size_t)NBP * 2 * DM;
constexpr size_t O_SWKV = O_SSHIFT + (size_t)NBS * APROJ;
constexpr size_t O_SRET = O_SWKV + (size_t)NBS * 8 * 4096;
constexpr size_t O_SCONV = O_SRET + (size_t)NBS * 8 * 4096;

struct Params { const float* in[30]; float* out; unsigned char* ws; int ph_lo, ph_hi; double inv_freq[32]; };

__device__ __forceinline__ float bf2f(bf16_t b) { return __uint_as_float(((unsigned)b) << 16); }
typedef __bf16 bf16x2_t __attribute__((ext_vector_type(2)));
typedef float f32x2_t __attribute__((ext_vector_type(2)));
__device__ __forceinline__ unsigned cvt_pk_bf16(float lo, float hi) { const f32x2_t v = {lo, hi}; const bf16x2_t b = __builtin_convertvector(v, bf16x2_t); return __builtin_bit_cast(unsigned, b); }
template <int CTRL> __device__ __forceinline__ float dpp_mov(float v) { return __int_as_float(__builtin_amdgcn_update_dpp(0, __float_as_int(v), CTRL, 0xF, 0xF, false)); }
__device__ __forceinline__ float row16_sum(float v) {
    v += dpp_mov<0xB1>(v); v += dpp_mov<0x4E>(v); v += dpp_mov<0x124>(v); v += dpp_mov<0x128>(v); return v;
}
__device__ __forceinline__ float rows_sum(float v) {
    { const auto r = __builtin_amdgcn_permlane16_swap(__float_as_uint(v), __float_as_uint(v), false, false); v = __uint_as_float(r[0]) + __uint_as_float(r[1]); }
    { const auto r = __builtin_amdgcn_permlane32_swap(__float_as_uint(v), __float_as_uint(v), false, false); v = __uint_as_float(r[0]) + __uint_as_float(r[1]); }
    return v;
}
__device__ __forceinline__ float wave_sum(float v) { return rows_sum(row16_sum(v)); }

namespace pg8 {
constexpr int BM = 256, BK = 64, HALF = 128, HTB = HALF * BK * 2, STAGE_BYTES = 8 * HTB, NXCD = 8, WGM = 8;
__device__ __forceinline__ int lds_byte(int r, int c) { const int st = (r >> 4) * 2 + (c >> 5), rr = r & 15, cc = c & 31, ob = rr * 64 + cc * 2; return st * 1024 + (ob ^ (((ob >> 9) & 1) << 5)); }
__device__ __forceinline__ void stage_rc(int b, int& R, int& C) { const int st = b / 1024, sb = b % 1024, swz = sb ^ (((sb >> 9) & 1) << 5); R = (st >> 1) * 16 + swz / 64; C = (st & 1) * 32 + (swz % 64) / 2; }
__device__ __forceinline__ int perm32(int rho) { const int n = rho >> 4, i = rho & 15; return 8 * (i >> 2) + 4 * n + (i & 3); }
struct Unit { int pm, pn; };
struct Gemm { const bf16_t* A; const bf16_t* Bt; int M, N, K; };
struct StaticOrder {
    int nM, nN, nwg, G, c, lim;
    __device__ void init(int M, int N, int G_, int c_) { nM = M / BM; nN = N / BM; nwg = nM * nN; G = G_; c = c_; lim = nwg; }
    __device__ void map(int L, Unit& u) const {
        int wgid = L; { const int q = nwg / NXCD, r = nwg % NXCD, xcd = wgid % NXCD, off = wgid / NXCD; wgid = (xcd < r ? xcd * (q + 1) : r * (q + 1) + (xcd - r) * q) + off; }
        const int nig = WGM * nN, gid = wgid / nig, fm = gid * WGM, gsz = (nM - fm) < WGM ? (nM - fm) : WGM;
        u.pm = fm + ((wgid % nig) % gsz); u.pn = (wgid % nig) / gsz;
    }
    __device__ bool next(int i, Unit& u) const { const long L = (long)i * G + c; if (L >= lim) return false; map((int)L, u); return true; }
};

struct Epi {
    int mode; bf16_t* O; int ldc; const float* xlo; const float* xhi; float* Z;
    __device__ __forceinline__ void operator()(const f32x4 (&acc)[2][2][4][2], const Unit& u, int wr, int wc, int fr, int fq) const {
        if (mode < 2) {
            const int row0 = u.pm * BM + wr * 64 + fr; const int col0 = u.pn * BM + wc * 32 + 8 * fq;
            const float lowclamp = mode == 1 ? 0.f : -3.0e38f;
#pragma unroll
            for (int ai = 0; ai < 2; ++ai)
#pragma unroll
                for (int m = 0; m < 4; ++m) { bf16_t* rowp = O + (size_t)(row0 + ai * HALF + m * 16) * ldc + col0;
#pragma unroll
                    for (int bj = 0; bj < 2; ++bj) { f32x4 v0 = acc[ai][bj][m][0], v1 = acc[ai][bj][m][1];
                        if (mode == 1) {
#pragma unroll
                            for (int j = 0; j < 4; ++j) { const float a = fmaxf(v0[j], lowclamp), b = fmaxf(v1[j], lowclamp); v0[j] = a * a; v1[j] = b * b; } }
                        u32x4 w; w.x = cvt_pk_bf16(v0[0], v0[1]); w.y = cvt_pk_bf16(v0[2], v0[3]); w.z = cvt_pk_bf16(v1[0], v1[1]); w.w = cvt_pk_bf16(v1[2], v1[3]);
                        *(u32x4*)(rowp + bj * HALF) = w; } }
        } else {
            const int row0 = u.pm * BM + wr * 64 + fr, col0 = u.pn * BM + wc * 32 + 4 * fq;
            const float* X = (u.pm * BM < MP) ? xlo : xhi;
#pragma unroll
            for (int ai = 0; ai < 2; ++ai)
#pragma unroll
                for (int mp = 0; mp < 2; ++mp) {
                    f32x4 x[2][2][2];
#pragma unroll
                    for (int mm = 0; mm < 2; ++mm) { const size_t off = (size_t)(row0 + ai * HALF + (mp * 2 + mm) * 16) * DM + col0;
#pragma unroll
                        for (int bj = 0; bj < 2; ++bj)
#pragma unroll
                            for (int n = 0; n < 2; ++n) x[mm][bj][n] = *(const f32x4*)(X + off + bj * HALF + n * 16); }
#pragma unroll
                    for (int mm = 0; mm < 2; ++mm) { const int m = mp * 2 + mm; const size_t off = (size_t)(row0 + ai * HALF + m * 16) * DM + col0;
#pragma unroll
                        for (int bj = 0; bj < 2; ++bj)
#pragma unroll
                            for (int n = 0; n < 2; ++n) *(f32x4*)(Z + off + bj * HALF + n * 16) = x[mm][bj][n] * ALPHA + acc[ai][bj][m][n]; }
                    asm volatile("" ::: "memory"); }
        }
    }
};

template <class Sched>
__device__ __forceinline__ void gemm_phase(LAS unsigned char* lds, const Gemm g, const Sched& S, const Epi& E, const int tid) {
    const bool PERM = E.mode < 2;
    const int wid = __builtin_amdgcn_readfirstlane(tid >> 6), lane = tid & 63, wr = wid >> 2, wc = wid & 3, fr = lane & 15, fq = lane >> 4;
    const int K = g.K, nt = K / BK;
    unsigned voffA[2], voffB[2];
#pragma unroll
    for (int i = 0; i < 2; ++i) { int R, C; stage_rc(tid * 16 + i * 8192, R, C); const int Rb = PERM ? ((R & ~31) + perm32(R & 31)) : R;
        voffA[i] = (unsigned)(R * K + C) * 2u; voffB[i] = (unsigned)(Rb * K + C) * 2u; }
    const size_t kstep = (size_t)(BK * 2);
    const size_t hstep = (size_t)HALF * K * 2;
    const size_t tstep = 2 * hstep;
    const unsigned ldsw = (unsigned)wid * 1024u;
    const int aoff = lds_byte(wr * 64 + fr, fq * 8), boff = lds_byte(wc * 32 + fr, fq * 8);
#define PG8_SA(b, h) (((b) * 2 + (h)) * HTB)
#define PG8_SB(b, h) ((4 + (b) * 2 + (h)) * HTB)
#define PG8_STAGE(bufoff, gbase, voff) do { _Pragma("unroll") for (int _i = 0; _i < 2; ++_i) \
        __builtin_amdgcn_global_load_lds((const unsigned*)((const char*)(gbase) + (voff)[_i]), (LAS unsigned*)(lds + (bufoff) + ldsw + _i * 8192), 16, 0, 0); } while (0)
#define PG8_LDA(dst, b, h) do { _Pragma("unroll") for (int m = 0; m < 4; ++m) _Pragma("unroll") for (int k = 0; k < 2; ++k) dst[m][k] = *(const LAS bf16x8*)(lds + PG8_SA(b, h) + aoff + m * 2048 + k * 1024); } while (0)
#define PG8_LDB(dst, b, h) do { _Pragma("unroll") for (int n = 0; n < 2; ++n) _Pragma("unroll") for (int k = 0; k < 2; ++k) dst[n][k] = *(const LAS bf16x8*)(lds + PG8_SB(b, h) + boff + n * 2048 + k * 1024); } while (0)
#define PG8_MMA(ai, bj, At, Bt) do { __builtin_amdgcn_s_setprio(1); _Pragma("unroll") for (int m = 0; m < 4; ++m) _Pragma("unroll") for (int n = 0; n < 2; ++n) _Pragma("unroll") for (int k = 0; k < 2; ++k) \
        acc[ai][bj][m][n] = __builtin_amdgcn_mfma_f32_16x16x32_bf16(Bt[n][k], At[m][k], acc[ai][bj][m][n], 0, 0, 0); __builtin_amdgcn_s_setprio(0); } while (0)
#define PG8_WAIT_V(n) asm volatile("s_waitcnt vmcnt(" #n ")" ::: "memory")
#define PG8_WAIT_L(n) asm volatile("s_waitcnt lgkmcnt(" #n ")" ::: "memory")
#define PG8_BAR __builtin_amdgcn_s_barrier()
#define PG8_SCHED __builtin_amdgcn_sched_barrier(0)
    Unit cur, nxt; int ui = 0;
    if (!S.next(0, cur)) return;
    f32x4 acc[2][2][4][2];
#pragma unroll
    for (int a = 0; a < 2; ++a)
#pragma unroll
        for (int b = 0; b < 2; ++b)
#pragma unroll
            for (int m = 0; m < 4; ++m)
#pragma unroll
                for (int n = 0; n < 2; ++n) acc[a][b][m][n] = (f32x4){0.f, 0.f, 0.f, 0.f};
    bf16x8 At[4][2], B0[2][2], B1[2][2];
    const char* cA = (const char*)g.A + (size_t)cur.pm * tstep; const char* cB = (const char*)g.Bt + (size_t)cur.pn * tstep;
    PG8_STAGE(PG8_SB(0, 0), cB, voffB); PG8_STAGE(PG8_SA(0, 0), cA, voffA); PG8_STAGE(PG8_SB(0, 1), cB + hstep, voffB); PG8_STAGE(PG8_SA(0, 1), cA + hstep, voffA);
    if (wr == 1) PG8_BAR;
    PG8_WAIT_V(4); PG8_BAR;
    PG8_STAGE(PG8_SB(1, 0), cB + kstep, voffB); PG8_STAGE(PG8_SA(1, 0), cA + kstep, voffA); PG8_STAGE(PG8_SB(1, 1), cB + hstep + kstep, voffB);
    PG8_WAIT_V(6); PG8_BAR;
    for (;;) {
        const bool has_next = S.next(ui + 1, nxt);
        const char* nA = has_next ? (const char*)g.A + (size_t)nxt.pm * tstep : cA; const char* nB = has_next ? (const char*)g.Bt + (size_t)nxt.pn * tstep : cB;
        for (int t = 0; t < nt; t += 2) {
            const bool last = (t == nt - 2);
            const char* a1 = cA + (size_t)(t + 1) * kstep;
            const char* a2 = last ? nA : cA + (size_t)(t + 2) * kstep; const char* b2 = last ? nB : cB + (size_t)(t + 2) * kstep;
            const char* a3 = a2 + kstep; const char* b3 = b2 + kstep;
            PG8_LDB(B0, 0, 0); PG8_SCHED; PG8_LDA(At, 0, 0); PG8_STAGE(PG8_SA(1, 1), a1 + hstep, voffA);
            PG8_WAIT_L(8); PG8_BAR; PG8_WAIT_L(0); PG8_MMA(0, 0, At, B0); PG8_BAR; PG8_SCHED;
            PG8_LDB(B1, 0, 1); PG8_STAGE(PG8_SB(0, 0), b2, voffB);
            PG8_BAR; PG8_WAIT_L(0); PG8_MMA(0, 1, At, B1); PG8_BAR;
            PG8_LDA(At, 0, 1); PG8_STAGE(PG8_SA(0, 0), a2, voffA);
            PG8_BAR; PG8_WAIT_L(0); PG8_MMA(1, 0, At, B0); PG8_BAR; PG8_SCHED;
            PG8_STAGE(PG8_SB(0, 1), b2 + hstep, voffB);
            PG8_WAIT_V(6); PG8_BAR; PG8_MMA(1, 1, At, B1); PG8_BAR;
            PG8_LDB(B0, 1, 0); PG8_SCHED; PG8_LDA(At, 1, 0); PG8_STAGE(PG8_SA(0, 1), a2 + hstep, voffA);
            PG8_WAIT_L(8); PG8_BAR; PG8_WAIT_L(0); PG8_MMA(0, 0, At, B0); PG8_BAR; PG8_SCHED;
            PG8_LDB(B1, 1, 1); PG8_STAGE(PG8_SB(1, 0), b3, voffB);
            PG8_BAR; PG8_WAIT_L(0); PG8_MMA(0, 1, At, B1); PG8_BAR;
            PG8_LDA(At, 1, 1); PG8_STAGE(PG8_SA(1, 0), a3, voffA);
            PG8_BAR; PG8_WAIT_L(0); PG8_MMA(1, 0, At, B0); PG8_BAR; PG8_SCHED;
            PG8_STAGE(PG8_SB(1, 1), b3 + hstep, voffB);
            PG8_WAIT_V(6); PG8_BAR; PG8_MMA(1, 1, At, B1); PG8_BAR;
        }
        E(acc, cur, wr, wc, fr, fq);
        if (!has_next) break;
#pragma unroll
        for (int a = 0; a < 2; ++a)
#pragma unroll
            for (int b = 0; b < 2; ++b)
#pragma unroll
                for (int m = 0; m < 4; ++m)
#pragma unroll
                    for (int n = 0; n < 2; ++n) acc[a][b][m][n] = (f32x4){0.f, 0.f, 0.f, 0.f};
        cur = nxt; cA = nA; cB = nB; ++ui;
    }
    PG8_WAIT_V(0);
    if (wr == 0) PG8_BAR;
    PG8_BAR;
#undef PG8_SA
#undef PG8_SB
#undef PG8_STAGE
#undef PG8_LDA
#undef PG8_LDB
#undef PG8_MMA
#undef PG8_WAIT_V
#undef PG8_WAIT_L
#undef PG8_BAR
#undef PG8_SCHED
}
}

__device__ __forceinline__ void gemm64_resid(LAS unsigned char* lds, const bf16_t* A, const bf16_t* Bt, const int K, const int row0, const int col0, const float* X, float* Z, const int tid) {
    const int wave = tid >> 6, lane = tid & 63, fr = lane & 15, fq = lane >> 4;
    const int kper = K >> 3;
    f32x4 acc[4][4];
#pragma unroll
    for (int m = 0; m < 4; ++m)
#pragma unroll
        for (int n = 0; n < 4; ++n) acc[m][n] = (f32x4){0.f, 0.f, 0.f, 0.f};
    const bf16_t* Ap = A + (size_t)(row0 + fr) * K + wave * kper + fq * 8;
    const bf16_t* Bp = Bt + (size_t)(col0 + fr) * K + wave * kper + fq * 8;
    const size_t rs16 = (size_t)16 * K;
#pragma unroll 2
    for (int ks = 0; ks < (kper >> 5); ++ks) {
        bf16x8 a[4], b[4];
#pragma unroll
        for (int m = 0; m < 4; ++m) { a[m] = *(const bf16x8*)(Ap + m * rs16 + ks * 32); b[m] = *(const bf16x8*)(Bp + m * rs16 + ks * 32); }
#pragma unroll
        for (int m = 0; m < 4; ++m)
#pragma unroll
            for (int n = 0; n < 4; ++n) acc[m][n] = __builtin_amdgcn_mfma_f32_16x16x32_bf16(a[m], b[n], acc[m][n], 0, 0, 0);
    }
    LAS unsigned char* part = lds + wave * (64 * 272);
#pragma unroll
    for (int m = 0; m < 4; ++m)
#pragma unroll
        for (int n = 0; n < 4; ++n)
#pragma unroll
            for (int jj = 0; jj < 4; ++jj) *(LAS float*)(part + (m * 16 + fq * 4 + jj) * 272 + (n * 16 + fr) * 4) = acc[m][n][jj];
    __syncthreads();
    { const int r = tid >> 3, c8 = (tid & 7) * 8; f32x4 s0 = (f32x4){0.f, 0.f, 0.f, 0.f}, s1 = s0;
#pragma unroll
      for (int w = 0; w < 8; ++w) { s0 += *(const LAS f32x4*)(lds + w * (64 * 272) + r * 272 + c8 * 4); s1 += *(const LAS f32x4*)(lds + w * (64 * 272) + r * 272 + c8 * 4 + 16); }
      const size_t off = (size_t)(row0 + r) * DM + col0 + c8;
      const f32x4 x0 = *(const f32x4*)(X + off), x1 = *(const f32x4*)(X + off + 4);
      *(f32x4*)(Z + off) = x0 * ALPHA + s0; *(f32x4*)(Z + off + 4) = x1 * ALPHA + s1; }
    __syncthreads();
}

__device__ __forceinline__ void phase_convert(const Params& p, float* L, const int tid, const int bid, const int G, const int tile_lo, const int tile_hi, const bool misc) {
    for (int tB = tile_lo + bid * 4; tB < tile_hi; tB += G * 4) {
        float4 v[4][2]; bf16_t* wt[4]; int kk[4], kb[4], nb[4];
#pragma unroll
        for (int q = 0; q < 4; ++q) { const int tI = tB + q; wt[q] = nullptr; kk[q] = 0; kb[q] = 0; nb[q] = 0;
            if (tI < tile_hi) {
                int j = tI; const float* W; bf16_t* Wt; int K, N;
                if (j < 960) { W = p.in[6]; Wt = (bf16_t*)(p.ws + WS_WIN); K = DM; N = NPROJ; }
                else if ((j -= 960) < 256) { W = p.in[20]; Wt = (bf16_t*)(p.ws + WS_WOUT); K = DM; N = DM; }
                else if ((j -= 256) < 768) { W = p.in[21]; Wt = (bf16_t*)(p.ws + WS_WCIN); K = DM; N = NCONV; }
                else if ((j -= 768) < 256) { W = p.in[23]; Wt = (bf16_t*)(p.ws + WS_WCOUT); K = DM; N = DM; }
                else if ((j -= 256) < 1024) { W = p.in[28]; Wt = (bf16_t*)(p.ws + WS_WUP0); K = DM; N = DFF; }
                else if ((j -= 1024) < 1024) { W = p.in[28] + (size_t)DM * DFF; Wt = (bf16_t*)(p.ws + WS_WUP1); K = DM; N = DFF; }
                else if ((j -= 1024) < 1024) { W = p.in[29]; Wt = (bf16_t*)(p.ws + WS_WDN0); K = DFF; N = DM; }
                else { j -= 1024; W = p.in[29] + (size_t)DM * DFF; Wt = (bf16_t*)(p.ws + WS_WDN1); K = DFF; N = DM; }
                const int tn = N / 64, k0 = (j / tn) * 64, n0 = (j % tn) * 64;
                wt[q] = Wt; kk[q] = K; kb[q] = k0; nb[q] = n0;
#pragma unroll
                for (int i = 0; i < 2; ++i) { const int e = tid + i * 512, r = e >> 4, c4 = e & 15; v[q][i] = *(const float4*)(W + (size_t)(k0 + r) * N + n0 + c4 * 4); } } }
#pragma unroll
        for (int q = 0; q < 4; ++q) if (wt[q]) {
#pragma unroll
            for (int i = 0; i < 2; ++i) { const int e = tid + i * 512, r = e >> 4, c4 = e & 15; float* d = L + q * 4160 + r * 65 + c4 * 4; d[0] = v[q][i].x; d[1] = v[q][i].y; d[2] = v[q][i].z; d[3] = v[q][i].w; } }
        __syncthreads();
#pragma unroll
        for (int q = 0; q < 4; ++q) if (wt[q]) { const int n = tid >> 3, k8 = tid & 7; float f[8];
#pragma unroll
            for (int z = 0; z < 8; ++z) f[z] = L[q * 4160 + (k8 * 8 + z) * 65 + n];
            u32x4 w; w.x = cvt_pk_bf16(f[0], f[1]); w.y = cvt_pk_bf16(f[2], f[3]); w.z = cvt_pk_bf16(f[4], f[5]); w.w = cvt_pk_bf16(f[6], f[7]);
            *(u32x4*)(wt[q] + (size_t)(nb[q] + n) * kk[q] + kb[q] + k8 * 8) = w; }
        __syncthreads();
    }
    if (!misc) return;
    { bf16_t* xb = (bf16_t*)(p.ws + WS_ACT);
      const size_t n8 = (size_t)MT * DM / 8, np8 = (size_t)MP * DM / 8;
      for (size_t i = (size_t)bid * NTHREADS + tid; i < n8; i += (size_t)G * NTHREADS) {
          const float* src = (i < np8) ? p.in[0] + i * 8 : p.in[1] + (i - np8) * 8;
          const float4 a = *(const float4*)src, b = *(const float4*)(src + 4);
          u32x4 w; w.x = cvt_pk_bf16(a.x, a.y); w.y = cvt_pk_bf16(a.z, a.w); w.z = cvt_pk_bf16(b.x, b.y); w.w = cvt_pk_bf16(b.z, b.w);
          *(u32x4*)(xb + i * 8) = w; } }
    { bf16_t* w2t = (bf16_t*)(p.ws + WS_W2T); bf16_t* a2t = (bf16_t*)(p.ws + WS_A2T); bf16_t* g2t = (bf16_t*)(p.ws + WS_G2T);
      for (int i = bid * NTHREADS + tid; i < 512 * 256; i += G * NTHREADS) { const int c = i >> 8, j = i & 255;
          if (j < 64) w2t[c * 64 + j] = (bf16_t)(cvt_pk_bf16(p.in[9][j * 512 + c], 0.f) & 0xffffu);
          else if (j < 128) a2t[c * 64 + (j - 64)] = (bf16_t)(cvt_pk_bf16(p.in[11][(j - 64) * 512 + c], 0.f) & 0xffffu);
          else g2t[c * 128 + (j - 128)] = (bf16_t)(cvt_pk_bf16(p.in[12][(j - 128) * 512 + c], 0.f) & 0xffffu); } }
    { float2* rope = (float2*)(p.ws + WS_ROPE);
      for (int i = bid * NTHREADS + tid; i < 2056 * 32; i += G * NTHREADS) {
          const int pidx = i >> 5, f = i & 31; const double pos = (double)(pidx < 2048 ? pidx : 16384 + (pidx - 2048));
          double rev = pos * p.inv_freq[f] * 0.15915494309189535; rev -= rint(rev);
          const float fr = (float)rev;
          rope[i] = make_float2(__builtin_amdgcn_cosf(fr), __builtin_amdgcn_sinf(fr)); } }
}

__device__ __forceinline__ void st_lds_bf16(LAS unsigned char* base, int byteoff, float v) { *(LAS bf16_t*)(base + byteoff) = (bf16_t)(cvt_pk_bf16(v, 0.f) & 0xffffu); }
constexpr int LRS = 528;
constexpr int S_LIN = 30720, S_AW = S_LIN + 16 * 528, S_AA = S_AW + 2048, S_AG = S_AA + 2048;
__device__ __forceinline__ void phase_sample(const Params& p, LAS unsigned char* lds, const int tid_in, const int bid, const int G) {
    const bf16_t* proj = (const bf16_t*)(p.ws + WS_BIG);
    bf16_t* ycat = (bf16_t*)(p.ws + WS_ACT);
    const float2* rope = (const float2*)(p.ws + WS_ROPE);
    const float* mu = p.in[7];
    LAS float* lora = (LAS float*)lds;
    LAS float* sc_r = lora + 2048; LAS float* sc_w = sc_r + 512; LAS float* sc_k = sc_w + 512; LAS float* sc_v = sc_k + 512; LAS float* sc_a = sc_v + 512; LAS float* sc_b = sc_a + 512;
    LAS float* rt_q = sc_b + 512; LAS float* rt_k = rt_q + 512; LAS float* rt_v = rt_k + 512; LAS float* o_w = rt_v + 512; LAS float* o_r = o_w + 512;
    for (int it = bid; it < NBS * 8; it += G) {
        int tid = tid_in; asm volatile("" : "+v"(tid));
        const int lane = tid & 63, wave = tid >> 6, c = lane, t = wave;
        const int b = it >> 3, h = it & 7, hc = h * 64; const unsigned hcc = (unsigned)(hc + c);
        const int rowbase = MP + b * TS;
        const float* shift0 = p.in[2] + (size_t)b * APROJ;
#pragma unroll
        for (int q = 0; q < 4; ++q) { const int idx = tid + q * NTHREADS; const int tt = idx >> 8, j = idx & 255; const unsigned col = 1536u + (unsigned)j; const unsigned ro = (unsigned)(rowbase + tt) * (unsigned)NPROJ;
            const float pc = bf2f(proj[ro + col]); const float pp = (tt == 0) ? shift0[col] : bf2f(proj[ro - (unsigned)NPROJ + col]);
            const float m = pc + (pp - pc) * mu[col];
            st_lds_bf16(lds + S_LIN, tt * LRS + j * 2, j < 64 ? (1.0f - 2.0f / (__expf(2.0f * m) + 1.0f)) : (j < 128 ? m : 1.0f / (1.0f + __expf(-m)))); }
        float mr, mk, mv, qg;
        { const unsigned ro = (unsigned)(rowbase + t) * (unsigned)NPROJ; const unsigned rp = ro - (unsigned)NPROJ; const bool first = (t == 0);
          { const float pc = bf2f(proj[ro + hcc]); const float pp = first ? shift0[hcc] : bf2f(proj[rp + hcc]); mr = pc + (pp - pc) * mu[hcc]; }
          { const float pc = bf2f(proj[ro + 512u + hcc]); const float pp = first ? shift0[512u + hcc] : bf2f(proj[rp + 512u + hcc]); mk = pc + (pp - pc) * mu[512u + hcc]; }
          { const float pc = bf2f(proj[ro + 1024u + hcc]); const float pp = first ? shift0[1024u + hcc] : bf2f(proj[rp + 1024u + hcc]); mv = pc + (pp - pc) * mu[1024u + hcc]; }
          const float2 cs = rope[(unsigned)(2048 + t) * 32u + (unsigned)(c & 31)]; const float sgn = (c < 32) ? -1.f : 1.f; const unsigned hco = (unsigned)(hc + (c ^ 32));
          const float qs = bf2f(proj[ro + (unsigned)APROJ + hcc]), qo = bf2f(proj[ro + (unsigned)APROJ + hco]);
          const float ks = bf2f(proj[ro + (unsigned)(APROJ + 512) + hcc]), ko = bf2f(proj[ro + (unsigned)(APROJ + 512) + hco]);
          rt_q[t * 64 + c] = qs * cs.x + sgn * qo * cs.y; rt_k[t * 64 + c] = (ks * cs.x + sgn * ko * cs.y) * 0.125f;
          rt_v[t * 64 + c] = bf2f(proj[ro + (unsigned)(APROJ + 1024) + hcc]); qg = bf2f(proj[ro + (unsigned)(APROJ + 1536) + hcc]); }
        __syncthreads();
        float gv, bonus;
        { const int fr = lane & 15, fq = lane >> 4, nt = wave & 3; const unsigned cr = (unsigned)(hc + nt * 16 + fr);
          const bf16_t* w2t = (const bf16_t*)(p.ws + WS_W2T); const bf16_t* a2t = (const bf16_t*)(p.ws + WS_A2T); const bf16_t* g2t = (const bf16_t*)(p.ws + WS_G2T);
          if (wave < 4) { f32x4 dw = (f32x4){0.f, 0.f, 0.f, 0.f}, da = dw;
#pragma unroll
              for (int ks = 0; ks < 2; ++ks) { const bf16x8 x0 = *(const LAS bf16x8*)(lds + S_LIN + fr * LRS + (ks * 32 + fq * 8) * 2), x1 = *(const LAS bf16x8*)(lds + S_LIN + fr * LRS + (64 + ks * 32 + fq * 8) * 2);
                  dw = __builtin_amdgcn_mfma_f32_16x16x32_bf16(x0, *(const bf16x8*)(w2t + cr * 64u + (unsigned)(ks * 32 + fq * 8)), dw, 0, 0, 0);
                  da = __builtin_amdgcn_mfma_f32_16x16x32_bf16(x1, *(const bf16x8*)(a2t + cr * 64u + (unsigned)(ks * 32 + fq * 8)), da, 0, 0, 0); }
              if (fq < 2) {
#pragma unroll
                  for (int jj = 0; jj < 4; ++jj) { *(LAS float*)(lds + S_AW + (fq * 4 + jj) * 256 + (nt * 16 + fr) * 4) = dw[jj]; *(LAS float*)(lds + S_AA + (fq * 4 + jj) * 256 + (nt * 16 + fr) * 4) = da[jj]; } } }
          else { f32x4 dg = (f32x4){0.f, 0.f, 0.f, 0.f};
#pragma unroll
              for (int ks = 0; ks < 4; ++ks) { const bf16x8 x2 = *(const LAS bf16x8*)(lds + S_LIN + fr * LRS + (128 + ks * 32 + fq * 8) * 2);
                  dg = __builtin_amdgcn_mfma_f32_16x16x32_bf16(x2, *(const bf16x8*)(g2t + cr * 128u + (unsigned)(ks * 32 + fq * 8)), dg, 0, 0, 0); }
              if (fq < 2) {
#pragma unroll
                  for (int jj = 0; jj < 4; ++jj) *(LAS float*)(lds + S_AG + (fq * 4 + jj) * 256 + (nt * 16 + fr) * 4) = dg[jj]; } } }
        __syncthreads();
        { const float aw = p.in[8][hcc] + *(const LAS float*)(lds + S_AW + t * 256 + c * 4), aa = p.in[10][hcc] + *(const LAS float*)(lds + S_AA + t * 256 + c * 4), ag = *(const LAS float*)(lds + S_AG + t * 256 + c * 4);
          const float z = -aw; const float sp = fmaxf(z, 0.f) + log1pf(__expf(-fabsf(z)));
          const float decay = __expf(-__expf(-sp - 0.5f));
          const float al = 1.0f / (1.0f + __expf(-aa));
          const float kkr = mk * p.in[13][hcc]; const float ss = wave_sum(kkr * kkr); const float kk = kkr * rsqrtf(fmaxf(ss, 1e-24f));
          const float kp = mk * (1.0f + (al - 1.0f) * p.in[14][hcc]);
          bonus = wave_sum(mr * kp * p.in[15][hcc]); gv = ag;
          sc_r[t * 64 + c] = mr; sc_w[t * 64 + c] = decay; sc_k[t * 64 + c] = kp; sc_v[t * 64 + c] = mv; sc_a[t * 64 + c] = -kk; sc_b[t * 64 + c] = kk * al; }
        __syncthreads();
        { const int wv = wave & 3, rloc = lane >> 2, kc = lane & 3, row = wv * 16 + rloc;
          float St[16];
          if (wave < 4) {
              const float* src = p.in[3] + (size_t)(b * 8 + h) * 4096 + (unsigned)(row * 64 + kc * 16);
#pragma unroll
              for (int i4 = 0; i4 < 4; ++i4) { const f32x4 v4 = *(const f32x4*)(src + i4 * 4); St[i4 * 4] = v4[0]; St[i4 * 4 + 1] = v4[1]; St[i4 * 4 + 2] = v4[2]; St[i4 * 4 + 3] = v4[3]; }
              for (int s = 0; s < TS; ++s) {
                  const LAS f32x4* A4 = (const LAS f32x4*)(sc_a + s * 64 + kc * 16); const LAS f32x4* W4 = (const LAS f32x4*)(sc_w + s * 64 + kc * 16); const LAS f32x4* B4 = (const LAS f32x4*)(sc_b + s * 64 + kc * 16);
                  const LAS f32x4* K4 = (const LAS f32x4*)(sc_k + s * 64 + kc * 16); const LAS f32x4* R4 = (const LAS f32x4*)(sc_r + s * 64 + kc * 16);
                  float sa = 0.f;
#pragma unroll
                  for (int i4 = 0; i4 < 4; ++i4) { const f32x4 a = A4[i4]; sa += (St[i4 * 4] * a[0] + St[i4 * 4 + 1] * a[1]) + (St[i4 * 4 + 2] * a[2] + St[i4 * 4 + 3] * a[3]); }
                  sa += dpp_mov<0xB1>(sa); sa += dpp_mov<0x4E>(sa);
                  const float vv = sc_v[s * 64 + row]; float o = 0.f;
#pragma unroll
                  for (int i4 = 0; i4 < 4; ++i4) { const f32x4 w = W4[i4], bb = B4[i4], kq = K4[i4], r = R4[i4];
#pragma unroll
                      for (int q = 0; q < 4; ++q) { St[i4 * 4 + q] = St[i4 * 4 + q] * w[q] + sa * bb[q] + vv * kq[q]; o += St[i4 * 4 + q] * r[q]; } }
                  o += dpp_mov<0xB1>(o); o += dpp_mov<0x4E>(o);
                  if (kc == 0) o_w[s * 64 + row] = o;
              }
              float* dst = p.out + O_SWKV + (size_t)(b * 8 + h) * 4096 + (unsigned)(row * 64 + kc * 16);
#pragma unroll
              for (int i4 = 0; i4 < 4; ++i4) *(f32x4*)(dst + i4 * 4) = (f32x4){St[i4 * 4], St[i4 * 4 + 1], St[i4 * 4 + 2], St[i4 * 4 + 3]};
          } else {
              const float gamma = 1.0f - exp2f(-5.0f - (float)h);
              const float* src = p.in[4] + (size_t)(b * 8 + h) * 4096 + (unsigned)(kc * 16 * 64 + row);
#pragma unroll
              for (int i = 0; i < 16; ++i) St[i] = src[i * 64];
              for (int s = 0; s < TS; ++s) {
                  const LAS f32x4* K4 = (const LAS f32x4*)(rt_k + s * 64 + kc * 16); const LAS f32x4* Q4 = (const LAS f32x4*)(rt_q + s * 64 + kc * 16);
                  const float vv = rt_v[s * 64 + row]; float o = 0.f;
#pragma unroll
                  for (int i4 = 0; i4 < 4; ++i4) { const f32x4 kq = K4[i4], q4 = Q4[i4];
#pragma unroll
                      for (int q = 0; q < 4; ++q) { St[i4 * 4 + q] = St[i4 * 4 + q] * gamma + kq[q] * vv; o += St[i4 * 4 + q] * q4[q]; } }
                  o += dpp_mov<0xB1>(o); o += dpp_mov<0x4E>(o);
                  if (kc == 0) o_r[s * 64 + row] = o;
              }
              float* dst = p.out + O_SRET + (size_t)(b * 8 + h) * 4096 + (unsigned)(kc * 16 * 64 + row);
#pragma unroll
              for (int i = 0; i < 16; ++i) dst[i * 64] = St[i];
          } }
        __syncthreads();
        { const unsigned row = (unsigned)(rowbase + t);
          { const float o = o_w[t * 64 + c]; const float mean = wave_sum(o) * (1.f / 64.f); const float d = o - mean; const float var = wave_sum(d * d) * (1.f / 64.f);
            const float ya = (d * rsqrtf(var + 64e-5f) * p.in[16][hcc] + p.in[17][hcc] + bonus * mv) * gv;
            const float ya2 = dpp_mov<0xF5>(ya); if (!(c & 1)) *(unsigned*)(ycat + (row * (unsigned)DM + hcc)) = cvt_pk_bf16(ya, ya2); }
          { const float o = o_r[t * 64 + c]; const float mean = wave_sum(o) * (1.f / 64.f); const float d = o - mean; const float var = wave_sum(d * d) * (1.f / 64.f);
            const float yb = qg / (1.0f + __expf(-qg)) * (d * rsqrtf(var + 1e-5f) * p.in[18][hcc] + p.in[19][hcc]);
            const float yb2 = dpp_mov<0xF5>(yb); if (!(c & 1)) *(unsigned*)(ycat + (row * (unsigned)DM + 512u + hcc)) = cvt_pk_bf16(yb, yb2); } }
        if (h == 0) { float* dst = p.out + O_SSHIFT + (size_t)b * APROJ; const bf16_t* pr = proj + (size_t)(rowbase + TS - 1) * NPROJ;
            for (int j = tid; j < APROJ; j += NTHREADS) dst[j] = bf2f(pr[j]); }
        __syncthreads();
    }
}

constexpr int RS = 144;
constexpr int UNIT = 64 * RS;
constexpr int FRS = 272;
constexpr int U_AT = 0, U_BT = UNIT, U_KT = 2 * UNIT, U_RT = 3 * UNIT, U_VT = 4 * UNIT, U_BH = 5 * UNIT, U_KH = 6 * UNIT;
constexpr int U_LAK = 7 * UNIT, U_MRB = 8 * UNIT, U_MRK = 9 * UNIT, U_PT = 10 * UNIT, U_QT = 11 * UNIT;
constexpr int F_LAB = 12 * UNIT, F_X = F_LAB + 64 * FRS, F_MISC = F_X + 64 * FRS;
constexpr int L_LIN = 7 * UNIT, F_AW = L_LIN + 64 * LRS, F_AA = F_AW + 64 * FRS;
static_assert(F_MISC + 2304 <= LDS_BYTES && F_AA + 64 * FRS <= F_MISC, "LDS map");

__device__ __forceinline__ f32x4 mm2(const LAS unsigned char* A, const LAS unsigned char* B, int arow, int brow, int fq, f32x4 acc) {
#pragma unroll
    for (int ks = 0; ks < 2; ++ks) {
        const bf16x8 a = *(const LAS bf16x8*)(A + arow * RS + (ks * 32 + fq * 8) * 2);
        const bf16x8 b = *(const LAS bf16x8*)(B + brow * RS + (ks * 32 + fq * 8) * 2);
        acc = __builtin_amdgcn_mfma_f32_16x16x32_bf16(a, b, acc, 0, 0, 0);
    }
    return acc;
}
#ifndef SAN
#define SAN 0
#endif
template <int CAT> __device__ __forceinline__ u32x2 pk4c(f32x4 v) { u32x2 w;
    if (SAN & (1 << CAT)) {
#pragma unroll
        for (int q = 0; q < 4; ++q) v[q] = (fabsf(v[q]) <= 3.0e38f) ? v[q] : 0.f; }
    w.x = cvt_pk_bf16(v[0], v[1]); w.y = cvt_pk_bf16(v[2], v[3]); return w; }

__device__ __forceinline__ void phase_mix_local(const Params& p, LAS unsigned char* lds, const int tid_in, const int bid, const int G) {
    bf16_t* proj = (bf16_t*)(p.ws + WS_BIG);
    const float2* rope = (const float2*)(p.ws + WS_ROPE);
    const float* mu = p.in[7];
    for (int item = bid; item < 2048; item += G) {
        int tid = tid_in; asm volatile("" : "+v"(tid));
        const int lane = tid & 63, wave = tid >> 6, fr = lane & 15, fq = lane >> 4;
        const int c = lane, tg = wave;
        const int mt = wave & 3, nt0 = (wave >> 2) * 2;
        const int bh = item >> 5, ch = item & 31, b = bh >> 3, h = bh & 7, hc = h * 64;
        const unsigned hcc = (unsigned)(hc + c);
        const int rowbase = b * TP + ch * 64;
        unsigned char* r1 = p.ws + WS_ACT + (size_t)item * 16384;
        unsigned char* r2 = (unsigned char*)(p.out + O_Y) + (size_t)item * 24576;
        unsigned char* r3 = p.ws + WS_R3 + (size_t)item * 8192;
        {
            const float l2g = log2f(1.0f - exp2f(-5.0f - (float)h));
            float qv[8], kv[8], vv[8];
#pragma unroll
            for (int i = 0; i < 8; ++i) { const int t = tg * 8 + i; const unsigned ro = (unsigned)(rowbase + t) * (unsigned)NPROJ;
                const float2 cs = rope[(unsigned)(ch * 64 + t) * 32u + (unsigned)(c & 31)];
                const float sgn = (c < 32) ? -1.f : 1.f; const unsigned hco = (unsigned)(hc + (c ^ 32));
                const float qs = bf2f(proj[ro + (unsigned)APROJ + hcc]), qo = bf2f(proj[ro + (unsigned)APROJ + hco]);
                const float ks = bf2f(proj[ro + (unsigned)(APROJ + 512) + hcc]), ko = bf2f(proj[ro + (unsigned)(APROJ + 512) + hco]);
                qv[i] = qs * cs.x + sgn * qo * cs.y; kv[i] = (ks * cs.x + sgn * ko * cs.y) * 0.125f; vv[i] = bf2f(proj[ro + (unsigned)(APROJ + 1024) + hcc]); }
            asm volatile("s_waitcnt vmcnt(0)" ::: "memory");
            __syncthreads();
            { float vt[8], kh[8];
#pragma unroll
              for (int i = 0; i < 8; ++i) { const int t = tg * 8 + i; const unsigned ro = (unsigned)(rowbase + t) * (unsigned)NPROJ;
                  const float qd = qv[i] * exp2f(l2g * (float)(t + 1));
                  const unsigned qb = cvt_pk_bf16(qd, 0.f) & 0xffffu;
                  proj[ro + (unsigned)APROJ + hcc] = (bf16_t)qb;
                  *(LAS bf16_t*)(lds + U_RT + t * RS + c * 2) = (bf16_t)qb;
                  st_lds_bf16(lds + U_KT, t * RS + c * 2, kv[i] * exp2f(-l2g * (float)(t + 1)));
                  vt[i] = vv[i]; kh[i] = kv[i] * exp2f(l2g * (float)(63 - t)); }
              u32x4 w; w.x = cvt_pk_bf16(vt[0], vt[1]); w.y = cvt_pk_bf16(vt[2], vt[3]); w.z = cvt_pk_bf16(vt[4], vt[5]); w.w = cvt_pk_bf16(vt[6], vt[7]);
              *(LAS u32x4*)(lds + U_VT + c * RS + tg * 16) = w;
              w.x = cvt_pk_bf16(kh[0], kh[1]); w.y = cvt_pk_bf16(kh[2], kh[3]); w.z = cvt_pk_bf16(kh[4], kh[5]); w.w = cvt_pk_bf16(kh[6], kh[7]);
              *(LAS u32x4*)(lds + U_KH + c * RS + tg * 16) = w; }
            __syncthreads();
#pragma unroll
            for (int n = 0; n < 2; ++n) { const int nt = nt0 + n; f32x4 acc = (f32x4){0.f, 0.f, 0.f, 0.f};
                acc = mm2(lds + U_KT, lds + U_RT, mt * 16 + fr, nt * 16 + fr, fq, acc);
                const int t = nt * 16 + fr, j0 = mt * 16 + fq * 4;
#pragma unroll
                for (int jj = 0; jj < 4; ++jj) if (j0 + jj > t) acc[jj] = 0.f;
                *(LAS u32x2*)(lds + U_MRK + t * RS + j0 * 2) = pk4c<1>(acc); }
            __syncthreads();
#pragma unroll
            for (int n = 0; n < 2; ++n) { const int nt = nt0 + n;
                { f32x4 acc = (f32x4){0.f, 0.f, 0.f, 0.f};
                  acc = mm2(lds + U_VT, lds + U_MRK, mt * 16 + fr, nt * 16 + fr, fq, acc);
                  const int t = nt * 16 + fr, v0 = mt * 16 + fq * 4;
                  *(u32x2*)(proj + (unsigned)(rowbase + t) * (unsigned)NPROJ + (unsigned)(APROJ + 512 + hc + v0)) = pk4c<1>(acc); }
                { f32x4 acc = (f32x4){0.f, 0.f, 0.f, 0.f};
                  acc = mm2(lds + U_KH, lds + U_VT, mt * 16 + fr, nt * 16 + fr, fq, acc);
                  const int v = nt * 16 + fr, k0 = mt * 16 + fq * 4;
                  *(u32x2*)(r3 + v * 128 + k0 * 2) = pk4c<1>(acc); } }
            __syncthreads();
        }
        {
            { const int j = tid & 255, t0 = (tid >> 8) * 32; const unsigned col = 1536u + (unsigned)j; const float muc = mu[col];
              const unsigned ro0 = (unsigned)(rowbase + t0) * (unsigned)NPROJ + col;
              float pv[33];
              pv[0] = (ch == 0 && t0 == 0) ? 0.f : bf2f(proj[ro0 - (unsigned)NPROJ]);
#pragma unroll
              for (int i = 0; i < 32; ++i) pv[i + 1] = bf2f(proj[ro0 + (unsigned)i * (unsigned)NPROJ]);
#pragma unroll
              for (int i = 0; i < 32; ++i) { const float m = pv[i + 1] + (pv[i] - pv[i + 1]) * muc;
                  st_lds_bf16(lds + L_LIN, (t0 + i) * LRS + j * 2, j < 64 ? (1.0f - 2.0f / (__expf(2.0f * m) + 1.0f)) : (j < 128 ? m : 1.0f / (1.0f + __expf(-m)))); } }
            float mr[8], mk[8], mv[8];
            { const float mu_r = mu[hcc], mu_k = mu[512u + hcc], mu_v = mu[1024u + hcc];
#pragma unroll
              for (int i = 0; i < 8; ++i) { const int t = tg * 8 + i; const unsigned ro = (unsigned)(rowbase + t) * (unsigned)NPROJ; const unsigned rp = ro - (unsigned)NPROJ; const bool first = (ch == 0 && t == 0);
                  { const float pc = bf2f(proj[ro + hcc]); const float pp = first ? 0.f : bf2f(proj[rp + hcc]); mr[i] = pc + (pp - pc) * mu_r; }
                  { const float pc = bf2f(proj[ro + 512u + hcc]); const float pp = first ? 0.f : bf2f(proj[rp + 512u + hcc]); mk[i] = pc + (pp - pc) * mu_k; }
                  { const float pc = bf2f(proj[ro + 1024u + hcc]); const float pp = first ? 0.f : bf2f(proj[rp + 1024u + hcc]); mv[i] = pc + (pp - pc) * mu_v; } } }
            __syncthreads();
            { const bf16_t* w2t = (const bf16_t*)(p.ws + WS_W2T); const bf16_t* a2t = (const bf16_t*)(p.ws + WS_A2T); const bf16_t* g2t = (const bf16_t*)(p.ws + WS_G2T);
#pragma unroll
              for (int n = 0; n < 2; ++n) { const int nt = nt0 + n; const unsigned cr = (unsigned)(hc + nt * 16 + fr);
                  f32x4 dw = (f32x4){0.f, 0.f, 0.f, 0.f}, da = dw, dg = dw;
#pragma unroll
                  for (int ks = 0; ks < 2; ++ks) {
                      const bf16x8 x0 = *(const LAS bf16x8*)(lds + L_LIN + (mt * 16 + fr) * LRS + (ks * 32 + fq * 8) * 2), x1 = *(const LAS bf16x8*)(lds + L_LIN + (mt * 16 + fr) * LRS + (64 + ks * 32 + fq * 8) * 2);
                      dw = __builtin_amdgcn_mfma_f32_16x16x32_bf16(x0, *(const bf16x8*)(w2t + cr * 64u + (unsigned)(ks * 32 + fq * 8)), dw, 0, 0, 0);
                      da = __builtin_amdgcn_mfma_f32_16x16x32_bf16(x1, *(const bf16x8*)(a2t + cr * 64u + (unsigned)(ks * 32 + fq * 8)), da, 0, 0, 0); }
#pragma unroll
                  for (int ks = 0; ks < 4; ++ks) { const bf16x8 x2 = *(const LAS bf16x8*)(lds + L_LIN + (mt * 16 + fr) * LRS + (128 + ks * 32 + fq * 8) * 2);
                      dg = __builtin_amdgcn_mfma_f32_16x16x32_bf16(x2, *(const bf16x8*)(g2t + cr * 128u + (unsigned)(ks * 32 + fq * 8)), dg, 0, 0, 0); }
#pragma unroll
                  for (int jj = 0; jj < 4; ++jj) { const int t = mt * 16 + fq * 4 + jj, cc = nt * 16 + fr;
                      *(LAS float*)(lds + F_AW + t * FRS + cc * 4) = dw[jj]; *(LAS float*)(lds + F_AA + t * FRS + cc * 4) = da[jj];
                      *(bf16_t*)(r2 + 8192 + t * 128 + cc * 2) = (bf16_t)(cvt_pk_bf16(dg[jj], 0.f) & 0xffffu); } } }
            __syncthreads();
            float lw[8], kp[8], na[8], bb[8];
            { float aw[8], aa[8];
              const float kkc = p.in[13][hcc], kac = p.in[14][hcc], rkc = p.in[15][hcc], w0c = p.in[8][hcc], a0c = p.in[10][hcc];
#pragma unroll
              for (int i = 0; i < 8; ++i) { const int t = tg * 8 + i; aw[i] = w0c + *(const LAS float*)(lds + F_AW + t * FRS + c * 4); aa[i] = a0c + *(const LAS float*)(lds + F_AA + t * FRS + c * 4); }
              float al8[8], ss8[8], bo8[8], kkr8[8];
#pragma unroll
              for (int i = 0; i < 8; ++i) {
                  const float z = -aw[i]; const float sp = fmaxf(z, 0.f) + log1pf(__expf(-fabsf(z)));
                  lw[i] = -__expf(-sp - 0.5f);
                  al8[i] = 1.0f / (1.0f + __expf(-aa[i]));
                  kkr8[i] = mk[i] * kkc; ss8[i] = kkr8[i] * kkr8[i];
                  kp[i] = mk[i] * (1.0f + (al8[i] - 1.0f) * kac); bo8[i] = mr[i] * kp[i] * rkc; }
#pragma unroll
              for (int i = 0; i < 8; ++i) { ss8[i] = wave_sum(ss8[i]); bo8[i] = wave_sum(bo8[i]); }
#pragma unroll
              for (int i = 0; i < 8; ++i) { const int t = tg * 8 + i;
                  const float kk = kkr8[i] * rsqrtf(fmaxf(ss8[i], 1e-24f));
                  na[i] = -kk; bb[i] = kk * al8[i];
                  *(bf16_t*)(r2 + 16384 + t * 128 + c * 2) = (bf16_t)(cvt_pk_bf16(bo8[i] * mv[i], 0.f) & 0xffffu); } }
            LAS float* wend = (LAS float*)(lds + F_MISC); LAS float* part = wend + 64;
            float cl[8];
            { float s = 0.f;
#pragma unroll
              for (int i = 0; i < 8; ++i) { s += lw[i]; cl[i] = s; }
              part[tg * 64 + c] = s; }
            __syncthreads();
            float base = 0.f, tot = 0.f;
#pragma unroll
            for (int g8 = 0; g8 < 8; ++g8) { const float pv = part[g8 * 64 + c]; tot += pv; if (g8 < tg) base += pv; }
            if (tg == 0) wend[c] = __expf(tot);
            { float vt[8], bh8[8], kh8[8];
#pragma unroll
              for (int i = 0; i < 8; ++i) { const int t = tg * 8 + i; const float cum = base + cl[i];
                  const float ec = __expf(cum), en = __expf(-cum), eh = __expf(tot - cum);
                  st_lds_bf16(lds + U_AT, t * RS + c * 2, na[i] * __expf(cum - lw[i]));
                  st_lds_bf16(lds + U_BT, t * RS + c * 2, bb[i] * en);
                  st_lds_bf16(lds + U_KT, t * RS + c * 2, kp[i] * en);
                  st_lds_bf16(lds + U_RT, t * RS + c * 2, mr[i] * ec);
                  vt[i] = mv[i]; bh8[i] = bb[i] * eh; kh8[i] = kp[i] * eh; }
              u32x4 w; w.x = cvt_pk_bf16(vt[0], vt[1]); w.y = cvt_pk_bf16(vt[2], vt[3]); w.z = cvt_pk_bf16(vt[4], vt[5]); w.w = cvt_pk_bf16(vt[6], vt[7]);
              *(LAS u32x4*)(lds + U_VT + c * RS + tg * 16) = w;
              w.x = cvt_pk_bf16(bh8[0], bh8[1]); w.y = cvt_pk_bf16(bh8[2], bh8[3]); w.z = cvt_pk_bf16(bh8[4], bh8[5]); w.w = cvt_pk_bf16(bh8[6], bh8[7]);
              *(LAS u32x4*)(lds + U_BH + c * RS + tg * 16) = w;
              w.x = cvt_pk_bf16(kh8[0], kh8[1]); w.y = cvt_pk_bf16(kh8[2], kh8[3]); w.z = cvt_pk_bf16(kh8[4], kh8[5]); w.w = cvt_pk_bf16(kh8[6], kh8[7]);
              *(LAS u32x4*)(lds + U_KH + c * RS + tg * 16) = w; }
            __syncthreads();
#pragma unroll
            for (int n = 0; n < 2; ++n) { const int nt = nt0 + n; const int t = nt * 16 + fr, j0 = mt * 16 + fq * 4; const f32x4 z4 = (f32x4){0.f, 0.f, 0.f, 0.f};
                f32x4 lab = mm2(lds + U_BT, lds + U_AT, mt * 16 + fr, nt * 16 + fr, fq, z4);
                f32x4 lak = mm2(lds + U_KT, lds + U_AT, mt * 16 + fr, nt * 16 + fr, fq, z4);
                f32x4 mrb = mm2(lds + U_BT, lds + U_RT, mt * 16 + fr, nt * 16 + fr, fq, z4);
                f32x4 mrk = mm2(lds + U_KT, lds + U_RT, mt * 16 + fr, nt * 16 + fr, fq, z4);
#pragma unroll
                for (int jj = 0; jj < 4; ++jj) { if (j0 + jj >= t) { lab[jj] = 0.f; lak[jj] = 0.f; } if (j0 + jj > t) { mrb[jj] = 0.f; mrk[jj] = 0.f; } }
                *(LAS f32x4*)(lds + F_LAB + t * FRS + j0 * 4) = lab;
                *(LAS u32x2*)(lds + U_LAK + t * RS + j0 * 2) = pk4c<0>(lak);
                *(LAS u32x2*)(lds + U_MRB + t * RS + j0 * 2) = pk4c<0>(mrb);
                *(LAS u32x2*)(lds + U_MRK + t * RS + j0 * 2) = pk4c<0>(mrk); }
            __syncthreads();
#pragma unroll
            for (int n = 0; n < 2; ++n) { const int nt = nt0 + n; const int t = nt * 16 + fr, v0 = mt * 16 + fq * 4;
                const f32x4 x = mm2(lds + U_VT, lds + U_LAK, mt * 16 + fr, nt * 16 + fr, fq, (f32x4){0.f, 0.f, 0.f, 0.f});
                *(LAS f32x4*)(lds + F_X + t * FRS + v0 * 4) = x; }
            { const int t = tid >> 3, j0 = (tid & 7) * 8;
              const f32x4 l0 = *(const LAS f32x4*)(lds + F_LAB + t * FRS + j0 * 4), l1 = *(const LAS f32x4*)(lds + F_LAB + t * FRS + j0 * 4 + 16);
              u32x4 w; w.x = cvt_pk_bf16(l0[0], l0[1]); w.y = cvt_pk_bf16(l0[2], l0[3]); w.z = cvt_pk_bf16(l1[0], l1[1]); w.w = cvt_pk_bf16(l1[2], l1[3]);
              if ((j0 >> 4) == (t >> 4)) w = (u32x4){0u, 0u, 0u, 0u};
              *(LAS u32x4*)(lds + U_KT + t * RS + j0 * 2) = w;
              for (int i = tid; i < 2 * UNIT / 16; i += NTHREADS) ((LAS u32x4*)(lds + U_PT))[i] = (u32x4){0u, 0u, 0u, 0u}; }
            __syncthreads();
#pragma unroll 1
            for (int bi = 0; bi < 4; ++bi) {
                { const LAS unsigned char* YB = lds + ((wave < 4) ? U_PT : U_QT); const int ntl = wave & 3;
                  f32x4 d = (f32x4){0.f, 0.f, 0.f, 0.f};
                  const int nks = (bi + 1) >> 1;
                  for (int ks = 0; ks < nks; ++ks) { const bf16x8 a = *(const LAS bf16x8*)(lds + U_KT + (bi * 16 + fr) * RS + (ks * 32 + fq * 8) * 2), bq = *(const LAS bf16x8*)(YB + (ntl * 16 + fr) * RS + (ks * 32 + fq * 8) * 2);
                      d = __builtin_amdgcn_mfma_f32_16x16x32_bf16(a, bq, d, 0, 0, 0); }
#pragma unroll
                  for (int jj = 0; jj < 4; ++jj) { const int i = fq * 4 + jj, row = bi * 16 + i;
                      const float rhs = (wave < 4) ? bf2f(*(const LAS bf16_t*)(lds + U_AT + row * RS + (ntl * 16 + fr) * 2)) : *(const LAS float*)(lds + F_X + row * FRS + (ntl * 16 + fr) * 4);
                      *(LAS float*)(lds + U_LAK + i * 528 + (wave * 16 + fr) * 4) = d[jj] + rhs; } }
                __syncthreads();
                if (wave < 2) {
                    LAS unsigned char* dst = lds + (wave == 0 ? U_PT : U_QT) + lane * RS;
                    float acc[16];
#pragma unroll
                    for (int r = 0; r < 16; ++r) acc[r] = *(const LAS float*)(lds + U_LAK + r * 528 + (wave * 64 + lane) * 4);
                    const LAS unsigned char* Ld = lds + F_LAB + (bi * 16) * FRS + bi * 64;
#pragma unroll
                    for (int r = 1; r < 16; ++r) {
#pragma unroll
                        for (int q4 = 0; q4 < (r + 3) / 4; ++q4) { const f32x4 l = *(const LAS f32x4*)(Ld + r * FRS + q4 * 16);
#pragma unroll
                            for (int q = 0; q < 4; ++q) if (q4 * 4 + q < r) acc[r] += l[q] * acc[q4 * 4 + q]; }
                    }
                    u32x4 w; w.x = cvt_pk_bf16(acc[0], acc[1]); w.y = cvt_pk_bf16(acc[2], acc[3]); w.z = cvt_pk_bf16(acc[4], acc[5]); w.w = cvt_pk_bf16(acc[6], acc[7]);
                    *(LAS u32x4*)(dst + bi * 32) = w;
                    w.x = cvt_pk_bf16(acc[8], acc[9]); w.y = cvt_pk_bf16(acc[10], acc[11]); w.z = cvt_pk_bf16(acc[12], acc[13]); w.w = cvt_pk_bf16(acc[14], acc[15]);
                    *(LAS u32x4*)(dst + bi * 32 + 16) = w;
                }
                __syncthreads();
            }
#pragma unroll
            for (int n = 0; n < 2; ++n) { const int nt = nt0 + n; const f32x4 z4 = (f32x4){0.f, 0.f, 0.f, 0.f};
                { f32x4 g4 = mm2(lds + U_PT, lds + U_MRB, mt * 16 + fr, nt * 16 + fr, fq, z4);
                  const int t = nt * 16 + fr, k0 = mt * 16 + fq * 4; const u32x2 rr = *(const LAS u32x2*)(lds + U_RT + t * RS + k0 * 2);
                  g4[0] += __uint_as_float(rr.x << 16); g4[1] += __uint_as_float(rr.x & 0xffff0000u); g4[2] += __uint_as_float(rr.y << 16); g4[3] += __uint_as_float(rr.y & 0xffff0000u);
                  *(u32x2*)(proj + (unsigned)(rowbase + t) * (unsigned)NPROJ + (unsigned)(APROJ + 1024 + hc + k0)) = pk4c<2>(g4); }
                { f32x4 h4 = mm2(lds + U_QT, lds + U_MRB, mt * 16 + fr, nt * 16 + fr, fq, z4);
                  h4 = mm2(lds + U_VT, lds + U_MRK, mt * 16 + fr, nt * 16 + fr, fq, h4);
                  const int t = nt * 16 + fr, v0 = mt * 16 + fq * 4;
                  *(u32x2*)(r2 + t * 128 + v0 * 2) = pk4c<2>(h4); }
                { f32x4 f4 = mm2(lds + U_PT, lds + U_BH, mt * 16 + fr, nt * 16 + fr, fq, z4);
                  const int k2 = nt * 16 + fr, k10 = mt * 16 + fq * 4;
#pragma unroll
                  for (int jj = 0; jj < 4; ++jj) if (k10 + jj == k2) f4[jj] += wend[k2];
                  *(u32x2*)(r1 + k2 * 128 + k10 * 2) = pk4c<3>(f4); }
                { f32x4 s4 = mm2(lds + U_BH, lds + U_QT, mt * 16 + fr, nt * 16 + fr, fq, z4);
                  s4 = mm2(lds + U_KH, lds + U_VT, mt * 16 + fr, nt * 16 + fr, fq, s4);
                  const int v = nt * 16 + fr, k0 = mt * 16 + fq * 4;
                  *(u32x2*)(r1 + 8192 + v * 128 + k0 * 2) = pk4c<3>(s4); } }
            if (h == 0 && ch == 31) { float* dst = p.out + O_PSHIFT + (size_t)b * APROJ; const bf16_t* pr = proj + (size_t)(rowbase + 63) * NPROJ;
                for (int j = tid; j < APROJ; j += NTHREADS) dst[j] = bf2f(pr[j]); }
            __syncthreads();
        }
    }
}

constexpr int ORS = 32;
constexpr int CH_SCR = 0, CH_OBUF = 4 * 16 * RS, CH_RING = CH_OBUF + 4 * 2 * 64 * ORS, CH_SLOT = 24576, CH_R = 5, CH_A = 4;
static_assert(CH_RING + CH_R * CH_SLOT <= 155648 && (CH_RING & 15) == 0, "chain LDS map");
__device__ __forceinline__ void phase_chain(const Params& p, LAS unsigned char* lds, const int tid, const int bid, const int G) {
    const int lane = tid & 63, wave = __builtin_amdgcn_readfirstlane(tid >> 6), fr = lane & 15, fq = lane >> 4;
    bf16_t* proj = (bf16_t*)(p.ws + WS_BIG);
#define CH_BAR() do { asm volatile("s_waitcnt lgkmcnt(0)" ::: "memory"); __builtin_amdgcn_s_barrier(); asm volatile("" ::: "memory"); } while (0)
    for (int chain = bid; chain < 128; chain += G) {
        const int kind = chain & 1, bh = chain >> 1, b = bh >> 3, h = bh & 7, hc = h * 64;
        const unsigned slot = APROJ + (kind ? 0 : 1024) + hc;
        if (wave < 4) {
            const int vt = wave;
            LAS unsigned char* scr = lds + CH_SCR + vt * (16 * RS);
            LAS unsigned char* obuf = lds + CH_OBUF + vt * (2 * 64 * ORS);
            const float gC = kind ? exp2f(64.0f * log2f(1.0f - exp2f(-5.0f - (float)h))) : 0.f;
            f32x4 S[4]; bf16x8 Sb[2];
#pragma unroll
            for (int m = 0; m < 4; ++m) S[m] = (f32x4){0.f, 0.f, 0.f, 0.f};
#pragma unroll
            for (int ks = 0; ks < 2; ++ks) Sb[ks] = (bf16x8){0, 0, 0, 0, 0, 0, 0, 0};
            for (int ch = 0; ch < 32; ++ch) {
                CH_BAR();
                const LAS unsigned char* sl = lds + CH_RING + (ch % CH_R) * CH_SLOT;
                LAS unsigned char* ob = obuf + (ch & 1) * (64 * ORS);
#pragma unroll
                for (int m = 0; m < 4; ++m) {
                    const u32x2 pw = *(const LAS u32x2*)(sl + 8192 + (vt * 16 + fr) * 128 + (m * 16 + fq * 4) * 2);
                    const f32x4 d = (f32x4){__uint_as_float(pw.x << 16), __uint_as_float(pw.x & 0xffff0000u), __uint_as_float(pw.y << 16), __uint_as_float(pw.y & 0xffff0000u)};
                    f32x4 dm = d, o = (f32x4){0.f, 0.f, 0.f, 0.f};
#pragma unroll
                    for (int ks = 0; ks < 2; ++ks) {
                        dm = __builtin_amdgcn_mfma_f32_16x16x32_bf16(*(const LAS bf16x8*)(sl + (m * 16 + fr) * 128 + (ks * 32 + fq * 8) * 2), Sb[ks], dm, 0, 0, 0);
                        o = __builtin_amdgcn_mfma_f32_16x16x32_bf16(*(const LAS bf16x8*)(sl + 16384 + (m * 16 + fr) * 128 + (ks * 32 + fq * 8) * 2), Sb[ks], o, 0, 0, 0); }
                    const f32x4 dr = S[m] * gC + d;
#pragma unroll
                    for (int q = 0; q < 4; ++q) S[m][q] = kind ? dr[q] : dm[q];
#pragma unroll
                    for (int jj = 0; jj < 4; ++jj) *(LAS bf16_t*)(ob + (m * 16 + fq * 4 + jj) * ORS + fr * 2) = (bf16_t)(cvt_pk_bf16(o[jj], 0.f) & 0xffffu);
                }
#pragma unroll
                for (int m = 0; m < 4; ++m) *(LAS u32x2*)(scr + fr * RS + (m * 16 + fq * 4) * 2) = pk4c<4>(S[m]);
                asm volatile("s_waitcnt lgkmcnt(0)" ::: "memory");
#pragma unroll
                for (int ks = 0; ks < 2; ++ks) Sb[ks] = *(const LAS bf16x8*)(scr + fr * RS + (ks * 32 + fq * 8) * 2);
            }
            CH_BAR();
            if (!kind) { float* dst = p.out + O_PWKV + ((size_t)bh * 64 + vt * 16 + fr) * 64;
#pragma unroll
                for (int m = 0; m < 4; ++m) *(f32x4*)(dst + m * 16 + fq * 4) = S[m]; }
            else { float* dst = p.out + O_PRET + (size_t)bh * 4096 + vt * 16 + fr;
#pragma unroll
                for (int m = 0; m < 4; ++m)
#pragma unroll
                    for (int jj = 0; jj < 4; ++jj) dst[(m * 16 + fq * 4 + jj) * 64] = S[m][jj]; }
        } else if (wave < 6) {
            const int lw = wave - 4;
#define CH_ISSUE(chx) do { const int item_ = bh * 32 + (chx); const unsigned char* r1_ = p.ws + WS_ACT + (size_t)item_ * 16384; \
                const unsigned char* psi_ = kind ? (p.ws + WS_R3 + (size_t)item_ * 8192) : (r1_ + 8192); \
                const unsigned char* gb_ = (const unsigned char*)(proj + (size_t)(b * TP + (chx) * 64) * NPROJ + slot); \
                LAS unsigned char* sl_ = lds + CH_RING + ((chx) % CH_R) * CH_SLOT; \
                _Pragma("unroll") for (int q = 0; q < 12; ++q) { const int pi = lw + 2 * q, seg = pi >> 3; const int off = (pi & 7) * 1024 + lane * 16; \
                    const unsigned char* src_ = seg == 0 ? (r1_ + off) : (seg == 1 ? (psi_ + off) : (gb_ + (size_t)(off >> 7) * (NPROJ * 2) + (off & 127))); \
                    __builtin_amdgcn_global_load_lds((const unsigned*)src_, (LAS unsigned*)(sl_ + pi * 1024), 16, 0, 0); } } while (0)
#pragma unroll
            for (int c0 = 0; c0 < CH_A; ++c0) CH_ISSUE(c0);
            for (int ch = 0; ch < 32; ++ch) {
                const int rem = 31 - ch;
                if (rem >= 3) asm volatile("s_waitcnt vmcnt(36)" ::: "memory"); else if (rem == 2) asm volatile("s_waitcnt vmcnt(24)" ::: "memory");
                else if (rem == 1) asm volatile("s_waitcnt vmcnt(12)" ::: "memory"); else asm volatile("s_waitcnt vmcnt(0)" ::: "memory");
                CH_BAR();
                if (ch + CH_A < 32) CH_ISSUE(ch + CH_A);
            }
#undef CH_ISSUE
            CH_BAR();
        } else {
            const int sw = wave - 6;
            for (int ch = 0; ch <= 32; ++ch) {
                CH_BAR();
                if (ch >= 1) {
#pragma unroll
                    for (int q = 0; q < 2; ++q) { const int vt = sw * 2 + q;
                        const LAS unsigned char* ob = lds + CH_OBUF + vt * (2 * 64 * ORS) + ((ch - 1) & 1) * (64 * ORS) + lane * ORS;
                        const u32x4 w0 = *(const LAS u32x4*)ob, w1 = *(const LAS u32x4*)(ob + 16);
                        bf16_t* dst = proj + (size_t)(b * TP + (ch - 1) * 64 + lane) * NPROJ + slot + vt * 16;
                        *(u32x4*)dst = w0; *(u32x4*)(dst + 8) = w1; } }
            }
        }
        asm volatile("s_waitcnt vmcnt(0)" ::: "memory");
        __syncthreads();
    }
#undef CH_BAR
}

__device__ __forceinline__ void phase_mix_post(const Params& p, const int tid, const int bid, const int G) {
    const int lane = tid & 63, wave = tid >> 6, c = lane;
    const bf16_t* proj = (const bf16_t*)(p.ws + WS_BIG);
    bf16_t* ycat = (bf16_t*)(p.ws + WS_ACT);
    for (int row0 = bid * 8 + wave; row0 < MP / 2; row0 += G * 8) {
        float ow[2][8], g[2][8], bv[2][8], orr[2][8], gt[2][8];
#pragma unroll
        for (int r = 0; r < 2; ++r) { const int row = row0 + r * (MP / 2);
            const int b = row >> 11, tt = row & 2047, ch = tt >> 6, t = tt & 63; const unsigned ro = (unsigned)row * (unsigned)NPROJ;
#pragma unroll
            for (int h = 0; h < 8; ++h) { const unsigned hcc = (unsigned)(h * 64 + c); const int item = (b * 8 + h) * 32 + ch;
                const unsigned char* r2 = (const unsigned char*)(p.out + O_Y) + (size_t)item * 24576;
                ow[r][h] = bf2f(*(const bf16_t*)(r2 + t * 128 + c * 2)) + bf2f(proj[ro + (unsigned)(APROJ + 1024) + hcc]);
                g[r][h] = bf2f(*(const bf16_t*)(r2 + 8192 + t * 128 + c * 2)); bv[r][h] = bf2f(*(const bf16_t*)(r2 + 16384 + t * 128 + c * 2));
                orr[r][h] = bf2f(proj[ro + (unsigned)(APROJ + 512) + hcc]) + bf2f(proj[ro + (unsigned)APROJ + hcc]);
                gt[r][h] = bf2f(proj[ro + (unsigned)(APROJ + 1536) + hcc]); } }
#pragma unroll
        for (int r = 0; r < 2; ++r) { const int row = row0 + r * (MP / 2);
            float sw[8], qw[8], sr[8], qr[8];
#pragma unroll
            for (int h = 0; h < 8; ++h) { sw[h] = ow[r][h]; qw[h] = ow[r][h] * ow[r][h]; sr[h] = orr[r][h]; qr[h] = orr[r][h] * orr[r][h]; }
#pragma unroll
            for (int h = 0; h < 8; ++h) { sw[h] = wave_sum(sw[h]); qw[h] = wave_sum(qw[h]); sr[h] = wave_sum(sr[h]); qr[h] = wave_sum(qr[h]); }
#pragma unroll
            for (int h = 0; h < 8; ++h) { const unsigned hcc = (unsigned)(h * 64 + c);
                const float mw = sw[h] * (1.f / 64.f), vw = fmaxf(qw[h] * (1.f / 64.f) - mw * mw, 0.f);
                const float ya = ((ow[r][h] - mw) * rsqrtf(vw + 64e-5f) * p.in[16][hcc] + p.in[17][hcc] + bv[r][h]) * g[r][h];
                const float mr_ = sr[h] * (1.f / 64.f), vr = fmaxf(qr[h] * (1.f / 64.f) - mr_ * mr_, 0.f);
                const float yb = gt[r][h] / (1.0f + __expf(-gt[r][h])) * ((orr[r][h] - mr_) * rsqrtf(vr + 1e-5f) * p.in[18][hcc] + p.in[19][hcc]);
                const float ya2 = dpp_mov<0xF5>(ya), yb2 = dpp_mov<0xF5>(yb);
                if (!(c & 1)) { *(unsigned*)(ycat + ((unsigned)row * (unsigned)DM + hcc)) = cvt_pk_bf16(ya, ya2); *(unsigned*)(ycat + ((unsigned)row * (unsigned)DM + 512u + hcc)) = cvt_pk_bf16(yb, yb2); } } }
    }
}

__device__ __forceinline__ void phase_ln(float* X, const float* g, const float* bta, bf16_t* xb, const bool want_bf16, const int tid, const int bid, const int G) {
    const int lane = tid & 63, wave = tid >> 6;
    f32x4 gg[4], bb[4];
#pragma unroll
    for (int i = 0; i < 4; ++i) { gg[i] = *(const f32x4*)(g + i * 256 + lane * 4); bb[i] = *(const f32x4*)(bta + i * 256 + lane * 4); }
    for (int row = bid * 8 + wave; row < MT; row += G * 8) {
        float* xr = X + (size_t)row * DM; f32x4 v[4]; float s = 0.f;
#pragma unroll
        for (int i = 0; i < 4; ++i) { v[i] = *(const f32x4*)(xr + i * 256 + lane * 4); s += (v[i][0] + v[i][1]) + (v[i][2] + v[i][3]); }
        const float mean = wave_sum(s) * (1.f / 1024.f); float q = 0.f;
#pragma unroll
        for (int i = 0; i < 4; ++i) { v[i] -= mean; q += (v[i][0] * v[i][0] + v[i][1] * v[i][1]) + (v[i][2] * v[i][2] + v[i][3] * v[i][3]); }
        const float rstd = rsqrtf(wave_sum(q) * (1.f / 1024.f) + 1e-5f);
#pragma unroll
        for (int i = 0; i < 4; ++i) { const f32x4 y = v[i] * rstd * gg[i] + bb[i]; *(f32x4*)(xr + i * 256 + lane * 4) = y;
            if (want_bf16) { u32x2 w; w.x = cvt_pk_bf16(y[0], y[1]); w.y = cvt_pk_bf16(y[2], y[3]); *(u32x2*)(xb + (size_t)row * DM + i * 256 + lane * 4) = w; } }
    }
}

__device__ __forceinline__ void phase_conv(const Params& p, const int tid, const int bid, const int G) {
    const bf16_t* cp = (const bf16_t*)(p.ws + WS_BIG);
    bf16_t* vb = (bf16_t*)(p.ws + WS_ACT);
    const float* cw = p.in[22];
    const size_t total = (size_t)MT * 128;
    for (size_t idx0 = (size_t)bid * NTHREADS + tid; idx0 < total / 2; idx0 += (size_t)G * NTHREADS)
#pragma unroll
    for (int rr = 0; rr < 2; ++rr) { const size_t idx = idx0 + (size_t)rr * (total / 2);
        const int row = (int)(idx >> 7), c0 = (int)(idx & 127) * 8;
        const bool smp = row >= MP; const int T = smp ? TS : TP; const int b = smp ? (row - MP) / TS : row / TP; const int t = smp ? (row - MP) % TS : row % TP;
        float u[3][8];
#pragma unroll
        for (int d = 0; d < 3; ++d) { const int tt = t - 2 + d;
            if (tt >= 0) { const bf16_t* r = cp + (size_t)(row - 2 + d) * NCONV; const u32x4 cgv = *(const u32x4*)(r + 1024 + c0), hv = *(const u32x4*)(r + 2048 + c0);
#pragma unroll
                for (int q = 0; q < 4; ++q) { u[d][2 * q] = __uint_as_float(cgv[q] << 16) * __uint_as_float(hv[q] << 16); u[d][2 * q + 1] = __uint_as_float(cgv[q] & 0xffff0000u) * __uint_as_float(hv[q] & 0xffff0000u); } }
            else { if (smp) { const float* sr = p.in[5] + ((size_t)b * 2 + (tt + 2)) * DM + c0;
#pragma unroll
                    for (int q = 0; q < 8; ++q) u[d][q] = sr[q]; }
                else {
#pragma unroll
                    for (int q = 0; q < 8; ++q) u[d][q] = 0.f; } } }
        const u32x4 bgv = *(const u32x4*)(cp + (size_t)row * NCONV + c0); float o[8];
#pragma unroll
        for (int q = 0; q < 8; ++q) { const float bg = (q & 1) ? __uint_as_float(bgv[q >> 1] & 0xffff0000u) : __uint_as_float(bgv[q >> 1] << 16);
            o[q] = bg * (u[0][q] * cw[c0 + q] + u[1][q] * cw[DM + c0 + q] + u[2][q] * cw[2 * DM + c0 + q]); }
        u32x4 w; w.x = cvt_pk_bf16(o[0], o[1]); w.y = cvt_pk_bf16(o[2], o[3]); w.z = cvt_pk_bf16(o[4], o[5]); w.w = cvt_pk_bf16(o[6], o[7]);
        *(u32x4*)(vb + (size_t)row * DM + c0) = w;
        if (t >= T - 2) { float* dst = p.out + (smp ? O_SCONV : O_PCONV) + ((size_t)b * 2 + (t - (T - 2))) * DM + c0;
#pragma unroll
            for (int q = 0; q < 8; ++q) dst[q] = u[2][q]; }
    }
}


#define XB_TMO      128
#define XB_XCNT(j)  (256  + 64 * (j))
#define XB_XSUB(j)  (1280 + 64 * (j))
#define XB_XGEN(j)  (2304 + 64 * (j))
#define XB_TOP      3328
#define XB_TOPGEN   3392
#define XCD_BAR_WORDS 3456
#define XB_SPIN_CAP (1u << 18)
__device__ __forceinline__ unsigned xb_ld(unsigned* p)              { return __hip_atomic_load(p, __ATOMIC_RELAXED, __HIP_MEMORY_SCOPE_AGENT); }
__device__ __forceinline__ unsigned xb_add(unsigned* p, unsigned v) { return __hip_atomic_fetch_add(p, v, __ATOMIC_RELAXED, __HIP_MEMORY_SCOPE_AGENT); }
__device__ __forceinline__ unsigned xb_xcc_id() { return (unsigned)__builtin_amdgcn_s_getreg((3 << 11) | 20) & 0xFu; }
#define XB_SPIN(cond, bar) do { unsigned _sp = 0; while (cond) { __builtin_amdgcn_s_sleep(1); \
    if ((++_sp & 255u) == 0u) { if (xb_ld(&(bar)[XB_TMO])) break; if (_sp > XB_SPIN_CAP) { atomicAdd(&(bar)[XB_TMO], 1u); break; } } } } while (0)
struct XcdBarrier { unsigned* bar; unsigned x; volatile LAS unsigned* st; };
__device__ __forceinline__ XcdBarrier xcd_barrier_post(unsigned* bar, volatile LAS unsigned* st) {
    XcdBarrier b; b.bar = bar; b.x = xb_xcc_id(); b.st = st;
    if (threadIdx.x == 0) (void)xb_add(&bar[XB_XCNT(b.x)], 1u);
    return b;
}
__device__ __forceinline__ void xcd_barrier_complete(unsigned* bar, unsigned x, unsigned& nloc, unsigned& nx) {
    const unsigned G = gridDim.x * gridDim.y * gridDim.z;
    unsigned sum, cnt, mine, sp = 0u;
    for (;;) {
        sum = 0u; cnt = 0u; mine = 0u;
#pragma unroll
        for (unsigned j = 0; j < 16; ++j) { const unsigned c = xb_ld(&bar[XB_XCNT(j)]); sum += c; cnt += (c > 0u) ? 1u : 0u; mine = (j == x) ? c : mine; }
        if (sum == G) break;
        __builtin_amdgcn_s_sleep(1);
        if ((++sp & 255u) == 0u) { if (xb_ld(&bar[XB_TMO])) break; if (sp > XB_SPIN_CAP) { atomicAdd(&bar[XB_TMO], 1u); break; } }
    }
    nloc = mine > 0u ? mine : 1u; nx = cnt > 0u ? cnt : 1u;
}
__device__ __forceinline__ void xcd_barrier(const XcdBarrier& b) {
    asm volatile("s_waitcnt vmcnt(0)" ::: "memory");
    __syncthreads();
    if (threadIdx.x == 0) {
        unsigned* bar = b.bar;
        __builtin_amdgcn_s_waitcnt(0);
        unsigned nloc = b.st[0], nx = b.st[1];
        if (nloc == 0u) { xcd_barrier_complete(bar, b.x, nloc, nx); b.st[0] = nloc; b.st[1] = nx; }
        const unsigned old = xb_add(&bar[XB_XSUB(b.x)], 1u);
        const unsigned gen = old / nloc;
        if (old + 1u == (gen + 1u) * nloc) {
            __builtin_amdgcn_fence(__ATOMIC_RELEASE, "agent");
            asm volatile("s_waitcnt vmcnt(0)" ::: "memory");
            const unsigned og = xb_add(&bar[XB_TOP], 1u);
            const unsigned tg = og / nx;
            if (og + 1u == (tg + 1u) * nx) xb_add(&bar[XB_TOPGEN], 1u);
            else XB_SPIN(xb_ld(&bar[XB_TOPGEN]) == tg, bar);
            __builtin_amdgcn_fence(__ATOMIC_ACQUIRE, "agent");
            xb_add(&bar[XB_XGEN(b.x)], 1u);
            asm volatile("s_waitcnt vmcnt(0)" ::: "memory");
        } else {
            XB_SPIN(xb_ld(&bar[XB_XGEN(b.x)]) == gen, bar);
            __builtin_amdgcn_fence(__ATOMIC_ACQUIRE, "agent");
            asm volatile("s_waitcnt vmcnt(0)" ::: "memory");
        }
    }
    __syncthreads();
}

__global__ void __launch_bounds__(NTHREADS, 2) mega(Params p_arg) {
    extern __shared__ __attribute__((aligned(16))) unsigned char lds[];
    cg::grid_group grid = cg::this_grid();
    LAS unsigned char* ldsl = (LAS unsigned char*)lds;
    float* L = (float*)lds;
    const int lo = p_arg.ph_lo, hi = p_arg.ph_hi & 0xff; const int dbg = p_arg.ph_hi >> 8;
    volatile LAS unsigned* xb_st = (volatile LAS unsigned*)(ldsl + 155648);
    if (threadIdx.x == 0) { xb_st[0] = 0u; xb_st[1] = 0u; }
    __syncthreads();
    const XcdBarrier xbar = xcd_barrier_post((unsigned*)(p_arg.ws + WS_BAR), xb_st);
    const int wid_s = __builtin_amdgcn_readfirstlane((int)threadIdx.x >> 6);
    for (int ph = lo; ph < hi; ++ph) {
        unsigned zero_v = 0u; asm volatile("" : "+v"(zero_v));
        int tid = wid_s * 64 + (int)__builtin_amdgcn_mbcnt_hi(~0u, __builtin_amdgcn_mbcnt_lo(~0u, zero_v)), bid = blockIdx.x, G = gridDim.x;
        asm volatile("" : "+v"(tid), "+s"(bid), "+s"(G));
        const __attribute__((address_space(4))) Params* pk = (const __attribute__((address_space(4))) Params*)__builtin_amdgcn_kernarg_segment_ptr();
        asm volatile("" : "+s"(pk));
        const Params& p = *(const Params*)pk;
        bf16_t* act = (bf16_t*)(p.ws + WS_ACT); bf16_t* big = (bf16_t*)(p.ws + WS_BIG);
        float* Y = p.out + O_Y;
#if PROBE_MASK
        if (bid == 0 && tid == 0) ((unsigned long long*)(p.ws + WS_STAMP))[ph] = __builtin_amdgcn_s_memrealtime();
#endif
        if (ph == 0) phase_convert(p, L, tid, bid, G, 0, 960, true);
        else if (ph == 2) { phase_mix_local(p, ldsl, tid, (dbg & 1) ? 4096 : bid, G); __syncthreads(); phase_sample(p, ldsl, tid, bid, G); }
        else if (ph == 3) { phase_chain(p, ldsl, tid, (dbg & 2) ? 4096 : bid, G);
            if (G > 128) { if (bid >= 128) phase_convert(p, L, tid, bid - 128, G - 128, 960, 6336, false); } else { __syncthreads(); phase_convert(p, L, tid, bid, G, 960, 6336, false); } }
        else if (ph == 4) phase_mix_post(p, tid, (dbg & 4) ? (1 << 20) : bid, G);
        else if (ph == 11) phase_conv(p, tid, bid, G);
        else if (ph == 6 || ph == 9 || ph == 13 || ph == 16) {
            const int l = ph >= 13 ? 1 : 0; const bool second = (ph == 9 || ph == 16);
            phase_ln(Y, (second ? p.in[26] : p.in[24]) + l * DM, (second ? p.in[27] : p.in[25]) + l * DM, act, ph != 16, tid, bid, G);
        } else {
            pg8::Gemm g; pg8::Epi E; E.O = big; E.xlo = Y; E.xhi = Y; E.Z = Y; g.M = MT; g.A = act; g.K = DM;
            size_t wo;
            switch (ph) {
                case 1: wo = WS_WIN; g.N = NPROJ; E.mode = 0; break;
                case 5: wo = WS_WOUT; g.N = DM; E.mode = 2; E.xlo = p.in[0]; E.xhi = p.in[1] - (size_t)MP * DM; break;
                case 7: wo = WS_WUP0; g.N = DFF; E.mode = 1; break;
                case 8: wo = WS_WDN0; g.N = DM; g.K = DFF; g.A = big; E.mode = 2; break;
                case 10: wo = WS_WCIN; g.N = NCONV; E.mode = 0; break;
                case 12: wo = WS_WCOUT; g.N = DM; E.mode = 2; break;
                case 14: wo = WS_WUP1; g.N = DFF; E.mode = 1; break;
                default: wo = WS_WDN1; g.N = DM; g.K = DFF; g.A = big; E.mode = 2; break;
            }
            g.Bt = (const bf16_t*)(p.ws + wo); E.ldc = g.N;
            pg8::StaticOrder S; S.init(MT, g.N, G, bid);
            const bool split_tail = (E.mode == 2 && G == 256 && S.nwg == 272);
            if (split_tail) S.lim = 256;
            pg8::gemm_phase(ldsl, g, S, E, tid);
            if (split_tail) { pg8::Unit u; S.map(256 + (bid >> 4), u); const int s = bid & 15; const int row0 = u.pm * 256 + (s >> 2) * 64, col0 = u.pn * 256 + (s & 3) * 64;
                gemm64_resid(ldsl, g.A, g.Bt, g.K, row0, col0, (row0 < MP) ? E.xlo : E.xhi, E.Z, tid); }
        }
        if (ph + 1 < hi) { if (dbg & 64) grid.sync(); else xcd_barrier(xbar); }
#if PROBE_MASK
        if (ph + 1 == hi && bid == 0 && tid == 0) { unsigned long long* st = (unsigned long long*)(p.ws + WS_STAMP); st[hi] = __builtin_amdgcn_s_memrealtime();
            unsigned long long tot = 0; for (int k = lo; k < hi; ++k) if ((PROBE_MASK >> k) & 1) tot += st[k + 1] - st[k];
            asm volatile("s_waitcnt vmcnt(0)" ::: "memory"); p.out[0] = (float)tot * 0.01f; }
#endif
    }
}
#ifndef PROBE_MASK
#define PROBE_MASK 0
#endif
constexpr int NPHASES = 17;
#ifndef DBG
#define DBG 0
#endif

#ifndef PER_PHASE_LAUNCH
#define PER_PHASE_LAUNCH 0
#endif

extern "C" void kernel_launch(void* const* d_in, const int* in_sizes, int n_in, void* d_out, int out_size, void* d_ws, size_t ws_size, hipStream_t stream) {
    static int grid = 0;
    if (grid == 0) {
        if (n_in != 30 || ws_size < WS_END2) { fprintf(stderr, "kernel_launch: unexpected n_in %d or ws_size %zu (need %zu)\n", n_in, ws_size, (size_t)WS_END2); grid = -1; return; }
        int dev = 0, cus = 0, per_cu = 0;
        hipGetDevice(&dev);
        hipDeviceGetAttribute(&cus, hipDeviceAttributeMultiprocessorCount, dev);
        if (hipFuncSetAttribute((const void*)mega, hipFuncAttributeMaxDynamicSharedMemorySize, LDS_BYTES) != hipSuccess) { fprintf(stderr, "kernel_launch: hipFuncSetAttribute failed\n"); grid = -1; return; }
        if (hipOccupancyMaxActiveBlocksPerMultiprocessor(&per_cu, (const void*)mega, NTHREADS, LDS_BYTES) != hipSuccess || per_cu < 1) { fprintf(stderr, "kernel_launch: occupancy query failed (%d)\n", per_cu); (void)hipGetLastError(); per_cu = 1; }
        if (per_cu > 1) per_cu = 1;
        grid = cus * per_cu;
    }
    if (grid < 0) return;
    if (hipMemsetAsync((char*)d_ws + WS_BAR, 0, 3456 * 4, stream) != hipSuccess) { fprintf(stderr, "kernel_launch: hipMemsetAsync failed\n"); return; }
    Params p{};
    for (int i = 0; i < 30; ++i) p.in[i] = (const float*)d_in[i];
    p.out = (float*)d_out; p.ws = (unsigned char*)d_ws;
    for (int f = 0; f < 32; ++f) p.inv_freq[f] = pow(10000.0, -(double)f / 32.0);
#if PER_PHASE_LAUNCH
    for (int ph = 0; ph < NPHASES; ++ph) { p.ph_lo = ph; p.ph_hi = ph + 1; hipLaunchKernelGGL(mega, dim3(grid), dim3(NTHREADS), LDS_BYTES, stream, p); }
#else
    p.ph_lo = 0; p.ph_hi = NPHASES | (DBG << 8);
    void* args[] = {&p};
    hipError_t e = hipLaunchCooperativeKernel((const void*)mega, dim3(grid), dim3(NTHREADS), args, LDS_BYTES, stream);
    if (e != hipSuccess) fprintf(stderr, "cooperative launch failed: %s (grid %d)\n", hipGetErrorString(e), grid);
#endif
}
```
